# Optimizing an MI355X kernel written in HIP

```python
import jax
import jax.numpy as jnp
from jax import lax
import numpy as np

D_MODEL = 1024
BATCH = 4
SEQ = 4096
DEPTH = 4

GRID_W = 64
CTX_LEN = 256
M_HEADS = 4
M_HEAD_DIM = 256
M_WIDTH = M_HEADS * M_HEAD_DIM
M_CHUNK = 64
M_CONV = 3
A_HEADS = 8
A_NOPE = 128
A_ROPE = 64
A_VDIM = 128
A_QRANK = 384
A_KVRANK = 256
A_QBLOCK = 128
AXIS_ROT = A_ROPE // 2
ROPE_THETA = 10000.0
D_FF = 2816
N_BRANCH = 2
N_MOD = 9
EPS = 1e-6

IN_GROUPS = (('m_q', M_WIDTH), ('m_k', M_WIDTH), ('m_v', M_WIDTH), ('m_o', M_WIDTH), ('m_gate', 4 * M_HEADS), ('a_cq', A_QRANK), ('a_ckv', A_KVRANK), ('a_kr', A_ROPE), ('br_gate', N_BRANCH * D_MODEL))
IN_WIDTH = 4 * M_WIDTH + 4 * M_HEADS + A_QRANK + A_KVRANK + A_ROPE + N_BRANCH * D_MODEL
ALL_GROUPS = ('m_q', 'm_k', 'm_v', 'm_o', 'm_gate', 'a_cq', 'a_ckv', 'a_kr', 'br_gate')
CTX_KV_GROUPS = ('m_k', 'm_v', 'm_gate', 'a_ckv', 'a_kr')

kernel_name = 'hybrid_mlstm_mla_macaron_dit'


def _rmsnorm(x, g):
    xf = x.astype(jnp.float32)
    y = xf * lax.rsqrt(jnp.mean(xf * xf, axis=-1, keepdims=True) + EPS)
    return (y * g.astype(jnp.float32)).astype(x.dtype)


def _modulate(h, shift, scale):
    return h * (1 + scale) + shift


def _swiglu(h, w_up, w_dn):
    a, b = jnp.split(h @ w_up, 2, axis=-1)
    return (jax.nn.silu(a) * b) @ w_dn


def _short_conv(x, w):
    pad = M_CONV // 2
    T = x.shape[1]
    xp = jnp.pad(x, ((0, 0), (pad, pad), (0, 0)))
    return sum(xp[:, i:i + T] * w[i] for i in range(M_CONV))


def _project(h, w_in, names):
    sizes = dict(IN_GROUPS)
    offs, o = {}, 0
    for name, n in IN_GROUPS:
        offs[name] = o
        o += n
    w = w_in if names == ALL_GROUPS else jnp.concatenate([w_in[:, offs[k]:offs[k] + sizes[k]] for k in names], axis=1)
    z = h @ w
    cuts = np.cumsum([sizes[k] for k in names])[:-1].tolist()
    return dict(zip(names, jnp.split(z, cuts, axis=-1)))


def _rope_tables(row, col):
    inv = ROPE_THETA ** (-jnp.arange(0, AXIS_ROT, 2, dtype=jnp.float32) / AXIS_ROT)
    ang = jnp.concatenate([row[:, None] * inv, col[:, None] * inv], axis=-1)
    return jnp.cos(ang), jnp.sin(ang)


def _rope(x, cos, sin):
    xr = x.astype(jnp.float32).reshape(*x.shape[:-1], A_ROPE // 2, 2)
    x1, x2 = xr[..., 0], xr[..., 1]
    c, s = cos[:, None, :], sin[:, None, :]
    out = jnp.stack([x1 * c - x2 * s, x1 * s + x2 * c], axis=-1)
    return out.reshape(x.shape).astype(x.dtype)


def _mlstm_kvg(z, p):
    B, T = z['m_k'].shape[:2]
    k = jax.nn.silu(_short_conv(z['m_k'], p['w_conv'][:, M_WIDTH:])).reshape(B, T, M_HEADS, M_HEAD_DIM)
    v = z['m_v'].reshape(B, T, M_HEADS, M_HEAD_DIM)
    g = (z['m_gate'] + p['b_gate']).reshape(B, T, 2, 2, M_HEADS)
    return k, v, g


def _mlstm_q(z, p):
    B, T = z['m_q'].shape[:2]
    q = jax.nn.silu(_short_conv(z['m_q'], p['w_conv'][:, :M_WIDTH])) * (M_HEAD_DIM ** -0.5)
    return q.reshape(B, T, M_HEADS, M_HEAD_DIM)


def _mlstm_scan(k, v, ig, fg, state, q=None):
    B, T, H, dh = k.shape
    nc = T // M_CHUNK

    def chunks(a):
        a = a.astype(jnp.float32).reshape(B, nc, M_CHUNK, H, *a.shape[3:])
        return jnp.moveaxis(a, (1, 3), (0, 2))

    xs = (chunks(k), chunks(v), chunks(ig), chunks(jax.nn.log_sigmoid(fg.astype(jnp.float32))))
    if q is not None:
        xs = xs + (chunks(q),)
    tri = jnp.tril(jnp.ones((M_CHUNK, M_CHUNK), dtype=bool))

    def body(carry, xc):
        C, n, m = carry
        kc, vc, ic, lc = xc[:4]
        b = jnp.cumsum(lc, axis=-1)
        bL = b[..., -1]
        end_log = bL[..., None] - b + ic
        m_new = jnp.maximum(bL + m, jnp.max(end_log, axis=-1))
        a_state = jnp.exp(bL + m - m_new)
        w_end = jnp.exp(end_log - m_new[..., None])
        C_new = a_state[..., None, None] * C + jnp.einsum('bhs,bhsk,bhsv->bhkv', w_end, kc, vc)
        n_new = a_state[..., None] * n + jnp.einsum('bhs,bhsk->bhk', w_end, kc)
        new = (C_new, n_new, m_new)
        if q is None:
            return new, None
        qc = xc[4]
        dlog = jnp.where(tri, b[..., :, None] - b[..., None, :] + ic[..., None, :], -jnp.inf)
        inter = b + m[..., None]
        mj = jnp.maximum(inter, jnp.max(dlog, axis=-1))
        s = jnp.einsum('bhjd,bhsd->bhjs', qc, kc) * jnp.exp(dlog - mj[..., None])
        e_inter = jnp.exp(inter - mj)
        num = s @ vc + e_inter[..., None] * (qc @ C)
        den = jnp.sum(s, axis=-1) + e_inter * jnp.einsum('bhjk,bhk->bhj', qc, n)
        h = num / jnp.maximum(jnp.abs(den), jnp.exp(-mj))[..., None]
        return new, h

    state, hs = lax.scan(body, state, xs)
    if q is None:
        return state, None
    return state, jnp.moveaxis(hs, (0, 2), (1, 3)).reshape(B, T, H, dh)


def _identity(a):
    return a


def _flip(a):
    return a[:, ::-1]


def _mlstm_out(h, z, p):
    B, T = h.shape[:2]
    hn = _rmsnorm(h, p['g_mh'].reshape(M_HEADS, M_HEAD_DIM)).astype(z['m_o'].dtype).reshape(B, T, M_WIDTH)
    return jax.nn.sigmoid(z['m_o']) * hn


def _mla_kv(z, p, cos, sin):
    B, T = z['a_ckv'].shape[:2]
    kv = (_rmsnorm(z['a_ckv'], p['g_kva']) @ p['w_ukv']).reshape(B, T, A_HEADS, A_NOPE + A_VDIM)
    k_nope, v = kv[..., :A_NOPE], kv[..., A_NOPE:]
    k_rope = z['a_kr'][:, :, None, :]
    if cos is not None:
        k_rope = _rope(k_rope, cos, sin)
    k = jnp.concatenate([k_nope, jnp.broadcast_to(k_rope, (B, T, A_HEADS, A_ROPE))], axis=-1)
    return k, v


def _mla_q(z, p, cos, sin):
    B, T = z['a_cq'].shape[:2]
    q = (_rmsnorm(z['a_cq'], p['g_qa']) @ p['w_uq']).reshape(B, T, A_HEADS, A_NOPE + A_ROPE)
    q_nope, q_rope = q[..., :A_NOPE], q[..., A_NOPE:]
    if cos is not None:
        q_rope = _rope(q_rope, cos, sin)
    return jnp.concatenate([q_nope, q_rope], axis=-1)


def _attend(q, k, v):
    B, T, H, dqk = q.shape
    blk = min(A_QBLOCK, T)
    nb = T // blk
    scale = dqk ** -0.5
    qb = jnp.moveaxis(q.reshape(B, nb, blk, H, dqk), 1, 0)

    def one(qi):
        s = jnp.einsum('bqhd,bkhd->bhqk', qi, k).astype(jnp.float32) * scale
        pr = jax.nn.softmax(s, axis=-1).astype(v.dtype)
        return jnp.einsum('bhqk,bkhd->bqhd', pr, v)

    o = lax.map(one, qb)
    return jnp.moveaxis(o, 0, 1).reshape(B, T, H * v.shape[-1])


def _merge(hm, ha, z, p):
    g_m, g_a = jnp.split(jax.nn.sigmoid(z['br_gate']), N_BRANCH, axis=-1)
    return (g_m * (hm @ p['w_bm']) + g_a * (ha @ p['w_ba'])) @ p['w_out']


def _token_mix(hc, hx, p, cos, sin, ctx_out):
    zc = _project(hc, p['w_in'], ALL_GROUPS if ctx_out else CTX_KV_GROUPS)
    zx = _project(hx, p['w_in'], ALL_GROUPS)
    B = hx.shape[0]
    kc, vc, gc = _mlstm_kvg(zc, p)
    kx, vx, gx = _mlstm_kvg(zx, p)
    qc = _mlstm_q(zc, p) if ctx_out else None
    qx = _mlstm_q(zx, p)
    state0 = (jnp.zeros((B, M_HEADS, M_HEAD_DIM, M_HEAD_DIM), jnp.float32), jnp.zeros((B, M_HEADS, M_HEAD_DIM), jnp.float32), jnp.zeros((B, M_HEADS), jnp.float32))
    h_ctx, h_lat = 0.0, 0.0
    for d in range(2):
        f = _identity if d == 0 else _flip
        st_c, hcd = _mlstm_scan(f(kc), f(vc), f(gc[:, :, d, 0]), f(gc[:, :, d, 1]), state0, None if qc is None else f(qc))
        _, hxd = _mlstm_scan(f(kx), f(vx), f(gx[:, :, d, 0]), f(gx[:, :, d, 1]), st_c, f(qx))
        h_lat = h_lat + f(hxd)
        if ctx_out:
            h_ctx = h_ctx + f(hcd)
    k_c, v_c = _mla_kv(zc, p, None, None)
    k_x, v_x = _mla_kv(zx, p, cos, sin)
    a_lat = _attend(_mla_q(zx, p, cos, sin), jnp.concatenate([k_c, k_x], axis=1), jnp.concatenate([v_c, v_x], axis=1))
    y_lat = _merge(_mlstm_out(h_lat, zx, p), a_lat, zx, p)
    if not ctx_out:
        return None, y_lat
    a_ctx = _attend(_mla_q(zc, p, None, None), k_c, v_c)
    y_ctx = _merge(_mlstm_out(h_ctx, zc, p), a_ctx, zc, p)
    return y_ctx, y_lat


def setup_inputs(seed: int = 0) -> dict:
    key = jax.random.key(seed)
    ks = jax.random.split(key, 32)
    L, D = DEPTH, D_MODEL

    def nrm(k, shape, s):
        return s * jax.random.normal(k, shape, jnp.float32)

    def gain(k, shape):
        return 1.0 + 0.05 * jax.random.normal(k, shape, jnp.float32)

    ib = nrm(ks[20], (L, 2, M_HEADS), 0.1)
    fb = 3.0 + 3.0 * jax.random.uniform(ks[21], (L, 2, M_HEADS), jnp.float32)
    b_gate = jnp.stack([ib, fb], axis=2).reshape(L, 4 * M_HEADS)
    return {
        'x': nrm(ks[0], (BATCH, SEQ, D), 1.0),
        'c': nrm(ks[1], (BATCH, D), 1.0),
        'ctx': nrm(ks[2], (BATCH, CTX_LEN, D), 1.0),
        'c_ctx': nrm(ks[3], (D,), 1.0),
        'w_ada': nrm(ks[4], (L, D, N_MOD * D), 0.5 * D ** -0.5),
        'b_ada': nrm(ks[5], (L, N_MOD * D), 0.02),
        'g_n1': gain(ks[6], (L, D)),
        'g_n2': gain(ks[7], (L, D)),
        'g_n3': gain(ks[8], (L, D)),
        'w_ff1_up': nrm(ks[9], (L, D, 2 * D_FF), D ** -0.5),
        'w_ff1_dn': nrm(ks[10], (L, D_FF, D), D_FF ** -0.5),
        'w_ff2_up': nrm(ks[11], (L, D, 2 * D_FF), D ** -0.5),
        'w_ff2_dn': nrm(ks[12], (L, D_FF, D), D_FF ** -0.5),
        'w_in': nrm(ks[13], (L, D, IN_WIDTH), D ** -0.5),
        'b_gate': b_gate,
        'w_conv': nrm(ks[14], (L, M_CONV, 2 * M_WIDTH), M_CONV ** -0.5),
        'g_mh': gain(ks[15], (L, M_WIDTH)),
        'g_qa': gain(ks[16], (L, A_QRANK)),
        'g_kva': gain(ks[17], (L, A_KVRANK)),
        'w_uq': nrm(ks[18], (L, A_QRANK, A_HEADS * (A_NOPE + A_ROPE)), A_QRANK ** -0.5),
        'w_ukv': nrm(ks[19], (L, A_KVRANK, A_HEADS * (A_NOPE + A_VDIM)), A_KVRANK ** -0.5),
        'w_bm': nrm(ks[22], (L, M_WIDTH, D), M_WIDTH ** -0.5),
        'w_ba': nrm(ks[23], (L, A_HEADS * A_VDIM, D), (A_HEADS * A_VDIM) ** -0.5),
        'w_out': nrm(ks[24], (L, D, D), D ** -0.5),
        'g_final': gain(ks[25], (D,)),
    }


def reference(x, c, ctx, c_ctx, w_ada, b_ada, g_n1, g_n2, g_n3, w_ff1_up, w_ff1_dn, w_ff2_up, w_ff2_dn, w_in, b_gate, w_conv, g_mh, g_qa, g_kva, w_uq, w_ukv, w_bm, w_ba, w_out, g_final):
    S = x.shape[1]
    ROWS = S // GRID_W
    row = jnp.repeat(jnp.arange(ROWS, dtype=jnp.float32), GRID_W)
    col = jnp.tile(jnp.arange(GRID_W, dtype=jnp.float32), ROWS)
    cos, sin = _rope_tables(row, col)
    for l in range(DEPTH):
        last = l == DEPTH - 1
        p = {'w_in': w_in[l], 'b_gate': b_gate[l], 'w_conv': w_conv[l], 'g_mh': g_mh[l], 'g_qa': g_qa[l], 'g_kva': g_kva[l], 'w_uq': w_uq[l], 'w_ukv': w_ukv[l], 'w_bm': w_bm[l], 'w_ba': w_ba[l], 'w_out': w_out[l]}
        mx = [m[:, None, :] for m in jnp.split(jax.nn.silu(c) @ w_ada[l] + b_ada[l], N_MOD, axis=-1)]
        mc = jnp.split(jax.nn.silu(c_ctx) @ w_ada[l] + b_ada[l], N_MOD, axis=-1)
        x = x + 0.5 * mx[2] * _swiglu(_modulate(_rmsnorm(x, g_n1[l]), mx[0], mx[1]), w_ff1_up[l], w_ff1_dn[l])
        ctx = ctx + 0.5 * mc[2] * _swiglu(_modulate(_rmsnorm(ctx, g_n1[l]), mc[0], mc[1]), w_ff1_up[l], w_ff1_dn[l])
        y_ctx, y_lat = _token_mix(_modulate(_rmsnorm(ctx, g_n2[l]), mc[3], mc[4]), _modulate(_rmsnorm(x, g_n2[l]), mx[3], mx[4]), p, cos, sin, not last)
        x = x + mx[5] * y_lat
        x = x + 0.5 * mx[8] * _swiglu(_modulate(_rmsnorm(x, g_n3[l]), mx[6], mx[7]), w_ff2_up[l], w_ff2_dn[l])
        if not last:
            ctx = ctx + mc[5] * y_ctx
            ctx = ctx + 0.5 * mc[8] * _swiglu(_modulate(_rmsnorm(ctx, g_n3[l]), mc[6], mc[7]), w_ff2_up[l], w_ff2_dn[l])
    return _rmsnorm(x, g_final)
```

```cpp
#include <hip/hip_runtime.h>
#include <hip/hip_cooperative_groups.h>
#include <cstdio>
namespace cg = cooperative_groups;

#ifndef DUP_MASK
#define DUP_MASK 0
#endif
#ifndef ONE_LAUNCH
#define ONE_LAUNCH 1
#endif

typedef unsigned short u16;
typedef __attribute__((ext_vector_type(8))) short bf16x8;
typedef __attribute__((ext_vector_type(4))) short s16x4;
typedef __attribute__((ext_vector_type(4))) float f32x4;
typedef __attribute__((ext_vector_type(16))) float f32x16;
typedef __attribute__((ext_vector_type(4))) _Float16 h16x4;
typedef __attribute__((ext_vector_type(4))) unsigned u32x4;
#define DI __device__ __forceinline__
#define MFMA16(a, b, c) __builtin_amdgcn_mfma_f32_16x16x32_bf16((a), (b), (c), 0, 0, 0)
#define MFMA32(a, b, c) __builtin_amdgcn_mfma_f32_32x32x16_bf16((a), (b), (c), 0, 0, 0)

constexpr int D = 1024, NB = 4, SEQ = 4096, NL = 4, CTX = 256;
constexpr int RL = NB * SEQ;
constexpr int RC = NB * CTX;
constexpr int R = RL + RC;
constexpr int DFF = 2816, INW = 6864, ZW = 6912, NMOD = 9;
constexpr float EPS = 1e-6f;
constexpr int NCH = 68;
constexpr int MT = R / 128;

constexpr size_t al(size_t x) { return (x + 255) & ~(size_t)255; }
constexpr size_t OFF_XC = 0;
constexpr size_t OFF_MODS = al(OFF_XC + (size_t)RC * D * 4);
constexpr size_t OFF_ROPE = al(OFF_MODS + (size_t)NL * 5 * NMOD * D * 4);
constexpr size_t OFF_G = al(OFF_ROPE + (size_t)SEQ * 32 * 8);
constexpr size_t OFF_CTR = al(OFF_G + (size_t)32 * NCH * 512 * 4);
constexpr size_t OFF_BAR = al(OFF_CTR + 8 * 16 * 4);
constexpr size_t OFF_WB = al(OFF_BAR + 3456 * 4);
constexpr size_t WB_UP1 = 0;
constexpr size_t WB_DN1 = WB_UP1 + (size_t)2 * DFF * D;
constexpr size_t WB_UP2 = WB_DN1 + (size_t)D * DFF;
constexpr size_t WB_DN2 = WB_UP2 + (size_t)2 * DFF * D;
constexpr size_t WB_IN = WB_DN2 + (size_t)D * DFF;
constexpr size_t WB_UQ = WB_IN + (size_t)ZW * D;
constexpr size_t WB_UKV = WB_UQ + (size_t)1536 * 384;
constexpr size_t WB_BM = WB_UKV + (size_t)2048 * 256;
constexpr size_t WB_BA = WB_BM + (size_t)D * D;
constexpr size_t WB_OUT = WB_BA + (size_t)D * D;
constexpr size_t WB_END = WB_OUT + (size_t)D * D;
constexpr size_t OFF_AN = al(OFF_WB + 2 * WB_END * 2);
constexpr size_t OFF_H = al(OFF_AN + (size_t)R * D * 2);
constexpr size_t OFF_ZQ = al(OFF_H + (size_t)R * DFF * 2);
constexpr size_t OFF_ZK = al(OFF_ZQ + (size_t)R * D * 2);
constexpr size_t OFF_ZV = al(OFF_ZK + (size_t)R * D * 2);
constexpr size_t OFF_ZO = al(OFF_ZV + (size_t)R * D * 2);
constexpr size_t OFF_ZCQ = al(OFF_ZO + (size_t)R * D * 2);
constexpr size_t OFF_ZCKV = al(OFF_ZCQ + (size_t)R * 384 * 2);
constexpr size_t OFF_ZKR = al(OFF_ZCKV + (size_t)R * 256 * 2);
constexpr size_t OFF_ZG = al(OFF_ZKR + (size_t)R * 64 * 2);
constexpr size_t OFF_ZBR = al(OFF_ZG + (size_t)R * 16 * 4);
constexpr size_t OFF_KC = al(OFF_ZBR + (size_t)R * 2048 * 2);
constexpr size_t OFF_KV = al(OFF_KC + (size_t)R * D * 2);
constexpr size_t OFF_CQN = al(OFF_KV + (size_t)R * 2048 * 2);
constexpr size_t OFF_CKVN = al(OFF_CQN + (size_t)R * 384 * 2);
constexpr size_t OFF_KROPE = al(OFF_CKVN + (size_t)R * 256 * 2);
constexpr size_t WS_END = al(OFF_KROPE + (size_t)R * 64 * 2);

constexpr int SMEM_BYTES = 76800;
constexpr int NPH_LAYER = 15;
constexpr int NPH = NL * NPH_LAYER + 1;

struct Params {
  const float *x, *c, *ctx, *c_ctx, *w_ada, *b_ada, *g_n1, *g_n2, *g_n3, *w_ff1_up, *w_ff1_dn, *w_ff2_up, *w_ff2_dn,
      *w_in, *b_gate, *w_conv, *g_mh, *g_qa, *g_kva, *w_uq, *w_ukv, *w_bm, *w_ba, *w_out, *g_final;
  float* out;
  char* ws;
  int ph_lo, ph_hi;
};

DI float bf2f(u16 u) { return __uint_as_float(((unsigned)u) << 16); }
DI u16 f2bf(float x) { return __builtin_bit_cast(u16, (__bf16)x); }
DI unsigned pk2(float a, float b) { return (unsigned)f2bf(a) | ((unsigned)f2bf(b) << 16); }
DI float siluf(float x) { return x / (1.f + __expf(-x)); }
DI float sigmf(float x) { return 1.f / (1.f + __expf(-x)); }
DI float wave_sum(float v) {
#pragma unroll
  for (int o = 32; o > 0; o >>= 1) v += __shfl_xor(v, o);
  return v;
}
DI float wave_max(float v) {
#pragma unroll
  for (int o = 32; o > 0; o >>= 1) v = fmaxf(v, __shfl_xor(v, o));
  return v;
}
DI int tidx() { int t = threadIdx.x; asm volatile("" : "+v"(t)); return t; }
DI unsigned bko(unsigned r, unsigned k, unsigned nkt) { return ((r >> 7) * nkt + (k >> 6)) * 8192u + ((r & 127u) << 6) + (k & 63u); }
DI float* xptr(const Params& p, int r) { return r < RL ? p.out + (size_t)r * D : (float*)(p.ws + OFF_XC) + (size_t)(r - RL) * D; }
DI int modrow(int r) { return r < RL ? (r >> 12) : 4; }
DI bf16x8 tr8(const char* lo, const char* hi) {
  s16x4 a = __builtin_amdgcn_ds_read_tr16_b64_v4i16((s16x4 __attribute__((address_space(3)))*)(lo));
  s16x4 b = __builtin_amdgcn_ds_read_tr16_b64_v4i16((s16x4 __attribute__((address_space(3)))*)(hi));
  return __builtin_shufflevector(a, b, 0, 1, 2, 3, 4, 5, 6, 7);
}


#define XB_TMO      128
#define XB_XCNT(j)  (256  + 64 * (j))
#define XB_XSUB(j)  (1280 + 64 * (j))
#define XB_XGEN(j)  (2304 + 64 * (j))
#define XB_TOP      3328
#define XB_TOPGEN   3392
#define XCD_BAR_WORDS 3456
#define XB_SPIN_CAP (1u << 22)
#define LAS __attribute__((address_space(3)))
DI unsigned xb_ld(unsigned* p) { return __hip_atomic_load(p, __ATOMIC_RELAXED, __HIP_MEMORY_SCOPE_AGENT); }
DI unsigned xb_add(unsigned* p, unsigned v) { return __hip_atomic_fetch_add(p, v, __ATOMIC_RELAXED, __HIP_MEMORY_SCOPE_AGENT); }
DI unsigned xb_xcc_id() { return (unsigned)__builtin_amdgcn_s_getreg((3 << 11) | 20) & 0xFu; }
#define XB_SPIN(cond, bar) do { unsigned _sp = 0; while (cond) { __builtin_amdgcn_s_sleep(1); \
    if ((++_sp & 255u) == 0u) { if (xb_ld(&(bar)[XB_TMO])) break; if (_sp > XB_SPIN_CAP) { atomicAdd(&(bar)[XB_TMO], 1u); break; } } } } while (0)
struct XcdBarrier { unsigned* bar; unsigned x; volatile LAS unsigned* st; };
DI XcdBarrier xcd_barrier_post(unsigned* bar, volatile LAS unsigned* st) {
  XcdBarrier b; b.bar = bar; b.x = xb_xcc_id(); b.st = st;
  if (threadIdx.x == 0) (void)xb_add(&bar[XB_XCNT(b.x)], 1u);
  return b;
}
DI void xcd_barrier_complete(unsigned* bar, unsigned x, unsigned& nloc, unsigned& nx) {
  const unsigned G = gridDim.x * gridDim.y * gridDim.z;
  unsigned sum, cnt, mine, sp = 0u;
  for (;;) {
    sum = 0u; cnt = 0u; mine = 0u;
#pragma unroll
    for (unsigned j = 0; j < 16; ++j) { const unsigned c = xb_ld(&bar[XB_XCNT(j)]); sum += c; cnt += (c > 0u) ? 1u : 0u; mine = (j == x) ? c : mine; }
    if (sum == G) break;
    __builtin_amdgcn_s_sleep(1);
    if ((++sp & 255u) == 0u) { if (xb_ld(&bar[XB_TMO])) break; if (sp > XB_SPIN_CAP) { atomicAdd(&bar[XB_TMO], 1u); break; } }
  }
  nloc = mine > 0u ? mine : 1u; nx = cnt > 0u ? cnt : 1u;
}
DI void xcd_barrier(const XcdBarrier& b) {
  asm volatile("s_waitcnt vmcnt(0)" ::: "memory");
  __syncthreads();
  if (threadIdx.x == 0) {
    unsigned* bar = b.bar;
    __builtin_amdgcn_s_waitcnt(0);
    unsigned nloc = b.st[0], nx = b.st[1];
    if (nloc == 0u) { xcd_barrier_complete(bar, b.x, nloc, nx); b.st[0] = nloc; b.st[1] = nx; }
    const unsigned old = xb_add(&bar[XB_XSUB(b.x)], 1u);
    const unsigned gen = old / nloc;
    if (old + 1u == (gen + 1u) * nloc) {
      __builtin_amdgcn_fence(__ATOMIC_RELEASE, "agent");
      asm volatile("s_waitcnt vmcnt(0)" ::: "memory");
      const unsigned og = xb_add(&bar[XB_TOP], 1u);
      const unsigned tg = og / nx;
      if (og + 1u == (tg + 1u) * nx) xb_add(&bar[XB_TOPGEN], 1u);
      else XB_SPIN(xb_ld(&bar[XB_TOPGEN]) == tg, bar);
      __builtin_amdgcn_fence(__ATOMIC_ACQUIRE, "agent");
      xb_add(&bar[XB_XGEN(b.x)], 1u);
      asm volatile("s_waitcnt vmcnt(0)" ::: "memory");
    } else {
      XB_SPIN(xb_ld(&bar[XB_XGEN(b.x)]) == gen, bar);
      __builtin_amdgcn_fence(__ATOMIC_ACQUIRE, "agent");
      asm volatile("s_waitcnt vmcnt(0)" ::: "memory");
    }
  }
  __syncthreads();
}

DI int src_col(int perm, int r) {
  if (perm == 0) return r;
  if (perm == 1) { int grp = r >> 6, j = r & 63; return j < 32 ? grp * 32 + j : DFF + grp * 32 + (j - 32); }
  if (r < 4096) return r;
  if (r < 4800) return r + 16;
  if (r < 4816) return r - 704;
  if (r < 4864) return -1;
  return r - 48;
}

DI void convert_tile(const float* __restrict__ W, int Nsrc, int K, int perm, u16* __restrict__ Wt, int tile, char* smem) {
  const int nkt = K >> 6;
  const int rt = tile / nkt, kt = tile - rt * nkt;
  const int r0 = rt * 32, k0 = kt * 64;
  u16* t = (u16*)smem;
  const int tid = tidx();
  {
    const int j = tid & 31, i = tid >> 5;
    const int sc = src_col(perm, r0 + j);
#pragma unroll
    for (int s = 0; s < 8; ++s) {
      const int k = i + 8 * s;
      float v = sc >= 0 ? W[(size_t)(k0 + k) * Nsrc + sc] : 0.f;
      t[j * 72 + k] = f2bf(v);
    }
  }
  __syncthreads();
  {
    const int row = tid >> 3, c8 = tid & 7;
    uint4 v = *(const uint4*)(t + row * 72 + c8 * 8);
    *(uint4*)(Wt + bko(r0 + row, k0 + c8 * 8, K >> 6)) = v;
  }
  __syncthreads();
}

DI void convert_range(const Params& p, int l, char* smem, int t0, int t1, int tstep) {
  u16* wb = (u16*)(p.ws + OFF_WB) + (size_t)(l & 1) * WB_END;
  constexpr int T_UP = (2 * DFF / 32) * (D / 64);
  constexpr int T_DN = (D / 32) * (DFF / 64);
  constexpr int T_IN = (ZW / 32) * (D / 64);
  constexpr int T_UQ = (1536 / 32) * (384 / 64);
  constexpr int T_UKV = (2048 / 32) * (256 / 64);
  constexpr int T_SQ = (D / 32) * (D / 64);
  constexpr int C1 = T_UP, C2 = C1 + T_DN, C3 = C2 + T_UP, C4 = C3 + T_DN, C5 = C4 + T_IN, C6 = C5 + T_UQ, C7 = C6 + T_UKV,
                C8 = C7 + T_SQ, C9 = C8 + T_SQ, C10 = C9 + T_SQ;
  if (t1 > C10) t1 = C10;
  for (int t = t0; t < t1; t += tstep) {
    if (t < C1) convert_tile(p.w_ff1_up + (size_t)l * D * 2 * DFF, 2 * DFF, D, 1, wb + WB_UP1, t, smem);
    else if (t < C2) convert_tile(p.w_ff1_dn + (size_t)l * DFF * D, D, DFF, 0, wb + WB_DN1, t - C1, smem);
    else if (t < C3) convert_tile(p.w_ff2_up + (size_t)l * D * 2 * DFF, 2 * DFF, D, 1, wb + WB_UP2, t - C2, smem);
    else if (t < C4) convert_tile(p.w_ff2_dn + (size_t)l * DFF * D, D, DFF, 0, wb + WB_DN2, t - C3, smem);
    else if (t < C5) convert_tile(p.w_in + (size_t)l * D * INW, INW, D, 2, wb + WB_IN, t - C4, smem);
    else if (t < C6) convert_tile(p.w_uq + (size_t)l * 384 * 1536, 1536, 384, 0, wb + WB_UQ, t - C5, smem);
    else if (t < C7) convert_tile(p.w_ukv + (size_t)l * 256 * 2048, 2048, 256, 0, wb + WB_UKV, t - C6, smem);
    else if (t < C8) convert_tile(p.w_bm + (size_t)l * D * D, D, D, 0, wb + WB_BM, t - C7, smem);
    else if (t < C9) convert_tile(p.w_ba + (size_t)l * D * D, D, D, 0, wb + WB_BA, t - C8, smem);
    else convert_tile(p.w_out + (size_t)l * D * D, D, D, 0, wb + WB_OUT, t - C9, smem);
  }
}
constexpr int CONV_TILES = 13984;
constexpr int CONV_PER_TASK = 16;
constexpr int NCONV = (CONV_TILES + CONV_PER_TASK - 1) / CONV_PER_TASK;
DI void phase_convert(const Params& p, int l, char* smem, int bid, int nb) { convert_range(p, l, smem, bid, CONV_TILES, nb); }

DI void phase_init(const Params& p, char* smem, int bid, int nb) {
  const int tid = tidx(), lane = tid & 63, wid = tid >> 6;
  {
    const float4* xs = (const float4*)p.x; float4* xd = (float4*)p.out;
    const size_t n4 = (size_t)RL * D / 4;
    for (size_t i = (size_t)bid * 256 + tid; i < n4; i += (size_t)nb * 256) xd[i] = xs[i];
    const float4* cs = (const float4*)p.ctx; float4* cd = (float4*)(p.ws + OFF_XC);
    const size_t m4 = (size_t)RC * D / 4;
    for (size_t i = (size_t)bid * 256 + tid; i < m4; i += (size_t)nb * 256) cd[i] = cs[i];
  }
  {
    float2* tab = (float2*)(p.ws + OFF_ROPE);
    for (int idx = bid * 256 + tid; idx < SEQ * 32; idx += nb * 256) {
      const int t = idx >> 5, i = idx & 31, f = i & 15;
      const float pos = (float)(i < 16 ? (t >> 6) : (t & 63));
      const float inv = powf(10000.f, -(float)(2 * f) / 32.f);
      const float ang = pos * inv;
      tab[idx] = make_float2(cosf(ang), sinf(ang));
    }
  }
  float* sc = (float*)smem;
  float* red = sc + 5 * D;
  for (int i = tid; i < 5 * D; i += 256) {
    const int row = i >> 10, k = i & 1023;
    const float v = row < 4 ? p.c[row * D + k] : p.c_ctx[k];
    sc[i] = siluf(v);
  }
  __syncthreads();
  float* mods = (float*)(p.ws + OFF_MODS);
  constexpr int NG = NMOD * D / 64;
  for (int t = bid; t < NL * NG; t += nb) {
    const int l = t / NG, n = (t - l * NG) * 64 + lane;
    const float* w = p.w_ada + (size_t)l * D * NMOD * D + n;
    float a0 = 0, a1 = 0, a2 = 0, a3 = 0, a4 = 0;
    const int kb = wid * 256;
#pragma unroll 8
    for (int k = 0; k < 256; ++k) {
      const float wv = w[(size_t)(kb + k) * (NMOD * D)];
      a0 += sc[kb + k] * wv; a1 += sc[D + kb + k] * wv; a2 += sc[2 * D + kb + k] * wv; a3 += sc[3 * D + kb + k] * wv; a4 += sc[4 * D + kb + k] * wv;
    }
    red[(wid * 5 + 0) * 64 + lane] = a0; red[(wid * 5 + 1) * 64 + lane] = a1; red[(wid * 5 + 2) * 64 + lane] = a2;
    red[(wid * 5 + 3) * 64 + lane] = a3; red[(wid * 5 + 4) * 64 + lane] = a4;
    __syncthreads();
    for (int i = tid; i < 320; i += 256) {
      const int row = i >> 6, ln = i & 63;
      const int nn = (t - l * NG) * 64 + ln;
      float s = red[(0 * 5 + row) * 64 + ln] + red[(1 * 5 + row) * 64 + ln] + red[(2 * 5 + row) * 64 + ln] + red[(3 * 5 + row) * 64 + ln];
      mods[((size_t)l * 5 + row) * (NMOD * D) + nn] = s + p.b_ada[(size_t)l * NMOD * D + nn];
    }
    __syncthreads();
  }
}

DI void phase_norm(const Params& p, int nrows, const float* __restrict__ g, const float* __restrict__ mods_l, int shift_idx, int scale_idx, u16* __restrict__ an, int bid, int nb) {
  const int tid_ = tidx(), lane = tid_ & 63, wid = tid_ >> 6;
  for (int r = bid * 4 + wid; r < nrows; r += nb * 4) {
    const float* x = xptr(p, r);
    float4 v[4]; float ss = 0.f;
#pragma unroll
    for (int i = 0; i < 4; ++i) { v[i] = *(const float4*)(x + i * 256 + lane * 4); ss += v[i].x * v[i].x + v[i].y * v[i].y + v[i].z * v[i].z + v[i].w * v[i].w; }
    ss = wave_sum(ss);
    const float rstd = rsqrtf(ss * (1.f / D) + EPS);
    const float* md = mods_l + (size_t)modrow(r) * (NMOD * D);
#pragma unroll
    for (int i = 0; i < 4; ++i) {
      const int col = i * 256 + lane * 4;
      const float4 g4 = *(const float4*)(g + col);
      const float4 sh = *(const float4*)(md + shift_idx * D + col);
      const float4 sc = *(const float4*)(md + scale_idx * D + col);
      const float y0 = v[i].x * rstd * g4.x * (1.f + sc.x) + sh.x;
      const float y1 = v[i].y * rstd * g4.y * (1.f + sc.y) + sh.y;
      const float y2 = v[i].z * rstd * g4.z * (1.f + sc.z) + sh.z;
      const float y3 = v[i].w * rstd * g4.w * (1.f + sc.w) + sh.w;
      uint2 o; o.x = pk2(y0, y1); o.y = pk2(y2, y3);
      *(uint2*)(an + bko(r, col, D / 64)) = o;
    }
  }
}

DI void phase_final(const Params& p, int bid, int nb) {
  const int tid_ = tidx(), lane = tid_ & 63, wid = tid_ >> 6;
  for (int r = bid * 4 + wid; r < RL; r += nb * 4) {
    float* x = p.out + (size_t)r * D;
    float4 v[4]; float ss = 0.f;
#pragma unroll
    for (int i = 0; i < 4; ++i) { v[i] = *(const float4*)(x + i * 256 + lane * 4); ss += v[i].x * v[i].x + v[i].y * v[i].y + v[i].z * v[i].z + v[i].w * v[i].w; }
    ss = wave_sum(ss);
    const float rstd = rsqrtf(ss * (1.f / D) + EPS);
#pragma unroll
    for (int i = 0; i < 4; ++i) {
      const int col = i * 256 + lane * 4;
      const float4 g4 = *(const float4*)(p.g_final + col);
      float4 o; o.x = v[i].x * rstd * g4.x; o.y = v[i].y * rstd * g4.y; o.z = v[i].z * rstd * g4.z; o.w = v[i].w * rstd * g4.w;
      *(float4*)(x + col) = o;
    }
  }
}

constexpr int GSTR = 128;
constexpr int GBUF = 128 * GSTR;

#define G_PARAMS uint4 &ra00, uint4 &ra01, uint4 &ra02, uint4 &ra03, uint4 &rb00, uint4 &rb01, uint4 &rb02, uint4 &rb03, \
                 uint4 &ra10, uint4 &ra11, uint4 &ra12, uint4 &ra13, uint4 &rb10, uint4 &rb11, uint4 &rb12, uint4 &rb13
#define G_DECL uint4 g_a00, g_a01, g_a02, g_a03, g_b00, g_b01, g_b02, g_b03, g_a10, g_a11, g_a12, g_a13, g_b10, g_b11, g_b12, g_b13
#define G_ARGS g_a00, g_a01, g_a02, g_a03, g_b00, g_b01, g_b02, g_b03, g_a10, g_a11, g_a12, g_a13, g_b10, g_b11, g_b12, g_b13
#define G_L1(S, i, kt) ra##S##i = *(const uint4*)(ap + (size_t)(kt) * 8192 + i * 2048); rb##S##i = *(const uint4*)(bp + (size_t)(kt) * 8192 + i * 2048);
#define G_LOAD(S, kt) { G_L1(S, 0, kt) G_L1(S, 1, kt) G_L1(S, 2, kt) G_L1(S, 3, kt) }
#define G_S1(S, i, buf) *(uint4*)(sA + (buf) * GBUF + soff + i * 32 * GSTR) = ra##S##i; *(uint4*)(sB + (buf) * GBUF + soff + i * 32 * GSTR) = rb##S##i;
#define G_STORE(S, buf) { G_S1(S, 0, buf) G_S1(S, 1, buf) G_S1(S, 2, buf) G_S1(S, 3, buf) }
DI void gemm_prefetch(G_PARAMS, const u16* __restrict__ A, int lda, const u16* __restrict__ Bt, int ldb, int m0, int n0) {
  const int tid = tidx();
  const int lr = tid >> 3, lc = tid & 7;
  const u16* ap = A + (size_t)((m0 >> 7) * (lda >> 6)) * 8192 + lr * 64 + lc * 8;
  const u16* bp = Bt + (size_t)((n0 >> 7) * (ldb >> 6)) * 8192 + lr * 64 + lc * 8;
  G_LOAD(0, 0)
  G_LOAD(1, 1)
}
DI void gemm_mainloop(G_PARAMS, const u16* __restrict__ A, int lda, const u16* __restrict__ Bt, int ldb, int nk, int m0, int n0, f32x4 (&acc)[4][4], char* smem) {
  const int tid = tidx(), lane = tid & 63, wid = tid >> 6, wr = wid >> 1, wc = wid & 1;
  const int lr = tid >> 3, lc = tid & 7;
  const u16* ap = A + (size_t)((m0 >> 7) * (lda >> 6)) * 8192 + lr * 64 + lc * 8;
  const u16* bp = Bt + (size_t)((n0 >> 7) * (ldb >> 6)) * 8192 + lr * 64 + lc * 8;
#define G_COMPUTE(buf) { const char* cA = sA + (buf) * GBUF; const char* cB = sB + (buf) * GBUF; \
    _Pragma("unroll") for (int ks = 0; ks < 2; ++ks) { \
      bf16x8 a[4], b[4]; \
      _Pragma("unroll") for (int m = 0; m < 4; ++m) a[m] = *(const bf16x8*)(cA + (aoff ^ (ks * 64)) + m * 16 * GSTR); \
      _Pragma("unroll") for (int n = 0; n < 4; ++n) b[n] = *(const bf16x8*)(cB + (boff ^ (ks * 64)) + n * 16 * GSTR); \
      _Pragma("unroll") for (int m = 0; m < 4; ++m) _Pragma("unroll") for (int n = 0; n < 4; ++n) acc[m][n] = MFMA16(b[n], a[m], acc[m][n]); \
    } }
  char* sA = smem; char* sB = smem + 2 * GBUF;
  const int soff = lr * GSTR + ((lc ^ ((lr >> 1) & 7)) << 4);
  const int fr = lane & 15, fq = lane >> 4;
  const int swz = (fq ^ ((fr >> 1) & 7)) << 4;
  const int aoff = (wr * 64 + fr) * GSTR + swz;
  const int boff = (wc * 64 + fr) * GSTR + swz;
  uint4 ra20, ra21, ra22, ra23, rb20, rb21, rb22, rb23;
  if (2 < nk) G_LOAD(2, 2)
  G_STORE(0, 0)
  __syncthreads();
  if (3 < nk) G_LOAD(0, 3)
#define G_STEP(i, SN, BN) if (kt + (i) < nk) { \
    G_COMPUTE((i) & 1) \
    if (kt + (i) + 1 < nk) G_STORE(SN, BN) \
    __syncthreads(); \
    if (kt + (i) + 4 < nk) G_LOAD(SN, kt + (i) + 4) }
  for (int kt = 0; kt < nk; kt += 6) {
    G_STEP(0, 1, 1)
    G_STEP(1, 2, 0)
    G_STEP(2, 0, 1)
    G_STEP(3, 1, 0)
    G_STEP(4, 2, 1)
    G_STEP(5, 0, 0)
  }
#undef G_STEP
#undef G_COMPUTE
}
#undef G_L1
#undef G_S1
#undef G_LOAD
#undef G_STORE

DI int vbid(int bid, int nb) { return bid; }
DI void tile_of(int tile, int ntn, int& mt, int& nt) {
  const int gm = tile / (8 * ntn), rem = tile - gm * 8 * ntn;
  nt = rem >> 3; mt = gm * 8 + (rem & 7);
}
#define ZERO_ACC(acc) _Pragma("unroll") for (int m_ = 0; m_ < 4; ++m_) _Pragma("unroll") for (int n_ = 0; n_ < 4; ++n_) acc[m_][n_] = f32x4{0.f, 0.f, 0.f, 0.f}

constexpr int ST16 = 272;
constexpr int ST32 = 528;
DI void stage_bf16(const f32x4 (&acc)[4][4], char* st, int wr, int wc, int fr, int fq) {
#pragma unroll
  for (int m = 0; m < 4; ++m)
#pragma unroll
    for (int n = 0; n < 4; ++n) {
      uint2 v; v.x = pk2(acc[m][n][0], acc[m][n][1]); v.y = pk2(acc[m][n][2], acc[m][n][3]);
      *(uint2*)(st + (wr * 64 + 16 * m + fr) * ST16 + (wc * 64 + 16 * n + 4 * fq) * 2) = v;
    }
}
DI void stage_f32(const f32x4 (&acc)[4][4], char* st, int wr, int wc, int fr, int fq) {
#pragma unroll
  for (int m = 0; m < 4; ++m)
#pragma unroll
    for (int n = 0; n < 4; ++n) *(f32x4*)(st + (wr * 64 + 16 * m + fr) * ST32 + (wc * 64 + 16 * n + 4 * fq) * 4) = acc[m][n];
}

DI void phase_ffn_up(const Params& p, int mtn, const u16* an, const u16* wt, u16* h, char* smem, int bid, int nb) {
  constexpr int NTN = 2 * DFF / 128;
  G_DECL;
  { int tile = vbid(bid, nb); if (tile < mtn * NTN) { int mt, nt; tile_of(tile, NTN, mt, nt); gemm_prefetch(G_ARGS, an, D, wt, D, mt * 128, nt * 128); } }
  for (int tile = vbid(bid, nb); tile < mtn * NTN; tile += nb) {
    int mt, nt; tile_of(tile, NTN, mt, nt);
    f32x4 acc[4][4]; ZERO_ACC(acc);
    gemm_mainloop(G_ARGS, an, D, wt, D, D / 64, mt * 128, nt * 128, acc, smem);
    if (tile + nb < mtn * NTN) { int mt2, nt2; tile_of(tile + nb, NTN, mt2, nt2); gemm_prefetch(G_ARGS, an, D, wt, D, mt2 * 128, nt2 * 128); }
    const int tid = tidx(), lane = tid & 63, wid = tid >> 6, wr = wid >> 1, wc = wid & 1, fr = lane & 15, fq = lane >> 4;
#pragma unroll
    for (int m = 0; m < 4; ++m)
#pragma unroll
      for (int n = 0; n < 2; ++n) {
        float o[4];
#pragma unroll
        for (int r = 0; r < 4; ++r) o[r] = siluf(acc[m][n][r]) * acc[m][n + 2][r];
        uint2 v; v.x = pk2(o[0], o[1]); v.y = pk2(o[2], o[3]);
        *(uint2*)(smem + (wr * 64 + 16 * m + fr) * ST16 + (wc * 32 + 16 * n + 4 * fq) * 2) = v;
      }
    __syncthreads();
    const unsigned rbase = mt * 128, cbase = nt * 64;
#pragma unroll
    for (int i = 0; i < 4; ++i) {
      const unsigned id = tid + 256 * i, row = id >> 3, ch = id & 7;
      const uint4 v = *(const uint4*)(smem + row * ST16 + ch * 16);
      *(uint4*)(h + bko(rbase + row, cbase + ch * 8, DFF / 64)) = v;
    }
    __syncthreads();
  }
}

DI void phase_gemm_resid(const Params& p, int mtn, const u16* a, int K, const u16* wt, const float* mods_l, int gate_idx, float coef, char* smem, int bid, int nb) {
  constexpr int NTN = D / 128;
  G_DECL;
  { int tile = vbid(bid, nb); if (tile < mtn * NTN) { int mt, nt; tile_of(tile, NTN, mt, nt); gemm_prefetch(G_ARGS, a, K, wt, K, mt * 128, nt * 128); } }
  for (int tile = vbid(bid, nb); tile < mtn * NTN; tile += nb) {
    int mt, nt; tile_of(tile, NTN, mt, nt);
    f32x4 acc[4][4]; ZERO_ACC(acc);
    gemm_mainloop(G_ARGS, a, K, wt, K, K / 64, mt * 128, nt * 128, acc, smem);
    if (tile + nb < mtn * NTN) { int mt2, nt2; tile_of(tile + nb, NTN, mt2, nt2); gemm_prefetch(G_ARGS, a, K, wt, K, mt2 * 128, nt2 * 128); }
    const int tid = tidx(), lane = tid & 63, wid = tid >> 6, wr = wid >> 1, wc = wid & 1, fr = lane & 15, fq = lane >> 4;
    stage_f32(acc, smem, wr, wc, fr, fq);
    __syncthreads();
    const int r0 = mt * 128;
    const float* md = mods_l + (size_t)modrow(r0) * (NMOD * D) + gate_idx * D + nt * 128;
    float* xb = xptr(p, r0) + nt * 128;
    const unsigned ch = tid & 31;
    const float4 g4 = *(const float4*)(md + ch * 4);
#pragma unroll 4
    for (int i = 0; i < 16; ++i) {
      const unsigned row = (tid >> 5) + 8 * i;
      const float4 v = *(const float4*)(smem + row * ST32 + ch * 16);
      float4* xp = (float4*)(xb + row * (unsigned)D + ch * 4);
      float4 x = *xp;
      x.x += coef * g4.x * v.x; x.y += coef * g4.y * v.y; x.z += coef * g4.z * v.z; x.w += coef * g4.w * v.w;
      *xp = x;
    }
    __syncthreads();
  }
}

DI void phase_inproj(const Params& p, int l, const u16* an, const u16* wt, char* smem, int bid, int nb) {
  constexpr int NTN = ZW / 128;
  char* ws = p.ws;
  G_DECL;
  { int tile = vbid(bid, nb); if (tile < MT * NTN) { int mt, nt; tile_of(tile, NTN, mt, nt); gemm_prefetch(G_ARGS, an, D, wt, D, mt * 128, nt * 128); } }
  for (int tile = vbid(bid, nb); tile < MT * NTN; tile += nb) {
    int mt, nt; tile_of(tile, NTN, mt, nt);
    f32x4 acc[4][4]; ZERO_ACC(acc);
    gemm_mainloop(G_ARGS, an, D, wt, D, D / 64, mt * 128, nt * 128, acc, smem);
    if (tile + nb < MT * NTN) { int mt2, nt2; tile_of(tile + nb, NTN, mt2, nt2); gemm_prefetch(G_ARGS, an, D, wt, D, mt2 * 128, nt2 * 128); }
    const int tid = tidx(), lane = tid & 63, wid = tid >> 6, wr = wid >> 1, wc = wid & 1, fr = lane & 15, fq = lane >> 4;
    if (nt == 37) {
      if (wc == 0) {
        u16* zkr = (u16*)(ws + OFF_ZKR);
#pragma unroll
        for (int m = 0; m < 4; ++m)
#pragma unroll
          for (int n = 0; n < 4; ++n) {
            const unsigned row = mt * 128 + wr * 64 + 16 * m + fr;
            uint2 v; v.x = pk2(acc[m][n][0], acc[m][n][1]); v.y = pk2(acc[m][n][2], acc[m][n][3]);
            *(uint2*)(zkr + row * 64u + 16 * n + 4 * fq) = v;
          }
      } else {
        float* zg = (float*)(ws + OFF_ZG);
        const float4 b4 = *(const float4*)(p.b_gate + l * 16 + 4 * fq);
#pragma unroll
        for (int m = 0; m < 4; ++m) {
          const unsigned row = mt * 128 + wr * 64 + 16 * m + fr;
          float4 v; v.x = acc[m][0][0] + b4.x; v.y = acc[m][0][1] + b4.y; v.z = acc[m][0][2] + b4.z; v.w = acc[m][0][3] + b4.w;
          *(float4*)(zg + row * 16u + 4 * fq) = v;
        }
      }
      continue;
    }
    stage_bf16(acc, smem, wr, wc, fr, fq);
    __syncthreads();
    const int c = nt * 128;
    u16* dst; unsigned ld, c0;
    if (c < 4096) { dst = (u16*)(ws + OFF_ZQ) + (size_t)(c >> 10) * R * D; ld = D; c0 = c & 1023; }
    else if (c < 4480) { dst = (u16*)(ws + OFF_ZCQ); ld = 384; c0 = c - 4096; }
    else if (c < 4736) { dst = (u16*)(ws + OFF_ZCKV); ld = 256; c0 = c - 4480; }
    else { dst = (u16*)(ws + OFF_ZBR); ld = 2048; c0 = c - 4864; }
    const unsigned rbase = mt * 128;
#pragma unroll
    for (int i = 0; i < 8; ++i) {
      const unsigned id = tid + 256 * i, row = id >> 4, ch = id & 15;
      const uint4 v = *(const uint4*)(smem + row * ST16 + ch * 16);
      *(uint4*)(dst + (rbase + row) * ld + c0 + ch * 8) = v;
    }
    __syncthreads();
  }
}

DI void phase_prep(const Params& p, int l, int bid, int nb) {
  const int tid_ = tidx(), lane = tid_ & 63, wid = tid_ >> 6;
  char* ws = p.ws;
  const u16* zq = (const u16*)(ws + OFF_ZQ); const u16* zk = (const u16*)(ws + OFF_ZK);
  u16* qc = (u16*)(ws + OFF_AN); u16* kc = (u16*)(ws + OFF_KC);
  const float* wcv = p.w_conv + (size_t)l * 3 * 2048;
  const float2* tab = (const float2*)(ws + OFF_ROPE);
  for (int r = bid * 4 + wid; r < R; r += nb * 4) {
    int t, T;
    if (r < RL) { t = r & 4095; T = SEQ; } else { t = (r - RL) & 255; T = CTX; }
    const bool hp = t > 0, hn = t < T - 1;
#pragma unroll
    for (int c4 = 0; c4 < 4; ++c4) {
      const int ch = c4 * 512 + lane * 8;
      const bool isq = ch < 1024;
      const u16* src = isq ? zq : zk;
      const int cc = isq ? ch : ch - 1024;
      const uint4 zero = make_uint4(0, 0, 0, 0);
      const uint4 vc = *(const uint4*)(src + (size_t)r * D + cc);
      const uint4 vp = hp ? *(const uint4*)(src + (size_t)(r - 1) * D + cc) : zero;
      const uint4 vn = hn ? *(const uint4*)(src + (size_t)(r + 1) * D + cc) : zero;
      const unsigned pc[4] = {vc.x, vc.y, vc.z, vc.w}, pp[4] = {vp.x, vp.y, vp.z, vp.w}, pn[4] = {vn.x, vn.y, vn.z, vn.w};
      float o[8];
#pragma unroll
      for (int e = 0; e < 8; ++e) {
        const int sh = (e & 1) * 16;
        const float xc = bf2f((u16)(pc[e >> 1] >> sh)), xp = bf2f((u16)(pp[e >> 1] >> sh)), xn = bf2f((u16)(pn[e >> 1] >> sh));
        const float w0 = wcv[ch + e], w1 = wcv[2048 + ch + e], w2 = wcv[4096 + ch + e];
        float y = siluf(xp * w0 + xc * w1 + xn * w2);
        o[e] = isq ? y * 0.0625f : y;
      }
      uint4 ov; ov.x = pk2(o[0], o[1]); ov.y = pk2(o[2], o[3]); ov.z = pk2(o[4], o[5]); ov.w = pk2(o[6], o[7]);
      *(uint4*)((isq ? qc : kc) + (size_t)r * D + cc) = ov;
    }
    {
      const u16* z = (const u16*)(ws + OFF_ZCQ) + (size_t)r * 384;
      float v[6]; float ss = 0.f;
#pragma unroll
      for (int i = 0; i < 6; ++i) { v[i] = bf2f(z[lane + 64 * i]); ss += v[i] * v[i]; }
      ss = wave_sum(ss);
      const float rstd = rsqrtf(ss * (1.f / 384.f) + EPS);
      u16* o = (u16*)(ws + OFF_CQN);
#pragma unroll
      for (int i = 0; i < 6; ++i) o[bko(r, lane + 64 * i, 6)] = f2bf(v[i] * rstd * p.g_qa[l * 384 + lane + 64 * i]);
    }
    {
      const u16* z = (const u16*)(ws + OFF_ZCKV) + (size_t)r * 256;
      float v[4]; float ss = 0.f;
#pragma unroll
      for (int i = 0; i < 4; ++i) { v[i] = bf2f(z[lane + 64 * i]); ss += v[i] * v[i]; }
      ss = wave_sum(ss);
      const float rstd = rsqrtf(ss * (1.f / 256.f) + EPS);
      u16* o = (u16*)(ws + OFF_CKVN);
#pragma unroll
      for (int i = 0; i < 4; ++i) o[bko(r, lane + 64 * i, 4)] = f2bf(v[i] * rstd * p.g_kva[l * 256 + lane + 64 * i]);
    }
    {
      const float v = bf2f(((const u16*)(ws + OFF_ZKR))[(size_t)r * 64 + lane]);
      const float pv = __shfl_xor(v, 1);
      float o = v;
      if (r < RL) {
        const float2 cs = tab[t * 32 + (lane >> 1)];
        o = (lane & 1) ? (pv * cs.y + v * cs.x) : (v * cs.x - pv * cs.y);
      }
      ((u16*)(ws + OFF_KROPE))[(size_t)r * 64 + lane] = f2bf(o);
    }
  }
  {
    const float* zg = (const float*)(ws + OFF_ZG);
    for (int item = bid * 4 + wid; item < 32 * NCH; item += nb * 4) {
      const int stream = item / NCH, n = item - stream * NCH;
      const int b = stream >> 3, hd = (stream >> 1) & 3, dir = stream & 1;
      int base, T, cc;
      if (n < 4) { base = RL + b * CTX; T = CTX; cc = n; } else { base = b * SEQ; T = SEQ; cc = n - 4; }
      const int pos = cc * 64 + lane;
      const int row = base + (dir ? T - 1 - pos : pos);
      const float ig = zg[(size_t)row * 16 + dir * 8 + hd];
      const float fg = zg[(size_t)row * 16 + dir * 8 + 4 + hd];
      const float lf = fminf(fg, 0.f) - log1pf(__expf(-fabsf(fg)));
      float bc = lf;
#pragma unroll
      for (int d = 1; d < 64; d <<= 1) { const float tt = __shfl_up(bc, d); if (lane >= d) bc += tt; }
      const float bL = __shfl(bc, 63);
      const float wv = ig - bc;
      float pm = wv;
#pragma unroll
      for (int d = 1; d < 64; d <<= 1) { const float tt = __shfl_up(pm, d); if (lane >= d) pm = fmaxf(pm, tt); }
      const float endl = bL + wv;
      const float me = wave_max(endl);
      float* g = (float*)(ws + OFF_G) + ((size_t)stream * NCH + n) * 512;
      g[lane] = bc; g[64 + lane] = wv; g[128 + lane] = pm; g[192 + lane] = endl;
      if (lane == 0) { g[256] = bL; g[257] = me; }
    }
  }
}

DI void phase_upproj(const Params& p, const u16* wb, char* smem, int bid, int nb) {
  char* ws = p.ws;
  const float2* tab = (const float2*)(ws + OFF_ROPE);
  u16* qa = (u16*)(ws + OFF_H);
  u16* kv = (u16*)(ws + OFF_KV);
  constexpr int NQ = 12, NKV = 16;
  const int total = MT * (NQ + NKV);
  G_DECL;
#define UP_PREFETCH(T) { const int t_ = (T); if (t_ < MT * NQ) { int m_, n_; tile_of(t_, NQ, m_, n_); gemm_prefetch(G_ARGS, (const u16*)(ws + OFF_CQN), 384, wb + WB_UQ, 384, m_ * 128, n_ * 128); } \
    else if (t_ < total) { int m_, n_; tile_of(t_ - MT * NQ, NKV, m_, n_); gemm_prefetch(G_ARGS, (const u16*)(ws + OFF_CKVN), 256, wb + WB_UKV, 256, m_ * 128, n_ * 128); } }
  for (int tile = vbid(bid, nb); tile < total; tile += nb) {
    const bool isq = tile < MT * NQ;
    int mt, nt;
    f32x4 acc[4][4]; ZERO_ACC(acc);
    UP_PREFETCH(tile)
    if (isq) { tile_of(tile, NQ, mt, nt); gemm_mainloop(G_ARGS, (const u16*)(ws + OFF_CQN), 384, wb + WB_UQ, 384, 6, mt * 128, nt * 128, acc, smem); }
    else { tile_of(tile - MT * NQ, NKV, mt, nt); gemm_mainloop(G_ARGS, (const u16*)(ws + OFF_CKVN), 256, wb + WB_UKV, 256, 4, mt * 128, nt * 128, acc, smem); }
    const int tid = tidx(), lane = tid & 63, wid = tid >> 6, wr = wid >> 1, wc = wid & 1, fr = lane & 15, fq = lane >> 4;
    stage_bf16(acc, smem, wr, wc, fr, fq);
    __syncthreads();
    const unsigned rbase = mt * 128;
    if (isq) {
#pragma unroll
      for (int i = 0; i < 8; ++i) {
        const unsigned id = tid + 256 * i, row = id >> 4, ch = id & 15;
        uint4 v = *(const uint4*)(smem + row * ST16 + ch * 16);
        const unsigned col = nt * 128 + ch * 8, d0 = col % 192u, grow = rbase + row;
        if (d0 >= 128u && grow < (unsigned)RL) {
          const float4* tp = (const float4*)(tab + (grow & 4095u) * 32u + ((d0 - 128u) >> 1));
          const float4 t0 = tp[0], t1 = tp[1];
          float x0, x1;
          x0 = bf2f((u16)(v.x & 0xffff)); x1 = bf2f((u16)(v.x >> 16)); v.x = pk2(x0 * t0.x - x1 * t0.y, x0 * t0.y + x1 * t0.x);
          x0 = bf2f((u16)(v.y & 0xffff)); x1 = bf2f((u16)(v.y >> 16)); v.y = pk2(x0 * t0.z - x1 * t0.w, x0 * t0.w + x1 * t0.z);
          x0 = bf2f((u16)(v.z & 0xffff)); x1 = bf2f((u16)(v.z >> 16)); v.z = pk2(x0 * t1.x - x1 * t1.y, x0 * t1.y + x1 * t1.x);
          x0 = bf2f((u16)(v.w & 0xffff)); x1 = bf2f((u16)(v.w >> 16)); v.w = pk2(x0 * t1.z - x1 * t1.w, x0 * t1.w + x1 * t1.z);
        }
        *(uint4*)(qa + grow * 1536u + col) = v;
      }
    } else {
#pragma unroll
      for (int i = 0; i < 8; ++i) {
        const unsigned id = tid + 256 * i, row = id >> 4, ch = id & 15;
        const uint4 v = *(const uint4*)(smem + row * ST16 + ch * 16);
        *(uint4*)(kv + (rbase + row) * 2048u + nt * 128 + ch * 8) = v;
      }
    }
    __syncthreads();
  }
#undef UP_PREFETCH
}

constexpr int AKS = 400;
constexpr int AVS = 320;
DI void attn_task(const Params& p, int b, int h, int qrow0, int nkt, bool with_latent, char* smem) {
  const int tid = tidx(), lane = tid & 63, wid = tid >> 6, l31 = lane & 31, h2 = lane >> 5;
  char* ws = p.ws;
  const u16* qa = (const u16*)(ws + OFF_H);
  const u16* kvb = (const u16*)(ws + OFF_KV);
  const u16* krp = (const u16*)(ws + OFF_KROPE);
  u16* ao = (u16*)(ws + OFF_H) + (size_t)R * 1536;
  char* Ks = smem; char* Vs = smem + 64 * AKS;
  bf16x8 qf[12];
  {
    const u16* qp = qa + (size_t)(qrow0 + wid * 32 + l31) * 1536 + h * 192 + h2 * 8;
#pragma unroll
    for (int st = 0; st < 12; ++st) qf[st] = *(const bf16x8*)(qp + st * 16);
  }
  uint4 kreg0, kreg1, kreg2, kreg3, kreg4, kreg5, vreg0, vreg1, vreg2, vreg3;
#define KEY_ROW(kt, i) ((kt) < 4 ? (RL + b * CTX + (kt) * 64 + (i)) : (b * SEQ + ((kt) - 4) * 64 + (i)))
#define ATT_KL(kt, i) { const int id = tid + 256 * i, row = id / 24, ch = id - row * 24; const int kr = KEY_ROW(kt, row); \
    const u16* src = ch < 16 ? (kvb + (size_t)kr * 2048 + h * 256 + ch * 8) : (krp + (size_t)kr * 64 + (ch - 16) * 8); kreg##i = *(const uint4*)src; }
#define ATT_VL(kt, i) { const int id = tid + 256 * i, row = id >> 4, ch = id & 15; const int kr = KEY_ROW(kt, row); \
    vreg##i = *(const uint4*)(kvb + (size_t)kr * 2048 + h * 256 + 128 + ch * 8); }
#define ATT_GLOADK(kt) ATT_KL(kt, 0) ATT_KL(kt, 1) ATT_KL(kt, 2) ATT_KL(kt, 3) ATT_KL(kt, 4) ATT_KL(kt, 5)
#define ATT_GLOADV(kt) ATT_VL(kt, 0) ATT_VL(kt, 1) ATT_VL(kt, 2) ATT_VL(kt, 3)
#define ATT_GLOAD(kt) ATT_GLOADK(kt) ATT_GLOADV(kt)
#define ATT_KS(i) { const int id = tid + 256 * i, row = id / 24, ch = id - row * 24; *(uint4*)(Ks + row * AKS + ch * 16) = kreg##i; }
#define ATT_VS(i) { const int id = tid + 256 * i, row = id >> 4, ch = id & 15; *(uint4*)(Vs + row * AVS + ch * 16) = vreg##i; }
#define ATT_SSTORE() ATT_KS(0) ATT_KS(1) ATT_KS(2) ATT_KS(3) ATT_KS(4) ATT_KS(5) ATT_VS(0) ATT_VS(1) ATT_VS(2) ATT_VS(3)
  f32x16 o[4];
#pragma unroll
  for (int n = 0; n < 4; ++n)
#pragma unroll
    for (int i = 0; i < 16; ++i) o[n][i] = 0.f;
  float mrun = -1e30f, lrun = 0.f;
  const float sc = 0.07216878364870322f * 1.4426950408889634f;
  const int i16 = lane & 15, tq = i16 >> 2, tp = i16 & 3, blk = (lane >> 4) & 1;
  ATT_GLOAD(0)
  __syncthreads();
  ATT_SSTORE()
  __syncthreads();
  for (int kt = 0; kt < nkt; ++kt) {
    if (kt + 1 < nkt) { ATT_GLOADK(kt + 1) }
    f32x16 s0, s1;
#pragma unroll
    for (int i = 0; i < 16; ++i) { s0[i] = 0.f; s1[i] = 0.f; }
#pragma unroll
    for (int st = 0; st < 12; ++st) {
      const bf16x8 a0 = *(const bf16x8*)(Ks + l31 * AKS + st * 32 + h2 * 16);
      const bf16x8 a1 = *(const bf16x8*)(Ks + (32 + l31) * AKS + st * 32 + h2 * 16);
      s0 = MFMA32(a0, qf[st], s0);
      s1 = MFMA32(a1, qf[st], s1);
      if ((st & 3) == 3) __builtin_amdgcn_sched_barrier(0);
    }
    float mx = s0[0];
#pragma unroll
    for (int i = 0; i < 16; ++i) { mx = fmaxf(mx, s0[i]); mx = fmaxf(mx, s1[i]); }
    mx = fmaxf(mx, __shfl_xor(mx, 32));
    const float mnew = fmaxf(mrun, mx * sc);
    const float alpha = __builtin_amdgcn_exp2f(mrun - mnew);
    mrun = mnew;
    float ls = 0.f;
#pragma unroll
    for (int i = 0; i < 16; ++i) { s0[i] = __builtin_amdgcn_exp2f(s0[i] * sc - mnew); s1[i] = __builtin_amdgcn_exp2f(s1[i] * sc - mnew); ls += s0[i] + s1[i]; }
    lrun = lrun * alpha + ls;
    if (__any(alpha != 1.f)) {
#pragma unroll
      for (int n = 0; n < 4; ++n)
#pragma unroll
        for (int i = 0; i < 16; ++i) o[n][i] *= alpha;
    }
    bf16x8 pbv[4];
#define ATT_PACK(SV, HH) \
    _Pragma("unroll") for (int s = 0; s < 2; ++s) { \
      u32x4 pu; \
      pu[0] = pk2(SV[8 * s + 0], SV[8 * s + 1]); pu[1] = pk2(SV[8 * s + 2], SV[8 * s + 3]); \
      pu[2] = pk2(SV[8 * s + 4], SV[8 * s + 5]); pu[3] = pk2(SV[8 * s + 6], SV[8 * s + 7]); \
      pbv[2 * HH + s] = __builtin_bit_cast(bf16x8, pu); \
    }
    ATT_PACK(s0, 0)
    ATT_PACK(s1, 1)
#undef ATT_PACK
    if (kt + 1 < nkt) { ATT_GLOADV(kt + 1) }
#pragma unroll
    for (int hs = 0; hs < 4; ++hs) {
      const char* vlo = Vs + (16 * hs + 4 * h2 + tq) * AVS + (16 * blk) * 2 + 8 * tp;
#pragma unroll
      for (int n = 0; n < 4; ++n) {
        const bf16x8 va = tr8(vlo + n * 64, vlo + n * 64 + 8 * AVS);
        o[n] = MFMA32(va, pbv[hs], o[n]);
      }
    }
    __syncthreads();
    if (kt + 1 < nkt) { ATT_SSTORE() }
    __syncthreads();
  }
  const float ltot = lrun + __shfl_xor(lrun, 32);
  const float inv = 1.f / ltot;
  const unsigned orow = qrow0 + wid * 32 + l31;
#pragma unroll
  for (int n = 0; n < 4; ++n)
#pragma unroll
    for (int g = 0; g < 4; ++g) {
      uint2 w; w.x = pk2(o[n][4 * g] * inv, o[n][4 * g + 1] * inv); w.y = pk2(o[n][4 * g + 2] * inv, o[n][4 * g + 3] * inv);
      *(uint2*)(ao + bko(orow, h * 128 + 32 * n + 8 * g + 4 * h2, D / 64)) = w;
    }
}

constexpr int MKS = 528;
constexpr int MVS = 112;
constexpr int M_CT = 64 * MKS;
constexpr int M_VS = M_CT + 48 * MKS;
constexpr int M_VW = M_VS + 64 * MVS;
constexpr int M_GS = 73728;
constexpr int M_MS = M_GS + 1536;
DI void mlstm_task(const Params& p, int task, char* smem) {
  const int tid = tidx(), lane = tid & 63, w = tid >> 6, fr = lane & 15, fq = lane >> 4, tq = fr >> 2, tp = fr & 3;
  const int stream = task >> 3, c = task & 7, b = stream >> 3, hd = (stream >> 1) & 3, dir = stream & 1;
  char* ws = p.ws;
  const u16* qc = (const u16*)(ws + OFF_AN); const u16* kc = (const u16*)(ws + OFF_KC); const u16* zv = (const u16*)(ws + OFF_ZV);
  const float* G = (const float*)(ws + OFF_G) + (size_t)stream * NCH * 512;
  _Float16* hout = (_Float16*)(ws + (dir ? OFF_ZK : OFF_ZQ));
  char* Ks = smem; char* Ct = smem + M_CT; char* Vs = smem + M_VS; char* Vw = smem + M_VW;
#define ROW_OF(n, pos) ((n) < 4 ? (RL + b * CTX + (dir ? CTX - 1 - ((n) * 64 + (pos)) : ((n) * 64 + (pos)))) : (b * SEQ + (dir ? SEQ - 1 - (((n) - 4) * 64 + (pos)) : (((n) - 4) * 64 + (pos)))))
  __syncthreads();
  for (int i = tid; i < 48 * MKS / 16; i += 256) ((uint4*)Ct)[i] = make_uint4(0, 0, 0, 0);
  f32x4 cacc[4][3];
#pragma unroll
  for (int kt = 0; kt < 4; ++kt)
#pragma unroll
    for (int vt = 0; vt < 3; ++vt) cacc[kt][vt] = f32x4{0.f, 0.f, 0.f, 0.f};
  uint4 kreg0, kreg1, kreg2, kreg3, kreg4, kreg5, kreg6, kreg7; uint4 vreg; float wreg; float4 greg = make_float4(0.f, 0.f, 0.f, 0.f);
#define M_KL(n, i) { const int id = tid + 256 * i, row = id >> 5, ch = id & 31; kreg##i = *(const uint4*)(kc + (size_t)ROW_OF(n, row) * D + hd * 256 + ch * 8); }
#define M_GLOAD(n) { M_KL(n, 0) M_KL(n, 1) M_KL(n, 2) M_KL(n, 3) M_KL(n, 4) M_KL(n, 5) M_KL(n, 6) M_KL(n, 7) \
    const int row_ = tid >> 2, part_ = tid & 3; \
    vreg = *(const uint4*)(zv + (size_t)ROW_OF(n, row_) * D + hd * 256 + c * 32 + part_ * 8); \
    wreg = G[(size_t)(n) * 512 + 192 + row_]; \
    if (tid < 64) { greg.x = G[(size_t)(n) * 512 + tid]; greg.y = G[(size_t)(n) * 512 + 64 + tid]; greg.z = G[(size_t)(n) * 512 + 128 + tid]; greg.w = G[(size_t)(n) * 512 + 192 + tid]; } }
#define M_KS(i) { const int id = tid + 256 * i, row = id >> 5, ch = id & 31; *(uint4*)(Ks + row * MKS + ch * 16) = kreg##i; }
#define M_SSTORE(n) { M_KS(0) M_KS(1) M_KS(2) M_KS(3) M_KS(4) M_KS(5) M_KS(6) M_KS(7) \
    const int row = tid >> 2, part = tid & 3; \
    const float mp_ = ((const float*)(smem + M_MS))[136 + (n)], mn_ = ((const float*)(smem + M_MS))[204 + (n)]; \
    if (tid < 64) { float* gs_ = (float*)(smem + M_GS); const float mj_ = fmaxf(greg.x + mp_, greg.x + greg.z); \
      gs_[tid] = greg.x - mj_; gs_[64 + tid] = greg.y; gs_[128 + tid] = __expf(greg.x + mp_ - mj_); gs_[192 + tid] = __expf(-mj_); gs_[256 + tid] = __expf(greg.w - mn_); \
      if (tid == 0) gs_[320] = __expf(((const float*)(smem + M_MS))[(n)] + mp_ - mn_); } \
    wreg = __expf(wreg - mn_); \
    *(uint4*)(Vs + row * MVS + part * 16) = vreg; \
    uint4 wv; \
    wv.x = pk2(bf2f((u16)(vreg.x & 0xffff)) * wreg, bf2f((u16)(vreg.x >> 16)) * wreg); \
    wv.y = pk2(bf2f((u16)(vreg.y & 0xffff)) * wreg, bf2f((u16)(vreg.y >> 16)) * wreg); \
    wv.z = pk2(bf2f((u16)(vreg.z & 0xffff)) * wreg, bf2f((u16)(vreg.z >> 16)) * wreg); \
    wv.w = pk2(bf2f((u16)(vreg.w & 0xffff)) * wreg, bf2f((u16)(vreg.w >> 16)) * wreg); \
    *(uint4*)(Vw + row * MVS + part * 16) = wv; \
    if (part == 0) { \
      *(uint4*)(Vs + row * MVS + 64) = make_uint4(0x3f80u, 0, 0, 0); \
      *(uint4*)(Vs + row * MVS + 80) = make_uint4(0, 0, 0, 0); \
      *(uint4*)(Vw + row * MVS + 64) = make_uint4((unsigned)f2bf(wreg), 0, 0, 0); \
      *(uint4*)(Vw + row * MVS + 80) = make_uint4(0, 0, 0, 0); \
    } }
#define M_QLOAD(n) { \
    const u16* qp = qc + (size_t)ROW_OF(n, 16 * w + fr) * D + hd * 256 + fq * 8; \
    _Pragma("unroll") for (int ks = 0; ks < 8; ++ks) qf[ks] = *(const bf16x8*)(qp + ks * 32); }
  bf16x8 qf[8];
  M_GLOAD(0) M_QLOAD(0)
  {
    float* ms = (float*)(smem + M_MS);
    if (tid < NCH) { ms[tid] = G[(size_t)tid * 512 + 256]; ms[68 + tid] = G[(size_t)tid * 512 + 257]; }
    __syncthreads();
    if (tid == 0) { float m = 0.f; for (int i = 0; i < NCH; ++i) { const float mn = fmaxf(ms[i] + m, ms[68 + i]); ms[136 + i] = m; ms[204 + i] = mn; m = mn; } }
    __syncthreads();
  }
  M_SSTORE(0)
  __syncthreads();
  for (int n = 0; n < NCH; ++n) {
    const bool more = n + 1 < NCH;
    if (more) M_GLOAD(n + 1)
    const float* g = (const float*)(smem + M_GS);
    const int jpos = 16 * w + fr;
    const float u_j = g[jpos], e_j = g[128 + jpos], rd_j = g[192 + jpos];
    const float a_state = g[320];
    f32x4 xs[4];
#pragma unroll
    for (int st = 0; st < 4; ++st) {
      xs[st] = f32x4{0.f, 0.f, 0.f, 0.f};
      if (st <= w) {
#pragma unroll
        for (int ks = 0; ks < 8; ++ks) {
          const bf16x8 a = *(const bf16x8*)(Ks + (16 * st + fr) * MKS + ks * 64 + fq * 16);
          xs[st] = MFMA16(a, qf[ks], xs[st]);
        }
        const float4 wv4 = *(const float4*)(g + 64 + 16 * st + 4 * fq);
        const int sb = 16 * st + 4 * fq;
        xs[st][0] *= (sb + 0 <= jpos) ? __expf(u_j + wv4.x) : 0.f;
        xs[st][1] *= (sb + 1 <= jpos) ? __expf(u_j + wv4.y) : 0.f;
        xs[st][2] *= (sb + 2 <= jpos) ? __expf(u_j + wv4.z) : 0.f;
        xs[st][3] *= (sb + 3 <= jpos) ? __expf(u_j + wv4.w) : 0.f;
      }
    }
    bf16x8 pb[2];
#pragma unroll
    for (int u = 0; u < 2; ++u) {
      u32x4 pu;
      pu[0] = pk2(xs[2 * u][0], xs[2 * u][1]); pu[1] = pk2(xs[2 * u][2], xs[2 * u][3]);
      pu[2] = pk2(xs[2 * u + 1][0], xs[2 * u + 1][1]); pu[3] = pk2(xs[2 * u + 1][2], xs[2 * u + 1][3]);
      pb[u] = __builtin_bit_cast(bf16x8, pu);
    }
    f32x4 num[3];
#pragma unroll
    for (int vt = 0; vt < 3; ++vt) {
      f32x4 n1 = {0.f, 0.f, 0.f, 0.f}, n2 = {0.f, 0.f, 0.f, 0.f};
#pragma unroll
      for (int u = 0; u < 2; ++u) {
        const char* lo = Vs + (32 * u + 4 * fq + tq) * MVS + (16 * vt) * 2 + 8 * tp;
        const bf16x8 a = tr8(lo, lo + 16 * MVS);
        n1 = MFMA16(a, pb[u], n1);
      }
#pragma unroll
      for (int ks = 0; ks < 8; ++ks) {
        const bf16x8 a = *(const bf16x8*)(Ct + (16 * vt + fr) * MKS + ks * 64 + fq * 16);
        n2 = MFMA16(a, qf[ks], n2);
      }
#pragma unroll
      for (int r = 0; r < 4; ++r) num[vt][r] = n1[r] + e_j * n2[r];
    }
    const float den = __shfl(num[2][0], fr);
    const float inv = 1.f / fmaxf(fabsf(den), rd_j);
    {
      _Float16* hp = hout + (size_t)ROW_OF(n, jpos) * D + hd * 256 + c * 32 + 4 * fq;
#pragma unroll
      for (int vt = 0; vt < 2; ++vt) {
        h16x4 hv;
#pragma unroll
        for (int r = 0; r < 4; ++r) hv[r] = (_Float16)(num[vt][r] * inv);
        *(h16x4*)(hp + 16 * vt) = hv;
      }
    }
    if (more) M_QLOAD(n + 1)
    __syncthreads();
#pragma unroll
    for (int kt = 0; kt < 4; ++kt)
#pragma unroll
      for (int vt = 0; vt < 3; ++vt) cacc[kt][vt] *= a_state;
#pragma unroll
    for (int u = 0; u < 2; ++u) {
      bf16x8 bfr[3];
#pragma unroll
      for (int vt = 0; vt < 3; ++vt) {
        const char* lo = Vw + (32 * u + 8 * fq + tq) * MVS + (16 * vt) * 2 + 8 * tp;
        bfr[vt] = tr8(lo, lo + 4 * MVS);
      }
#pragma unroll
      for (int kt = 0; kt < 4; ++kt) {
        const char* lo = Ks + (32 * u + 8 * fq + tq) * MKS + (64 * w + 16 * kt) * 2 + 8 * tp;
        const bf16x8 af = tr8(lo, lo + 4 * MKS);
#pragma unroll
        for (int vt = 0; vt < 3; ++vt) cacc[kt][vt] = MFMA16(af, bfr[vt], cacc[kt][vt]);
      }
    }
#pragma unroll
    for (int kt = 0; kt < 4; ++kt)
#pragma unroll
      for (int vt = 0; vt < 3; ++vt) {
        uint2 o2; o2.x = pk2(cacc[kt][vt][0], cacc[kt][vt][1]); o2.y = pk2(cacc[kt][vt][2], cacc[kt][vt][3]);
        *(uint2*)(Ct + (16 * vt + fr) * MKS + (64 * w + 16 * kt + 4 * fq) * 2) = o2;
      }
    __syncthreads();
    if (more) M_SSTORE(n + 1)
    __syncthreads();
  }
}

DI int q_pull(int* head, volatile LAS unsigned* s_task_p) {
  __syncthreads();
  if (threadIdx.x == 0) *s_task_p = (unsigned)atomicAdd(head, 1);
  __syncthreads();
  return (int)*s_task_p;
}
DI void phase_mix(const Params& p, int l, char* smem, volatile LAS unsigned* s_task_p, int bid, int nb) {
  int* C = (int*)(p.ws + OFF_CTR) + l * 16;
  const bool last = (l & 3) == NL - 1;
  const int per_g = last ? 32 : 34;
  const int n_cv = last ? 0 : NCONV;
  const int xcd = (int)(xb_xcc_id() & 7u);
  for (;;) { const int t = q_pull(C, s_task_p); if (t >= 256) break; mlstm_task(p, t, smem); }
  for (int j = 0; j < 8; ++j) {
    const int x = (xcd + j) & 7;
    for (;;) {
      const int e = q_pull(C + 1 + x, s_task_p);
      if (e >= 4 * per_g) break;
      const int gi = e / per_g, r = e - gi * per_g, g = x + 8 * gi, b = g >> 3, h = g & 7;
      if (r < 32) attn_task(p, b, h, b * SEQ + r * 128, 68, true, smem);
      else attn_task(p, b, h, RL + b * CTX + (r - 32) * 128, 4, false, smem);
    }
  }
  for (;;) { const int t = q_pull(C + 9, s_task_p); if (t >= n_cv) break; const int c0 = t * CONV_PER_TASK; convert_range(p, (l & 3) + 1, smem, c0, c0 + CONV_PER_TASK, 1); }
}

DI void phase_mout(const Params& p, int l, int bid, int nb) {
  const int tid_ = tidx(), lane = tid_ & 63, wid = tid_ >> 6;
  char* ws = p.ws;
  const _Float16* hf = (const _Float16*)(ws + OFF_ZQ); const _Float16* hb = (const _Float16*)(ws + OFF_ZK);
  const u16* zo = (const u16*)(ws + OFF_ZO);
  u16* hm = (u16*)(ws + OFF_KC);
  for (int r = bid * 4 + wid; r < R; r += nb * 4) {
#pragma unroll
    for (int hd = 0; hd < 4; ++hd) {
      const size_t off = (size_t)r * D + hd * 256 + lane * 4;
      const h16x4 a = *(const h16x4*)(hf + off), bb = *(const h16x4*)(hb + off);
      float v[4]; float ss = 0.f;
#pragma unroll
      for (int e = 0; e < 4; ++e) { v[e] = (float)a[e] + (float)bb[e]; ss += v[e] * v[e]; }
      ss = wave_sum(ss);
      const float rstd = rsqrtf(ss * (1.f / 256.f) + EPS);
      const uint2 z = *(const uint2*)(zo + off);
      const float4 g4 = *(const float4*)(p.g_mh + (size_t)l * D + hd * 256 + lane * 4);
      const float o0 = sigmf(bf2f((u16)(z.x & 0xffff))) * v[0] * rstd * g4.x;
      const float o1 = sigmf(bf2f((u16)(z.x >> 16))) * v[1] * rstd * g4.y;
      const float o2 = sigmf(bf2f((u16)(z.y & 0xffff))) * v[2] * rstd * g4.z;
      const float o3 = sigmf(bf2f((u16)(z.y >> 16))) * v[3] * rstd * g4.w;
      uint2 o; o.x = pk2(o0, o1); o.y = pk2(o2, o3);
      *(uint2*)(hm + bko(r, hd * 256 + lane * 4, D / 64)) = o;
    }
  }
}

DI void phase_merge(const Params& p, const u16* wb, int mtn, char* smem, int bid, int nb) {
  constexpr int NTN = D / 128;
  char* ws = p.ws;
  const u16* hm = (const u16*)(ws + OFF_KC);
  const u16* ao = (const u16*)(ws + OFF_H) + (size_t)R * 1536;
  const u16* zbr = (const u16*)(ws + OFF_ZBR);
  u16* tt = (u16*)(ws + OFF_AN);
  G_DECL;
  for (int tile = vbid(bid, nb); tile < mtn * NTN; tile += nb) {
    int mt, nt; tile_of(tile, NTN, mt, nt);
    f32x4 acc[4][4]; ZERO_ACC(acc);
    gemm_prefetch(G_ARGS, hm, D, wb + WB_BM, D, mt * 128, nt * 128);
    gemm_mainloop(G_ARGS, hm, D, wb + WB_BM, D, D / 64, mt * 128, nt * 128, acc, smem);
    const unsigned rbase = mt * 128;
    {
      const int tid = tidx(), lane = tid & 63, wid = tid >> 6, wr = wid >> 1, wc = wid & 1, fr = lane & 15, fq = lane >> 4;
      stage_bf16(acc, smem, wr, wc, fr, fq);
      __syncthreads();
#pragma unroll
      for (int i = 0; i < 8; ++i) {
        const unsigned id = tid + 256 * i, row = id >> 4, ch = id & 15;
        const uint4 a = *(const uint4*)(smem + row * ST16 + ch * 16);
        const unsigned grow = rbase + row, col = nt * 128 + ch * 8;
        const uint4 gm = *(const uint4*)(zbr + grow * 2048u + col);
        uint4 o;
#define MRG1(F) o.F = pk2(sigmf(bf2f((u16)(gm.F & 0xffff))) * bf2f((u16)(a.F & 0xffff)), sigmf(bf2f((u16)(gm.F >> 16))) * bf2f((u16)(a.F >> 16)));
        MRG1(x) MRG1(y) MRG1(z) MRG1(w)
#undef MRG1
        *(uint4*)(tt + bko(grow, col, D / 64)) = o;
      }
      __syncthreads();
    }
    ZERO_ACC(acc);
    gemm_prefetch(G_ARGS, ao, D, wb + WB_BA, D, mt * 128, nt * 128);
    gemm_mainloop(G_ARGS, ao, D, wb + WB_BA, D, D / 64, mt * 128, nt * 128, acc, smem);
    const int tid = tidx(), lane = tid & 63, wid = tid >> 6, wr = wid >> 1, wc = wid & 1, fr = lane & 15, fq = lane >> 4;
    stage_bf16(acc, smem, wr, wc, fr, fq);
    __syncthreads();
#pragma unroll
    for (int i = 0; i < 8; ++i) {
      const unsigned id = tid + 256 * i, row = id >> 4, ch = id & 15;
      const uint4 b = *(const uint4*)(smem + row * ST16 + ch * 16);
      const unsigned grow = rbase + row, col = nt * 128 + ch * 8;
      const uint4 a = *(const uint4*)(tt + bko(grow, col, D / 64));
      const uint4 ga = *(const uint4*)(zbr + grow * 2048u + 1024u + col);
      uint4 o;
#define MRG(F) { \
      const float o0 = bf2f((u16)(a.F & 0xffff)) + sigmf(bf2f((u16)(ga.F & 0xffff))) * bf2f((u16)(b.F & 0xffff)); \
      const float o1 = bf2f((u16)(a.F >> 16)) + sigmf(bf2f((u16)(ga.F >> 16))) * bf2f((u16)(b.F >> 16)); \
      o.F = pk2(o0, o1); }
      MRG(x) MRG(y) MRG(z) MRG(w)
#undef MRG
      *(uint4*)(tt + bko(grow, col, D / 64)) = o;
    }
    __syncthreads();
  }
}

__global__ void __launch_bounds__(256, 2) fwd_kernel(Params p) {
  extern __shared__ __attribute__((aligned(16))) char smem[];
  __shared__ __attribute__((aligned(16))) unsigned xbw[4];
  const int bid = blockIdx.x, nb = gridDim.x;
  char* ws = p.ws;
  u16* an = (u16*)(ws + OFF_AN);
  u16* hbuf = (u16*)(ws + OFF_H);
  if (threadIdx.x < 4) xbw[threadIdx.x] = 0u;
  __syncthreads();
  XcdBarrier xb = xcd_barrier_post((unsigned*)(ws + OFF_BAR), (volatile LAS unsigned*)xbw);
  for (int ph = p.ph_lo; ph < p.ph_hi; ++ph) {
    if (ph == NPH - 1) {
      phase_final(p, bid, nb);
    } else {
      const int l = ph / NPH_LAYER, k = ph - l * NPH_LAYER;
      if (k == 0 && l > 0) continue;
      const u16* wb = (const u16*)(ws + OFF_WB) + (size_t)(l & 1) * WB_END;
      const float* mods_l = (const float*)(ws + OFF_MODS) + (size_t)l * 5 * NMOD * D;
      const int mtl = (l == NL - 1) ? RL / 128 : MT;
      const int nrep = ((DUP_MASK >> k) & 1) ? 2 : 1;
      for (int rep = 0; rep < nrep; ++rep) {
      if (rep) xcd_barrier(xb);
      switch (k) {
        case 0:
          if (l == 0) phase_init(p, smem, bid, nb);
          phase_convert(p, l, smem, bid, nb);
          break;
        case 1: phase_norm(p, R, p.g_n1 + l * D, mods_l, 0, 1, an, bid, nb); break;
        case 2: phase_ffn_up(p, MT, an, wb + WB_UP1, hbuf, smem, bid, nb); break;
        case 3: phase_gemm_resid(p, MT, hbuf, DFF, wb + WB_DN1, mods_l, 2, 0.5f, smem, bid, nb); break;
        case 4: phase_norm(p, R, p.g_n2 + l * D, mods_l, 3, 4, an, bid, nb); break;
        case 5: phase_inproj(p, l, an, wb + WB_IN, smem, bid, nb); break;
        case 6: phase_prep(p, l, bid, nb); break;
        case 7: phase_upproj(p, wb, smem, bid, nb); break;
        case 8: phase_mix(p, l + 4 * rep, smem, (volatile LAS unsigned*)&xbw[2], bid, nb); break;
        case 9: phase_mout(p, l, bid, nb); break;
        case 10: phase_merge(p, wb, mtl, smem, bid, nb); break;
        case 11: phase_gemm_resid(p, mtl, an, D, wb + WB_OUT, mods_l, 5, 1.0f, smem, bid, nb); break;
        case 12: phase_norm(p, mtl * 128, p.g_n3 + l * D, mods_l, 6, 7, an, bid, nb); break;
        case 13: phase_ffn_up(p, mtl, an, wb + WB_UP2, hbuf, smem, bid, nb); break;
        case 14: phase_gemm_resid(p, mtl, hbuf, DFF, wb + WB_DN2, mods_l, 8, 0.5f, smem, bid, nb); break;
      }
      }
    }
    if (ph + 1 < p.ph_hi) { if (ph == 0) cg::this_grid().sync(); else xcd_barrier(xb); }
  }
}

extern "C" void kernel_launch(void* const* d_in, const int* in_sizes, int n_in, void* d_out, int out_size, void* d_ws, size_t ws_size, hipStream_t stream) {
  static int grid = 0;
  if (grid == 0) {
    if (n_in != 25 || ws_size < WS_END) { fprintf(stderr, "kernel_launch: unexpected n_in %d or ws_size %zu (< %zu)\n", n_in, ws_size, (size_t)WS_END); grid = -1; return; }
    int dev = 0, cus = 0, per_cu = 0;
    hipGetDevice(&dev);
    hipDeviceGetAttribute(&cus, hipDeviceAttributeMultiprocessorCount, dev);
    hipFuncSetAttribute((const void*)fwd_kernel, hipFuncAttributeMaxDynamicSharedMemorySize, SMEM_BYTES);
    hipOccupancyMaxActiveBlocksPerMultiprocessor(&per_cu, (const void*)fwd_kernel, 256, SMEM_BYTES);
    if (per_cu < 1) per_cu = 1;
    if (per_cu > 2) per_cu = 2;
    grid = cus * per_cu;
    fprintf(stderr, "kernel_launch: grid %d (%d CUs x %d), ws need %zu have %zu\n", grid, cus, per_cu, (size_t)WS_END, ws_size);
  }
  if (grid < 0) return;
  Params p{};
  const float** f = (const float**)&p;
  for (int i = 0; i < 25; ++i) f[i] = (const float*)d_in[i];
  p.out = (float*)d_out; p.ws = (char*)d_ws;
  hipMemsetAsync((char*)d_ws + OFF_CTR, 0, (OFF_WB - OFF_CTR), stream);
#if ONE_LAUNCH
  p.ph_lo = 0; p.ph_hi = NPH;
  void* args[] = {&p};
  hipError_t e = hipLaunchCooperativeKernel((const void*)fwd_kernel, dim3(grid), dim3(256), args, SMEM_BYTES, stream);
  if (e != hipSuccess) fprintf(stderr, "cooperative launch failed: %s (grid %d)\n", hipGetErrorString(e), grid);
#else
  for (int ph = 0; ph < NPH; ++ph) {
    p.ph_lo = ph; p.ph_hi = ph + 1;
    hipLaunchKernelGGL(fwd_kernel, dim3(grid), dim3(256), SMEM_BYTES, stream, p);
  }
#endif
}
```

```cpp
#include <hip/hip_runtime.h>
#include <hip/hip_cooperative_groups.h>
#include <cstdio>
namespace cg = cooperative_groups;

#ifndef DUP_MASK
#define DUP_MASK 0
#endif
#ifndef ONE_LAUNCH
#define ONE_LAUNCH 1
#endif

typedef unsigned short u16;
typedef __attribute__((ext_vector_type(8))) short bf16x8;
typedef __attribute__((ext_vector_type(4))) short s16x4;
typedef __attribute__((ext_vector_type(4))) float f32x4;
typedef __attribute__((ext_vector_type(16))) float f32x16;
typedef __attribute__((ext_vector_type(4))) _Float16 h16x4;
typedef __attribute__((ext_vector_type(4))) unsigned u32x4;
#define DI __device__ __forceinline__
#define MFMA16(a, b, c) __builtin_amdgcn_mfma_f32_16x16x32_bf16((a), (b), (c), 0, 0, 0)
#define MFMA32(a, b, c) __builtin_amdgcn_mfma_f32_32x32x16_bf16((a), (b), (c), 0, 0, 0)

constexpr int D = 1024, NB = 4, SEQ = 4096, NL = 4, CTX = 256;
constexpr int RL = NB * SEQ;
constexpr int RC = NB * CTX;
constexpr int R = RL + RC;
constexpr int DFF = 2816, INW = 6864, ZW = 6912, NMOD = 9;
constexpr float EPS = 1e-6f;
constexpr int NCH = 68;
constexpr int MT = R / 128;

constexpr size_t al(size_t x) { return (x + 255) & ~(size_t)255; }
constexpr size_t OFF_XC = 0;
constexpr size_t OFF_MODS = al(OFF_XC + (size_t)RC * D * 4);
constexpr size_t OFF_ROPE = al(OFF_MODS + (size_t)NL * 5 * NMOD * D * 4);
constexpr size_t OFF_G = al(OFF_ROPE + (size_t)SEQ * 32 * 8);
constexpr size_t OFF_CTR = al(OFF_G + (size_t)32 * NCH * 512 * 4);
constexpr size_t OFF_BAR = al(OFF_CTR + 8 * 16 * 4);
constexpr size_t OFF_WB = al(OFF_BAR + 3456 * 4);
constexpr size_t WB_UP1 = 0;
constexpr size_t WB_DN1 = WB_UP1 + (size_t)2 * DFF * D;
constexpr size_t WB_UP2 = WB_DN1 + (size_t)D * DFF;
constexpr size_t WB_DN2 = WB_UP2 + (size_t)2 * DFF * D;
constexpr size_t WB_IN = WB_DN2 + (size_t)D * DFF;
constexpr size_t WB_UQ = WB_IN + (size_t)ZW * D;
constexpr size_t WB_UKV = WB_UQ + (size_t)1536 * 384;
constexpr size_t WB_BM = WB_UKV + (size_t)2048 * 256;
constexpr size_t WB_BA = WB_BM + (size_t)D * D;
constexpr size_t WB_OUT = WB_BA + (size_t)D * D;
constexpr size_t WB_END = WB_OUT + (size_t)D * D;
constexpr size_t OFF_AN = al(OFF_WB + 2 * WB_END * 2);
constexpr size_t OFF_H = al(OFF_AN + (size_t)R * D * 2);
constexpr size_t OFF_ZQ = al(OFF_H + (size_t)R * DFF * 2);
constexpr size_t OFF_ZK = al(OFF_ZQ + (size_t)R * D * 2);
constexpr size_t OFF_ZV = al(OFF_ZK + (size_t)R * D * 2);
constexpr size_t OFF_ZO = al(OFF_ZV + (size_t)R * D * 2);
constexpr size_t OFF_ZCQ = al(OFF_ZO + (size_t)R * D * 2);
constexpr size_t OFF_ZCKV = al(OFF_ZCQ + (size_t)R * 384 * 2);
constexpr size_t OFF_ZKR = al(OFF_ZCKV + (size_t)R * 256 * 2);
constexpr size_t OFF_ZG = al(OFF_ZKR + (size_t)R * 64 * 2);
constexpr size_t OFF_ZBR = al(OFF_ZG + (size_t)R * 16 * 4);
constexpr size_t OFF_KC = al(OFF_ZBR + (size_t)R * 2048 * 2);
constexpr size_t OFF_KV = al(OFF_KC + (size_t)R * D * 2);
constexpr size_t OFF_CQN = al(OFF_KV + (size_t)R * 2048 * 2);
constexpr size_t OFF_CKVN = al(OFF_CQN + (size_t)R * 384 * 2);
constexpr size_t OFF_KROPE = al(OFF_CKVN + (size_t)R * 256 * 2);
constexpr size_t WS_END = al(OFF_KROPE + (size_t)R * 64 * 2);

constexpr int SMEM_BYTES = 76800;
constexpr int NPH_LAYER = 15;
constexpr int NPH = NL * NPH_LAYER + 1;

struct Params {
  const float *x, *c, *ctx, *c_ctx, *w_ada, *b_ada, *g_n1, *g_n2, *g_n3, *w_ff1_up, *w_ff1_dn, *w_ff2_up, *w_ff2_dn,
      *w_in, *b_gate, *w_conv, *g_mh, *g_qa, *g_kva, *w_uq, *w_ukv, *w_bm, *w_ba, *w_out, *g_final;
  float* out;
  char* ws;
  int ph_lo, ph_hi;
};

DI float bf2f(u16 u) { return __uint_as_float(((unsigned)u) << 16); }
DI u16 f2bf(float x) { return __builtin_bit_cast(u16, (__bf16)x); }
DI unsigned pk2(float a, float b) { return (unsigned)f2bf(a) | ((unsigned)f2bf(b) << 16); }
DI float siluf(float x) { return x / (1.f + __expf(-x)); }
DI float sigmf(float x) { return 1.f / (1.f + __expf(-x)); }
DI float wave_sum(float v) {
#pragma unroll
  for (int o = 32; o > 0; o >>= 1) v += __shfl_xor(v, o);
  return v;
}
DI float wave_max(float v) {
#pragma unroll
  for (int o = 32; o > 0; o >>= 1) v = fmaxf(v, __shfl_xor(v, o));
  return v;
}
DI int tidx() { int t = threadIdx.x; asm volatile("" : "+v"(t)); return t; }
DI unsigned bko(unsigned r, unsigned k, unsigned nkt) { return ((r >> 7) * nkt + (k >> 6)) * 8192u + ((r & 127u) << 6) + (k & 63u); }
DI float* xptr(const Params& p, int r) { return r < RL ? p.out + (size_t)r * D : (float*)(p.ws + OFF_XC) + (size_t)(r - RL) * D; }
DI int modrow(int r) { return r < RL ? (r >> 12) : 4; }
DI bf16x8 tr8(const char* lo, const char* hi) {
  s16x4 a = __builtin_amdgcn_ds_read_tr16_b64_v4i16((s16x4 __attribute__((address_space(3)))*)(lo));
  s16x4 b = __builtin_amdgcn_ds_read_tr16_b64_v4i16((s16x4 __attribute__((address_space(3)))*)(hi));
  return __builtin_shufflevector(a, b, 0, 1, 2, 3, 4, 5, 6, 7);
}


#define XB_TMO      128
#define XB_XCNT(j)  (256  + 64 * (j))
#define XB_XSUB(j)  (1280 + 64 * (j))
#define XB_XGEN(j)  (2304 + 64 * (j))
#define XB_TOP      3328
#define XB_TOPGEN   3392
#define XCD_BAR_WORDS 3456
#define XB_SPIN_CAP (1u << 22)
#define LAS __attribute__((address_space(3)))
DI unsigned xb_ld(unsigned* p) { return __hip_atomic_load(p, __ATOMIC_RELAXED, __HIP_MEMORY_SCOPE_AGENT); }
DI unsigned xb_add(unsigned* p, unsigned v) { return __hip_atomic_fetch_add(p, v, __ATOMIC_RELAXED, __HIP_MEMORY_SCOPE_AGENT); }
DI unsigned xb_xcc_id() { return (unsigned)__builtin_amdgcn_s_getreg((3 << 11) | 20) & 0xFu; }
#define XB_SPIN(cond, bar) do { unsigned _sp = 0; while (cond) { __builtin_amdgcn_s_sleep(1); \
    if ((++_sp & 255u) == 0u) { if (xb_ld(&(bar)[XB_TMO])) break; if (_sp > XB_SPIN_CAP) { atomicAdd(&(bar)[XB_TMO], 1u); break; } } } } while (0)
struct XcdBarrier { unsigned* bar; unsigned x; volatile LAS unsigned* st; };
DI XcdBarrier xcd_barrier_post(unsigned* bar, volatile LAS unsigned* st) {
  XcdBarrier b; b.bar = bar; b.x = xb_xcc_id(); b.st = st;
  if (threadIdx.x == 0) (void)xb_add(&bar[XB_XCNT(b.x)], 1u);
  return b;
}
DI void xcd_barrier_complete(unsigned* bar, unsigned x, unsigned& nloc, unsigned& nx) {
  const unsigned G = gridDim.x * gridDim.y * gridDim.z;
  unsigned sum, cnt, mine, sp = 0u;
  for (;;) {
    sum = 0u; cnt = 0u; mine = 0u;
#pragma unroll
    for (unsigned j = 0; j < 16; ++j) { const unsigned c = xb_ld(&bar[XB_XCNT(j)]); sum += c; cnt += (c > 0u) ? 1u : 0u; mine = (j == x) ? c : mine; }
    if (sum == G) break;
    __builtin_amdgcn_s_sleep(1);
    if ((++sp & 255u) == 0u) { if (xb_ld(&bar[XB_TMO])) break; if (sp > XB_SPIN_CAP) { atomicAdd(&bar[XB_TMO], 1u); break; } }
  }
  nloc = mine > 0u ? mine : 1u; nx = cnt > 0u ? cnt : 1u;
}
DI void xcd_barrier(const XcdBarrier& b) {
  asm volatile("s_waitcnt vmcnt(0)" ::: "memory");
  __syncthreads();
  if (threadIdx.x == 0) {
    unsigned* bar = b.bar;
    __builtin_amdgcn_s_waitcnt(0);
    unsigned nloc = b.st[0], nx = b.st[1];
    if (nloc == 0u) { xcd_barrier_complete(bar, b.x, nloc, nx); b.st[0] = nloc; b.st[1] = nx; }
    const unsigned old = xb_add(&bar[XB_XSUB(b.x)], 1u);
    const unsigned gen = old / nloc;
    if (old + 1u == (gen + 1u) * nloc) {
      __builtin_amdgcn_fence(__ATOMIC_RELEASE, "agent");
      asm volatile("s_waitcnt vmcnt(0)" ::: "memory");
      const unsigned og = xb_add(&bar[XB_TOP], 1u);
      const unsigned tg = og / nx;
      if (og + 1u == (tg + 1u) * nx) xb_add(&bar[XB_TOPGEN], 1u);
      else XB_SPIN(xb_ld(&bar[XB_TOPGEN]) == tg, bar);
      __builtin_amdgcn_fence(__ATOMIC_ACQUIRE, "agent");
      xb_add(&bar[XB_XGEN(b.x)], 1u);
      asm volatile("s_waitcnt vmcnt(0)" ::: "memory");
    } else {
      XB_SPIN(xb_ld(&bar[XB_XGEN(b.x)]) == gen, bar);
      __builtin_amdgcn_fence(__ATOMIC_ACQUIRE, "agent");
      asm volatile("s_waitcnt vmcnt(0)" ::: "memory");
    }
  }
  __syncthreads();
}

DI int src_col(int perm, int r) {
  if (perm == 0) return r;
  if (perm == 1) { int grp = r >> 6, j = r & 63; return j < 32 ? grp * 32 + j : DFF + grp * 32 + (j - 32); }
  if (r < 4096) return r;
  if (r < 4800) return r + 16;
  if (r < 4816) return r - 704;
  if (r < 4864) return -1;
  return r - 48;
}

DI void convert_tile(const float* __restrict__ W, int Nsrc, int K, int perm, u16* __restrict__ Wt, int tile, char* smem) {
  const int nkt = K >> 6;
  const int rt = tile / nkt, kt = tile - rt * nkt;
  const int r0 = rt * 32, k0 = kt * 64;
  u16* t = (u16*)smem;
  const int tid = tidx();
  {
    const int j = tid & 31, i = tid >> 5;
    const int sc = src_col(perm, r0 + j);
#pragma unroll
    for (int s = 0; s < 8; ++s) {
      const int k = i + 8 * s;
      float v = sc >= 0 ? W[(size_t)(k0 + k) * Nsrc + sc] : 0.f;
      t[j * 72 + k] = f2bf(v);
    }
  }
  __syncthreads();
  {
    const int row = tid >> 3, c8 = tid & 7;
    uint4 v = *(const uint4*)(t + row * 72 + c8 * 8);
    *(uint4*)(Wt + bko(r0 + row, k0 + c8 * 8, K >> 6)) = v;
  }
  __syncthreads();
}

DI void convert_range(const Params& p, int l, char* smem, int t0, int t1, int tstep) {
  u16* wb = (u16*)(p.ws + OFF_WB) + (size_t)(l & 1) * WB_END;
  constexpr int T_UP = (2 * DFF / 32) * (D / 64);
  constexpr int T_DN = (D / 32) * (DFF / 64);
  constexpr int T_IN = (ZW / 32) * (D / 64);
  constexpr int T_UQ = (1536 / 32) * (384 / 64);
  constexpr int T_UKV = (2048 / 32) * (256 / 64);
  constexpr int T_SQ = (D / 32) * (D / 64);
  constexpr int C1 = T_UP, C2 = C1 + T_DN, C3 = C2 + T_UP, C4 = C3 + T_DN, C5 = C4 + T_IN, C6 = C5 + T_UQ, C7 = C6 + T_UKV,
                C8 = C7 + T_SQ, C9 = C8 + T_SQ, C10 = C9 + T_SQ;
  if (t1 > C10) t1 = C10;
  for (int t = t0; t < t1; t += tstep) {
    if (t < C1) convert_tile(p.w_ff1_up + (size_t)l * D * 2 * DFF, 2 * DFF, D, 1, wb + WB_UP1, t, smem);
    else if (t < C2) convert_tile(p.w_ff1_dn + (size_t)l * DFF * D, D, DFF, 0, wb + WB_DN1, t - C1, smem);
    else if (t < C3) convert_tile(p.w_ff2_up + (size_t)l * D * 2 * DFF, 2 * DFF, D, 1, wb + WB_UP2, t - C2, smem);
    else if (t < C4) convert_tile(p.w_ff2_dn + (size_t)l * DFF * D, D, DFF, 0, wb + WB_DN2, t - C3, smem);
    else if (t < C5) convert_tile(p.w_in + (size_t)l * D * INW, INW, D, 2, wb + WB_IN, t - C4, smem);
    else if (t < C6) convert_tile(p.w_uq + (size_t)l * 384 * 1536, 1536, 384, 0, wb + WB_UQ, t - C5, smem);
    else if (t < C7) convert_tile(p.w_ukv + (size_t)l * 256 * 2048, 2048, 256, 0, wb + WB_UKV, t - C6, smem);
    else if (t < C8) convert_tile(p.w_bm + (size_t)l * D * D, D, D, 0, wb + WB_BM, t - C7, smem);
    else if (t < C9) convert_tile(p.w_ba + (size_t)l * D * D, D, D, 0, wb + WB_BA, t - C8, smem);
    else convert_tile(p.w_out + (size_t)l * D * D, D, D, 0, wb + WB_OUT, t - C9, smem);
  }
}
constexpr int CONV_TILES = 13984;
constexpr int CONV_PER_TASK = 16;
constexpr int NCONV = (CONV_TILES + CONV_PER_TASK - 1) / CONV_PER_TASK;
DI void phase_convert(const Params& p, int l, char* smem, int bid, int nb) { convert_range(p, l, smem, bid, CONV_TILES, nb); }

DI void phase_init(const Params& p, char* smem, int bid, int nb) {
  const int tid = tidx(), lane = tid & 63, wid = tid >> 6;
  {
    const float4* xs = (const float4*)p.x; float4* xd = (float4*)p.out;
    const size_t n4 = (size_t)RL * D / 4;
    for (size_t i = (size_t)bid * 256 + tid; i < n4; i += (size_t)nb * 256) xd[i] = xs[i];
    const float4* cs = (const float4*)p.ctx; float4* cd = (float4*)(p.ws + OFF_XC);
    const size_t m4 = (size_t)RC * D / 4;
    for (size_t i = (size_t)bid * 256 + tid; i < m4; i += (size_t)nb * 256) cd[i] = cs[i];
  }
  {
    float2* tab = (float2*)(p.ws + OFF_ROPE);
    for (int idx = bid * 256 + tid; idx < SEQ * 32; idx += nb * 256) {
      const int t = idx >> 5, i = idx & 31, f = i & 15;
      const float pos = (float)(i < 16 ? (t >> 6) : (t & 63));
      const float inv = powf(10000.f, -(float)(2 * f) / 32.f);
      const float ang = pos * inv;
      tab[idx] = make_float2(cosf(ang), sinf(ang));
    }
  }
  float* sc = (float*)smem;
  float* red = sc + 5 * D;
  for (int i = tid; i < 5 * D; i += 256) {
    const int row = i >> 10, k = i & 1023;
    const float v = row < 4 ? p.c[row * D + k] : p.c_ctx[k];
    sc[i] = siluf(v);
  }
  __syncthreads();
  float* mods = (float*)(p.ws + OFF_MODS);
  constexpr int NG = NMOD * D / 64;
  for (int t = bid; t < NL * NG; t += nb) {
    const int l = t / NG, n = (t - l * NG) * 64 + lane;
    const float* w = p.w_ada + (size_t)l * D * NMOD * D + n;
    float a0 = 0, a1 = 0, a2 = 0, a3 = 0, a4 = 0;
    const int kb = wid * 256;
#pragma unroll 8
    for (int k = 0; k < 256; ++k) {
      const float wv = w[(size_t)(kb + k) * (NMOD * D)];
      a0 += sc[kb + k] * wv; a1 += sc[D + kb + k] * wv; a2 += sc[2 * D + kb + k] * wv; a3 += sc[3 * D + kb + k] * wv; a4 += sc[4 * D + kb + k] * wv;
    }
    red[(wid * 5 + 0) * 64 + lane] = a0; red[(wid * 5 + 1) * 64 + lane] = a1; red[(wid * 5 + 2) * 64 + lane] = a2;
    red[(wid * 5 + 3) * 64 + lane] = a3; red[(wid * 5 + 4) * 64 + lane] = a4;
    __syncthreads();
    for (int i = tid; i < 320; i += 256) {
      const int row = i >> 6, ln = i & 63;
      const int nn = (t - l * NG) * 64 + ln;
      float s = red[(0 * 5 + row) * 64 + ln] + red[(1 * 5 + row) * 64 + ln] + red[(2 * 5 + row) * 64 + ln] + red[(3 * 5 + row) * 64 + ln];
      mods[((size_t)l * 5 + row) * (NMOD * D) + nn] = s + p.b_ada[(size_t)l * NMOD * D + nn];
    }
    __syncthreads();
  }
}

DI void phase_norm(const Params& p, int nrows, const float* __restrict__ g, const float* __restrict__ mods_l, int shift_idx, int scale_idx, u16* __restrict__ an, int bid, int nb) {
  const int tid_ = tidx(), lane = tid_ & 63, wid = tid_ >> 6;
  for (int r = bid * 4 + wid; r < nrows; r += nb * 4) {
    const float* x = xptr(p, r);
    float4 v[4]; float ss = 0.f;
#pragma unroll
    for (int i = 0; i < 4; ++i) { v[i] = *(const float4*)(x + i * 256 + lane * 4); ss += v[i].x * v[i].x + v[i].y * v[i].y + v[i].z * v[i].z + v[i].w * v[i].w; }
    ss = wave_sum(ss);
    const float rstd = rsqrtf(ss * (1.f / D) + EPS);
    const float* md = mods_l + (size_t)modrow(r) * (NMOD * D);
#pragma unroll
    for (int i = 0; i < 4; ++i) {
      const int col = i * 256 + lane * 4;
      const float4 g4 = *(const float4*)(g + col);
      const float4 sh = *(const float4*)(md + shift_idx * D + col);
      const float4 sc = *(const float4*)(md + scale_idx * D + col);
      const float y0 = v[i].x * rstd * g4.x * (1.f + sc.x) + sh.x;
      const float y1 = v[i].y * rstd * g4.y * (1.f + sc.y) + sh.y;
      const float y2 = v[i].z * rstd * g4.z * (1.f + sc.z) + sh.z;
      const float y3 = v[i].w * rstd * g4.w * (1.f + sc.w) + sh.w;
      uint2 o; o.x = pk2(y0, y1); o.y = pk2(y2, y3);
      *(uint2*)(an + bko(r, col, D / 64)) = o;
    }
  }
}

DI void phase_final(const Params& p, int bid, int nb) {
  const int tid_ = tidx(), lane = tid_ & 63, wid = tid_ >> 6;
  for (int r = bid * 4 + wid; r < RL; r += nb * 4) {
    float* x = p.out + (size_t)r * D;
    float4 v[4]; float ss = 0.f;
#pragma unroll
    for (int i = 0; i < 4; ++i) { v[i] = *(const float4*)(x + i * 256 + lane * 4); ss += v[i].x * v[i].x + v[i].y * v[i].y + v[i].z * v[i].z + v[i].w * v[i].w; }
    ss = wave_sum(ss);
    const float rstd = rsqrtf(ss * (1.f / D) + EPS);
#pragma unroll
    for (int i = 0; i < 4; ++i) {
      const int col = i * 256 + lane * 4;
      const float4 g4 = *(const float4*)(p.g_final + col);
      float4 o; o.x = v[i].x * rstd * g4.x; o.y = v[i].y * rstd * g4.y; o.z = v[i].z * rstd * g4.z; o.w = v[i].w * rstd * g4.w;
      *(float4*)(x + col) = o;
    }
  }
}

constexpr int GSTR = 128;
constexpr int GBUF = 128 * GSTR;

#define G_PARAMS uint4 &ra00, uint4 &ra01, uint4 &ra02, uint4 &ra03, uint4 &rb00, uint4 &rb01, uint4 &rb02, uint4 &rb03, \
                 uint4 &ra10, uint4 &ra11, uint4 &ra12, uint4 &ra13, uint4 &rb10, uint4 &rb11, uint4 &rb12, uint4 &rb13
#define G_DECL uint4 g_a00, g_a01, g_a02, g_a03, g_b00, g_b01, g_b02, g_b03, g_a10, g_a11, g_a12, g_a13, g_b10, g_b11, g_b12, g_b13
#define G_ARGS g_a00, g_a01, g_a02, g_a03, g_b00, g_b01, g_b02, g_b03, g_a10, g_a11, g_a12, g_a13, g_b10, g_b11, g_b12, g_b13
#define G_L1(S, i, kt) ra##S##i = *(const uint4*)(ap + (size_t)(kt) * 8192 + i * 2048); rb##S##i = *(const uint4*)(bp + (size_t)(kt) * 8192 + i * 2048);
#define G_LOAD(S, kt) { G_L1(S, 0, kt) G_L1(S, 1, kt) G_L1(S, 2, kt) G_L1(S, 3, kt) }
#define G_S1(S, i, buf) *(uint4*)(sA + (buf) * GBUF + soff + i * 32 * GSTR) = ra##S##i; *(uint4*)(sB + (buf) * GBUF + soff + i * 32 * GSTR) = rb##S##i;
#define G_STORE(S, buf) { G_S1(S, 0, buf) G_S1(S, 1, buf) G_S1(S, 2, buf) G_S1(S, 3, buf) }
DI void gemm_prefetch(G_PARAMS, const u16* __restrict__ A, int lda, const u16* __restrict__ Bt, int ldb, int m0, int n0) {
  const int tid = tidx();
  const int lr = tid >> 3, lc = tid & 7;
  const u16* ap = A + (size_t)((m0 >> 7) * (lda >> 6)) * 8192 + lr * 64 + lc * 8;
  const u16* bp = Bt + (size_t)((n0 >> 7) * (ldb >> 6)) * 8192 + lr * 64 + lc * 8;
  G_LOAD(0, 0)
  G_LOAD(1, 1)
}
DI void gemm_mainloop(G_PARAMS, const u16* __restrict__ A, int lda, const u16* __restrict__ Bt, int ldb, int nk, int m0, int n0, f32x4 (&acc)[4][4], char* smem) {
  const int tid = tidx(), lane = tid & 63, wid = tid >> 6, wr = wid >> 1, wc = wid & 1;
  const int lr = tid >> 3, lc = tid & 7;
  const u16* ap = A + (size_t)((m0 >> 7) * (lda >> 6)) * 8192 + lr * 64 + lc * 8;
  const u16* bp = Bt + (size_t)((n0 >> 7) * (ldb >> 6)) * 8192 + lr * 64 + lc * 8;
#define G_COMPUTE(buf) { const char* cA = sA + (buf) * GBUF; const char* cB = sB + (buf) * GBUF; \
    _Pragma("unroll") for (int ks = 0; ks < 2; ++ks) { \
      bf16x8 a[4], b[4]; \
      _Pragma("unroll") for (int m = 0; m < 4; ++m) a[m] = *(const bf16x8*)(cA + (aoff ^ (ks * 64)) + m * 16 * GSTR); \
      _Pragma("unroll") for (int n = 0; n < 4; ++n) b[n] = *(const bf16x8*)(cB + (boff ^ (ks * 64)) + n * 16 * GSTR); \
      _Pragma("unroll") for (int m = 0; m < 4; ++m) _Pragma("unroll") for (int n = 0; n < 4; ++n) acc[m][n] = MFMA16(b[n], a[m], acc[m][n]); \
    } }
  char* sA = smem; char* sB = smem + 2 * GBUF;
  const int soff = lr * GSTR + ((lc ^ ((lr >> 1) & 7)) << 4);
  const int fr = lane & 15, fq = lane >> 4;
  const int swz = (fq ^ ((fr >> 1) & 7)) << 4;
  const int aoff = (wr * 64 + fr) * GSTR + swz;
  const int boff = (wc * 64 + fr) * GSTR + swz;
  uint4 ra20, ra21, ra22, ra23, rb20, rb21, rb22, rb23;
  if (2 < nk) G_LOAD(2, 2)
  G_STORE(0, 0)
  __syncthreads();
  if (3 < nk) G_LOAD(0, 3)
#define G_STEP(i, SN, BN) if (kt + (i) < nk) { \
    G_COMPUTE((i) & 1) \
    if (kt + (i) + 1 < nk) G_STORE(SN, BN) \
    __syncthreads(); \
    if (kt + (i) + 4 < nk) G_LOAD(SN, kt + (i) + 4) }
  for (int kt = 0; kt < nk; kt += 6) {
    G_STEP(0, 1, 1)
    G_STEP(1, 2, 0)
    G_STEP(2, 0, 1)
    G_STEP(3, 1, 0)
    G_STEP(4, 2, 1)
    G_STEP(5, 0, 0)
  }
#undef G_STEP
#undef G_COMPUTE
}
#undef G_L1
#undef G_S1
#undef G_LOAD
#undef G_STORE

DI int vbid(int bid, int nb) { return bid; }
DI void tile_of(int tile, int ntn, int& mt, int& nt) {
  const int gm = tile / (8 * ntn), rem = tile - gm * 8 * ntn;
  nt = rem >> 3; mt = gm * 8 + (rem & 7);
}
#define ZERO_ACC(acc) _Pragma("unroll") for (int m_ = 0; m_ < 4; ++m_) _Pragma("unroll") for (int n_ = 0; n_ < 4; ++n_) acc[m_][n_] = f32x4{0.f, 0.f, 0.f, 0.f}

constexpr int ST16 = 272;
constexpr int ST32 = 528;
DI void stage_bf16(const f32x4 (&acc)[4][4], char* st, int wr, int wc, int fr, int fq) {
#pragma unroll
  for (int m = 0; m < 4; ++m)
#pragma unroll
    for (int n = 0; n < 4; ++n) {
      uint2 v; v.x = pk2(acc[m][n][0], acc[m][n][1]); v.y = pk2(acc[m][n][2], acc[m][n][3]);
      *(uint2*)(st + (wr * 64 + 16 * m + fr) * ST16 + (wc * 64 + 16 * n + 4 * fq) * 2) = v;
    }
}
DI void stage_f32(const f32x4 (&acc)[4][4], char* st, int wr, int wc, int fr, int fq) {
#pragma unroll
  for (int m = 0; m < 4; ++m)
#pragma unroll
    for (int n = 0; n < 4; ++n) *(f32x4*)(st + (wr * 64 + 16 * m + fr) * ST32 + (wc * 64 + 16 * n + 4 * fq) * 4) = acc[m][n];
}

DI void phase_ffn_up(const Params& p, int mtn, const u16* an, const u16* wt, u16* h, char* smem, int bid, int nb) {
  constexpr int NTN = 2 * DFF / 128;
  G_DECL;
  { int tile = vbid(bid, nb); if (tile < mtn * NTN) { int mt, nt; tile_of(tile, NTN, mt, nt); gemm_prefetch(G_ARGS, an, D, wt, D, mt * 128, nt * 128); } }
  for (int tile = vbid(bid, nb); tile < mtn * NTN; tile += nb) {
    int mt, nt; tile_of(tile, NTN, mt, nt);
    f32x4 acc[4][4]; ZERO_ACC(acc);
    gemm_mainloop(G_ARGS, an, D, wt, D, D / 64, mt * 128, nt * 128, acc, smem);
    if (tile + nb < mtn * NTN) { int mt2, nt2; tile_of(tile + nb, NTN, mt2, nt2); gemm_prefetch(G_ARGS, an, D, wt, D, mt2 * 128, nt2 * 128); }
    const int tid = tidx(), lane = tid & 63, wid = tid >> 6, wr = wid >> 1, wc = wid & 1, fr = lane & 15, fq = lane >> 4;
#pragma unroll
    for (int m = 0; m < 4; ++m)
#pragma unroll
      for (int n = 0; n < 2; ++n) {
        float o[4];
#pragma unroll
        for (int r = 0; r < 4; ++r) o[r] = siluf(acc[m][n][r]) * acc[m][n + 2][r];
        uint2 v; v.x = pk2(o[0], o[1]); v.y = pk2(o[2], o[3]);
        *(uint2*)(smem + (wr * 64 + 16 * m + fr) * ST16 + (wc * 32 + 16 * n + 4 * fq) * 2) = v;
      }
    __syncthreads();
    const unsigned rbase = mt * 128, cbase = nt * 64;
#pragma unroll
    for (int i = 0; i < 4; ++i) {
      const unsigned id = tid + 256 * i, row = id >> 3, ch = id & 7;
      const uint4 v = *(const uint4*)(smem + row * ST16 + ch * 16);
      *(uint4*)(h + bko(rbase + row, cbase + ch * 8, DFF / 64)) = v;
    }
    __syncthreads();
  }
}

DI void phase_gemm_resid(const Params& p, int mtn, const u16* a, int K, const u16* wt, const float* mods_l, int gate_idx, float coef, char* smem, int bid, int nb) {
  constexpr int NTN = D / 128;
  G_DECL;
  { int tile = vbid(bid, nb); if (tile < mtn * NTN) { int mt, nt; tile_of(tile, NTN, mt, nt); gemm_prefetch(G_ARGS, a, K, wt, K, mt * 128, nt * 128); } }
  for (int tile = vbid(bid, nb); tile < mtn * NTN; tile += nb) {
    int mt, nt; tile_of(tile, NTN, mt, nt);
    f32x4 acc[4][4]; ZERO_ACC(acc);
    gemm_mainloop(G_ARGS, a, K, wt, K, K / 64, mt * 128, nt * 128, acc, smem);
    if (tile + nb < mtn * NTN) { int mt2, nt2; tile_of(tile + nb, NTN, mt2, nt2); gemm_prefetch(G_ARGS, a, K, wt, K, mt2 * 128, nt2 * 128); }
    const int tid = tidx(), lane = tid & 63, wid = tid >> 6, wr = wid >> 1, wc = wid & 1, fr = lane & 15, fq = lane >> 4;
    stage_f32(acc, smem, wr, wc, fr, fq);
    __syncthreads();
    const int r0 = mt * 128;
    const float* md = mods_l + (size_t)modrow(r0) * (NMOD * D) + gate_idx * D + nt * 128;
    float* xb = xptr(p, r0) + nt * 128;
    const unsigned ch = tid & 31;
    const float4 g4 = *(const float4*)(md + ch * 4);
#pragma unroll 4
    for (int i = 0; i < 16; ++i) {
      const unsigned row = (tid >> 5) + 8 * i;
      const float4 v = *(const float4*)(smem + row * ST32 + ch * 16);
      float4* xp = (float4*)(xb + row * (unsigned)D + ch * 4);
      float4 x = *xp;
      x.x += coef * g4.x * v.x; x.y += coef * g4.y * v.y; x.z += coef * g4.z * v.z; x.w += coef * g4.w * v.w;
      *xp = x;
    }
    __syncthreads();
  }
}

DI void phase_inproj(const Params& p, int l, const u16* an, const u16* wt, char* smem, int bid, int nb) {
  constexpr int NTN = ZW / 128;
  char* ws = p.ws;
  G_DECL;
  { int tile = vbid(bid, nb); if (tile < MT * NTN) { int mt, nt; tile_of(tile, NTN, mt, nt); gemm_prefetch(G_ARGS, an, D, wt, D, mt * 128, nt * 128); } }
  for (int tile = vbid(bid, nb); tile < MT * NTN; tile += nb) {
    int mt, nt; tile_of(tile, NTN, mt, nt);
    f32x4 acc[4][4]; ZERO_ACC(acc);
    gemm_mainloop(G_ARGS, an, D, wt, D, D / 64, mt * 128, nt * 128, acc, smem);
    if (tile + nb < MT * NTN) { int mt2, nt2; tile_of(tile + nb, NTN, mt2, nt2); gemm_prefetch(G_ARGS, an, D, wt, D, mt2 * 128, nt2 * 128); }
    const int tid = tidx(), lane = tid & 63, wid = tid >> 6, wr = wid >> 1, wc = wid & 1, fr = lane & 15, fq = lane >> 4;
    if (nt == 37) {
      if (wc == 0) {
        u16* zkr = (u16*)(ws + OFF_ZKR);
#pragma unroll
        for (int m = 0; m < 4; ++m)
#pragma unroll
          for (int n = 0; n < 4; ++n) {
            const unsigned row = mt * 128 + wr * 64 + 16 * m + fr;
            uint2 v; v.x = pk2(acc[m][n][0], acc[m][n][1]); v.y = pk2(acc[m][n][2], acc[m][n][3]);
            *(uint2*)(zkr + row * 64u + 16 * n + 4 * fq) = v;
          }
      } else {
        float* zg = (float*)(ws + OFF_ZG);
        const float4 b4 = *(const float4*)(p.b_gate + l * 16 + 4 * fq);
#pragma unroll
        for (int m = 0; m < 4; ++m) {
          const unsigned row = mt * 128 + wr * 64 + 16 * m + fr;
          float4 v; v.x = acc[m][0][0] + b4.x; v.y = acc[m][0][1] + b4.y; v.z = acc[m][0][2] + b4.z; v.w = acc[m][0][3] + b4.w;
          *(float4*)(zg + row * 16u + 4 * fq) = v;
        }
      }
      continue;
    }
    stage_bf16(acc, smem, wr, wc, fr, fq);
    __syncthreads();
    const int c = nt * 128;
    u16* dst; unsigned ld, c0;
    if (c < 4096) { dst = (u16*)(ws + OFF_ZQ) + (size_t)(c >> 10) * R * D; ld = D; c0 = c & 1023; }
    else if (c < 4480) { dst = (u16*)(ws + OFF_ZCQ); ld = 384; c0 = c - 4096; }
    else if (c < 4736) { dst = (u16*)(ws + OFF_ZCKV); ld = 256; c0 = c - 4480; }
    else { dst = (u16*)(ws + OFF_ZBR); ld = 2048; c0 = c - 4864; }
    const unsigned rbase = mt * 128;
#pragma unroll
    for (int i = 0; i < 8; ++i) {
      const unsigned id = tid + 256 * i, row = id >> 4, ch = id & 15;
      const uint4 v = *(const uint4*)(smem + row * ST16 + ch * 16);
      *(uint4*)(dst + (rbase + row) * ld + c0 + ch * 8) = v;
    }
    __syncthreads();
  }
}

DI void phase_prep(const Params& p, int l, int bid, int nb) {
  const int tid_ = tidx(), lane = tid_ & 63, wid = tid_ >> 6;
  char* ws = p.ws;
  const u16* zq = (const u16*)(ws + OFF_ZQ); const u16* zk = (const u16*)(ws + OFF_ZK);
  u16* qc = (u16*)(ws + OFF_AN); u16* kc = (u16*)(ws + OFF_KC);
  const float* wcv = p.w_conv + (size_t)l * 3 * 2048;
  const float2* tab = (const float2*)(ws + OFF_ROPE);
  for (int r = bid * 4 + wid; r < R; r += nb * 4) {
    int t, T;
    if (r < RL) { t = r & 4095; T = SEQ; } else { t = (r - RL) & 255; T = CTX; }
    const bool hp = t > 0, hn = t < T - 1;
#pragma unroll
    for (int c4 = 0; c4 < 4; ++c4) {
      const int ch = c4 * 512 + lane * 8;
      const bool isq = ch < 1024;
      const u16* src = isq ? zq : zk;
      const int cc = isq ? ch : ch - 1024;
      const uint4 zero = make_uint4(0, 0, 0, 0);
      const uint4 vc = *(const uint4*)(src + (size_t)r * D + cc);
      const uint4 vp = hp ? *(const uint4*)(src + (size_t)(r - 1) * D + cc) : zero;
      const uint4 vn = hn ? *(const uint4*)(src + (size_t)(r + 1) * D + cc) : zero;
      const unsigned pc[4] = {vc.x, vc.y, vc.z, vc.w}, pp[4] = {vp.x, vp.y, vp.z, vp.w}, pn[4] = {vn.x, vn.y, vn.z, vn.w};
      float o[8];
#pragma unroll
      for (int e = 0; e < 8; ++e) {
        const int sh = (e & 1) * 16;
        const float xc = bf2f((u16)(pc[e >> 1] >> sh)), xp = bf2f((u16)(pp[e >> 1] >> sh)), xn = bf2f((u16)(pn[e >> 1] >> sh));
        const float w0 = wcv[ch + e], w1 = wcv[2048 + ch + e], w2 = wcv[4096 + ch + e];
        float y = siluf(xp * w0 + xc * w1 + xn * w2);
        o[e] = isq ? y * 0.0625f : y;
      }
      uint4 ov; ov.x = pk2(o[0], o[1]); ov.y = pk2(o[2], o[3]); ov.z = pk2(o[4], o[5]); ov.w = pk2(o[6], o[7]);
      *(uint4*)((isq ? qc : kc) + (size_t)r * D + cc) = ov;
    }
    {
      const u16* z = (const u16*)(ws + OFF_ZCQ) + (size_t)r * 384;
      float v[6]; float ss = 0.f;
#pragma unroll
      for (int i = 0; i < 6; ++i) { v[i] = bf2f(z[lane + 64 * i]); ss += v[i] * v[i]; }
      ss = wave_sum(ss);
      const float rstd = rsqrtf(ss * (1.f / 384.f) + EPS);
      u16* o = (u16*)(ws + OFF_CQN);
#pragma unroll
      for (int i = 0; i < 6; ++i) o[bko(r, lane + 64 * i, 6)] = f2bf(v[i] * rstd * p.g_qa[l * 384 + lane + 64 * i]);
    }
    {
      const u16* z = (const u16*)(ws + OFF_ZCKV) + (size_t)r * 256;
      float v[4]; float ss = 0.f;
#pragma unroll
      for (int i = 0; i < 4; ++i) { v[i] = bf2f(z[lane + 64 * i]); ss += v[i] * v[i]; }
      ss = wave_sum(ss);
      const float rstd = rsqrtf(ss * (1.f / 256.f) + EPS);
      u16* o = (u16*)(ws + OFF_CKVN);
#pragma unroll
      for (int i = 0; i < 4; ++i) o[bko(r, lane + 64 * i, 4)] = f2bf(v[i] * rstd * p.g_kva[l * 256 + lane + 64 * i]);
    }
    {
      const float v = bf2f(((const u16*)(ws + OFF_ZKR))[(size_t)r * 64 + lane]);
      const float pv = __shfl_xor(v, 1);
      float o = v;
      if (r < RL) {
        const float2 cs = tab[t * 32 + (lane >> 1)];
        o = (lane & 1) ? (pv * cs.y + v * cs.x) : (v * cs.x - pv * cs.y);
      }
      ((u16*)(ws + OFF_KROPE))[(size_t)r * 64 + lane] = f2bf(o);
    }
  }
  {
    const float* zg = (const float*)(ws + OFF_ZG);
    for (int item = bid * 4 + wid; item < 32 * NCH; item += nb * 4) {
      const int stream = item / NCH, n = item - stream * NCH;
      const int b = stream >> 3, hd = (stream >> 1) & 3, dir = stream & 1;
      int base, T, cc;
      if (n < 4) { base = RL + b * CTX; T = CTX; cc = n; } else { base = b * SEQ; T = SEQ; cc = n - 4; }
      const int pos = cc * 64 + lane;
      const int row = base + (dir ? T - 1 - pos : pos);
      const float ig = zg[(size_t)row * 16 + dir * 8 + hd];
      const float fg = zg[(size_t)row * 16 + dir * 8 + 4 + hd];
      const float lf = fminf(fg, 0.f) - log1pf(__expf(-fabsf(fg)));
      float bc = lf;
#pragma unroll
      for (int d = 1; d < 64; d <<= 1) { const float tt = __shfl_up(bc, d); if (lane >= d) bc += tt; }
      const float bL = __shfl(bc, 63);
      const float wv = ig - bc;
      float pm = wv;
#pragma unroll
      for (int d = 1; d < 64; d <<= 1) { const float tt = __shfl_up(pm, d); if (lane >= d) pm = fmaxf(pm, tt); }
      const float endl = bL + wv;
      const float me = wave_max(endl);
      float* g = (float*)(ws + OFF_G) + ((size_t)stream * NCH + n) * 512;
      g[lane] = bc; g[64 + lane] = wv; g[128 + lane] = pm; g[192 + lane] = endl;
      if (lane == 0) { g[256] = bL; g[257] = me; }
    }
  }
}

DI void phase_upproj(const Params& p, const u16* wb, char* smem, int bid, int nb) {
  char* ws = p.ws;
  const float2* tab = (const float2*)(ws + OFF_ROPE);
  u16* qa = (u16*)(ws + OFF_H);
  u16* kv = (u16*)(ws + OFF_KV);
  constexpr int NQ = 12, NKV = 16;
  const int total = MT * (NQ + NKV);
  G_DECL;
#define UP_PREFETCH(T) { const int t_ = (T); if (t_ < MT * NQ) { int m_, n_; tile_of(t_, NQ, m_, n_); gemm_prefetch(G_ARGS, (const u16*)(ws + OFF_CQN), 384, wb + WB_UQ, 384, m_ * 128, n_ * 128); } \
    else if (t_ < total) { int m_, n_; tile_of(t_ - MT * NQ, NKV, m_, n_); gemm_prefetch(G_ARGS, (const u16*)(ws + OFF_CKVN), 256, wb + WB_UKV, 256, m_ * 128, n_ * 128); } }
  for (int tile = vbid(bid, nb); tile < total; tile += nb) {
    const bool isq = tile < MT * NQ;
    int mt, nt;
    f32x4 acc[4][4]; ZERO_ACC(acc);
    UP_PREFETCH(tile)
    if (isq) { tile_of(tile, NQ, mt, nt); gemm_mainloop(G_ARGS, (const u16*)(ws + OFF_CQN), 384, wb + WB_UQ, 384, 6, mt * 128, nt * 128, acc, smem); }
    else { tile_of(tile - MT * NQ, NKV, mt, nt); gemm_mainloop(G_ARGS, (const u16*)(ws + OFF_CKVN), 256, wb + WB_UKV, 256, 4, mt * 128, nt * 128, acc, smem); }
    const int tid = tidx(), lane = tid & 63, wid = tid >> 6, wr = wid >> 1, wc = wid & 1, fr = lane & 15, fq = lane >> 4;
    stage_bf16(acc, smem, wr, wc, fr, fq);
    __syncthreads();
    const unsigned rbase = mt * 128;
    if (isq) {
#pragma unroll
      for (int i = 0; i < 8; ++i) {
        const unsigned id = tid + 256 * i, row = id >> 4, ch = id & 15;
        uint4 v = *(const uint4*)(smem + row * ST16 + ch * 16);
        const unsigned col = nt * 128 + ch * 8, d0 = col % 192u, grow = rbase + row;
        if (d0 >= 128u && grow < (unsigned)RL) {
          const float4* tp = (const float4*)(tab + (grow & 4095u) * 32u + ((d0 - 128u) >> 1));
          const float4 t0 = tp[0], t1 = tp[1];
          float x0, x1;
          x0 = bf2f((u16)(v.x & 0xffff)); x1 = bf2f((u16)(v.x >> 16)); v.x = pk2(x0 * t0.x - x1 * t0.y, x0 * t0.y + x1 * t0.x);
          x0 = bf2f((u16)(v.y & 0xffff)); x1 = bf2f((u16)(v.y >> 16)); v.y = pk2(x0 * t0.z - x1 * t0.w, x0 * t0.w + x1 * t0.z);
          x0 = bf2f((u16)(v.z & 0xffff)); x1 = bf2f((u16)(v.z >> 16)); v.z = pk2(x0 * t1.x - x1 * t1.y, x0 * t1.y + x1 * t1.x);
          x0 = bf2f((u16)(v.w & 0xffff)); x1 = bf2f((u16)(v.w >> 16)); v.w = pk2(x0 * t1.z - x1 * t1.w, x0 * t1.w + x1 * t1.z);
        }
        *(uint4*)(qa + grow * 1536u + col) = v;
      }
    } else {
#pragma unroll
      for (int i = 0; i < 8; ++i) {
        const unsigned id = tid + 256 * i, row = id >> 4, ch = id & 15;
        const uint4 v = *(const uint4*)(smem + row * ST16 + ch * 16);
        *(uint4*)(kv + (rbase + row) * 2048u + nt * 128 + ch * 8) = v;
      }
    }
    __syncthreads();
  }
#undef UP_PREFETCH
}

constexpr int AKS = 400;
constexpr int AVS = 320;
DI void attn_task(const Params& p, int b, int h, int qrow0, int nkt, bool with_latent, char* smem) {
  const int tid = tidx(), lane = tid & 63, wid = tid >> 6, l31 = lane & 31, h2 = lane >> 5;
  char* ws = p.ws;
  const u16* qa = (const u16*)(ws + OFF_H);
  const u16* kvb = (const u16*)(ws + OFF_KV);
  const u16* krp = (const u16*)(ws + OFF_KROPE);
  u16* ao = (u16*)(ws + OFF_H) + (size_t)R * 1536;
  char* Ks = smem; char* Vs = smem + 64 * AKS;
  bf16x8 qf[12];
  {
    const u16* qp = qa + (size_t)(qrow0 + wid * 32 + l31) * 1536 + h * 192 + h2 * 8;
#pragma unroll
    for (int st = 0; st < 12; ++st) qf[st] = *(const bf16x8*)(qp + st * 16);
  }
  uint4 kreg0, kreg1, kreg2, kreg3, kreg4, kreg5, vreg0, vreg1, vreg2, vreg3;
#define KEY_ROW(kt, i) ((kt) < 4 ? (RL + b * CTX + (kt) * 64 + (i)) : (b * SEQ + ((kt) - 4) * 64 + (i)))
#define ATT_KL(kt, i) { const int id = tid + 256 * i, row = id / 24, ch = id - row * 24; const int kr = KEY_ROW(kt, row); \
    const u16* src = ch < 16 ? (kvb + (size_t)kr * 2048 + h * 256 + ch * 8) : (krp + (size_t)kr * 64 + (ch - 16) * 8); kreg##i = *(const uint4*)src; }
#define ATT_VL(kt, i) { const int id = tid + 256 * i, row = id >> 4, ch = id & 15; const int kr = KEY_ROW(kt, row); \
    vreg##i = *(const uint4*)(kvb + (size_t)kr * 2048 + h * 256 + 128 + ch * 8); }
#define ATT_GLOADK(kt) ATT_KL(kt, 0) ATT_KL(kt, 1) ATT_KL(kt, 2) ATT_KL(kt, 3) ATT_KL(kt, 4) ATT_KL(kt, 5)
#define ATT_GLOADV(kt) ATT_VL(kt, 0) ATT_VL(kt, 1) ATT_VL(kt, 2) ATT_VL(kt, 3)
#define ATT_GLOAD(kt) ATT_GLOADK(kt) ATT_GLOADV(kt)
#define ATT_KS(i) { const int id = tid + 256 * i, row = id / 24, ch = id - row * 24; *(uint4*)(Ks + row * AKS + ch * 16) = kreg##i; }
#define ATT_VS(i) { const int id = tid + 256 * i, row = id >> 4, ch = id & 15; *(uint4*)(Vs + row * AVS + ch * 16) = vreg##i; }
#define ATT_SSTORE() ATT_KS(0) ATT_KS(1) ATT_KS(2) ATT_KS(3) ATT_KS(4) ATT_KS(5) ATT_VS(0) ATT_VS(1) ATT_VS(2) ATT_VS(3)
  f32x16 o[4];
#pragma unroll
  for (int n = 0; n < 4; ++n)
#pragma unroll
    for (int i = 0; i < 16; ++i) o[n][i] = 0.f;
  float mrun = -1e30f, lrun = 0.f;
  const float sc = 0.07216878364870322f * 1.4426950408889634f;
  const int i16 = lane & 15, tq = i16 >> 2, tp = i16 & 3, blk = (lane >> 4) & 1;
  ATT_GLOAD(0)
  __syncthreads();
  ATT_SSTORE()
  __syncthreads();
  for (int kt = 0; kt < nkt; ++kt) {
    if (kt + 1 < nkt) { ATT_GLOADK(kt + 1) }
    f32x16 s0, s1;
#pragma unroll
    for (int i = 0; i < 16; ++i) { s0[i] = 0.f; s1[i] = 0.f; }
#pragma unroll
    for (int st = 0; st < 12; ++st) {
      const bf16x8 a0 = *(const bf16x8*)(Ks + l31 * AKS + st * 32 + h2 * 16);
      const bf16x8 a1 = *(const bf16x8*)(Ks + (32 + l31) * AKS + st * 32 + h2 * 16);
      s0 = MFMA32(a0, qf[st], s0);
      s1 = MFMA32(a1, qf[st], s1);
    }
    __builtin_amdgcn_sched_group_barrier(0x100, 4, 0);
#pragma unroll
    for (int i = 0; i < 10; ++i) { __builtin_amdgcn_sched_group_barrier(0x008, 2, 0); __builtin_amdgcn_sched_group_barrier(0x100, 2, 0); }
    __builtin_amdgcn_sched_group_barrier(0x008, 4, 0);
    __builtin_amdgcn_sched_barrier(0);
    float mx = s0[0];
#pragma unroll
    for (int i = 0; i < 16; ++i) { mx = fmaxf(mx, s0[i]); mx = fmaxf(mx, s1[i]); }
    mx = fmaxf(mx, __shfl_xor(mx, 32));
    const float mnew = fmaxf(mrun, mx * sc);
    const float alpha = __builtin_amdgcn_exp2f(mrun - mnew);
    mrun = mnew;
    float ls = 0.f;
#pragma unroll
    for (int i = 0; i < 16; ++i) { s0[i] = __builtin_amdgcn_exp2f(s0[i] * sc - mnew); s1[i] = __builtin_amdgcn_exp2f(s1[i] * sc - mnew); ls += s0[i] + s1[i]; }
    lrun = lrun * alpha + ls;
    if (__any(alpha != 1.f)) {
#pragma unroll
      for (int n = 0; n < 4; ++n)
#pragma unroll
        for (int i = 0; i < 16; ++i) o[n][i] *= alpha;
    }
    bf16x8 pbv[4];
#define ATT_PACK(SV, HH) \
    _Pragma("unroll") for (int s = 0; s < 2; ++s) { \
      u32x4 pu; \
      pu[0] = pk2(SV[8 * s + 0], SV[8 * s + 1]); pu[1] = pk2(SV[8 * s + 2], SV[8 * s + 3]); \
      pu[2] = pk2(SV[8 * s + 4], SV[8 * s + 5]); pu[3] = pk2(SV[8 * s + 6], SV[8 * s + 7]); \
      pbv[2 * HH + s] = __builtin_bit_cast(bf16x8, pu); \
    }
    ATT_PACK(s0, 0)
    ATT_PACK(s1, 1)
#undef ATT_PACK
    if (kt + 1 < nkt) { ATT_GLOADV(kt + 1) }
#pragma unroll
    for (int hs = 0; hs < 4; ++hs) {
      const char* vlo = Vs + (16 * hs + 4 * h2 + tq) * AVS + (16 * blk) * 2 + 8 * tp;
#pragma unroll
      for (int n = 0; n < 4; ++n) {
        const bf16x8 va = tr8(vlo + n * 64, vlo + n * 64 + 8 * AVS);
        o[n] = MFMA32(va, pbv[hs], o[n]);
      }
    }
    __syncthreads();
    if (kt + 1 < nkt) { ATT_SSTORE() }
    __syncthreads();
  }
  const float ltot = lrun + __shfl_xor(lrun, 32);
  const float inv = 1.f / ltot;
  const unsigned orow = qrow0 + wid * 32 + l31;
#pragma unroll
  for (int n = 0; n < 4; ++n)
#pragma unroll
    for (int g = 0; g < 4; ++g) {
      uint2 w; w.x = pk2(o[n][4 * g] * inv, o[n][4 * g + 1] * inv); w.y = pk2(o[n][4 * g + 2] * inv, o[n][4 * g + 3] * inv);
      *(uint2*)(ao + bko(orow, h * 128 + 32 * n + 8 * g + 4 * h2, D / 64)) = w;
    }
}

constexpr int MKS = 528;
constexpr int MVS = 112;
constexpr int M_CT = 64 * MKS;
constexpr int M_VS = M_CT + 48 * MKS;
constexpr int M_VW = M_VS + 64 * MVS;
constexpr int M_GS = 73728;
constexpr int M_MS = M_GS + 1536;
DI void mlstm_task(const Params& p, int task, char* smem) {
  const int tid = tidx(), lane = tid & 63, w = tid >> 6, fr = lane & 15, fq = lane >> 4, tq = fr >> 2, tp = fr & 3;
  const int stream = task >> 3, c = task & 7, b = stream >> 3, hd = (stream >> 1) & 3, dir = stream & 1;
  char* ws = p.ws;
  const u16* qc = (const u16*)(ws + OFF_AN); const u16* kc = (const u16*)(ws + OFF_KC); const u16* zv = (const u16*)(ws + OFF_ZV);
  const float* G = (const float*)(ws + OFF_G) + (size_t)stream * NCH * 512;
  _Float16* hout = (_Float16*)(ws + (dir ? OFF_ZK : OFF_ZQ));
  char* Ks = smem; char* Ct = smem + M_CT; char* Vs = smem + M_VS; char* Vw = smem + M_VW;
#define ROW_OF(n, pos) ((n) < 4 ? (RL + b * CTX + (dir ? CTX - 1 - ((n) * 64 + (pos)) : ((n) * 64 + (pos)))) : (b * SEQ + (dir ? SEQ - 1 - (((n) - 4) * 64 + (pos)) : (((n) - 4) * 64 + (pos)))))
  __syncthreads();
  for (int i = tid; i < 48 * MKS / 16; i += 256) ((uint4*)Ct)[i] = make_uint4(0, 0, 0, 0);
  f32x4 cacc[4][3];
#pragma unroll
  for (int kt = 0; kt < 4; ++kt)
#pragma unroll
    for (int vt = 0; vt < 3; ++vt) cacc[kt][vt] = f32x4{0.f, 0.f, 0.f, 0.f};
  uint4 kreg0, kreg1, kreg2, kreg3, kreg4, kreg5, kreg6, kreg7; uint4 vreg; float wreg; float4 greg = make_float4(0.f, 0.f, 0.f, 0.f);
#define M_KL(n, i) { const int id = tid + 256 * i, row = id >> 5, ch = id & 31; kreg##i = *(const uint4*)(kc + (size_t)ROW_OF(n, row) * D + hd * 256 + ch * 8); }
#define M_GLOAD(n) { M_KL(n, 0) M_KL(n, 1) M_KL(n, 2) M_KL(n, 3) M_KL(n, 4) M_KL(n, 5) M_KL(n, 6) M_KL(n, 7) \
    const int row_ = tid >> 2, part_ = tid & 3; \
    vreg = *(const uint4*)(zv + (size_t)ROW_OF(n, row_) * D + hd * 256 + c * 32 + part_ * 8); \
    wreg = G[(size_t)(n) * 512 + 192 + row_]; \
    if (tid < 64) { greg.x = G[(size_t)(n) * 512 + tid]; greg.y = G[(size_t)(n) * 512 + 64 + tid]; greg.z = G[(size_t)(n) * 512 + 128 + tid]; greg.w = G[(size_t)(n) * 512 + 192 + tid]; } }
#define M_KS(i) { const int id = tid + 256 * i, row = id >> 5, ch = id & 31; *(uint4*)(Ks + row * MKS + ch * 16) = kreg##i; }
#define M_SSTORE(n) { M_KS(0) M_KS(1) M_KS(2) M_KS(3) M_KS(4) M_KS(5) M_KS(6) M_KS(7) \
    const int row = tid >> 2, part = tid & 3; \
    const float mp_ = ((const float*)(smem + M_MS))[136 + (n)], mn_ = ((const float*)(smem + M_MS))[204 + (n)]; \
    if (tid < 64) { float* gs_ = (float*)(smem + M_GS); const float mj_ = fmaxf(greg.x + mp_, greg.x + greg.z); \
      gs_[tid] = greg.x - mj_; gs_[64 + tid] = greg.y; gs_[128 + tid] = __expf(greg.x + mp_ - mj_); gs_[192 + tid] = __expf(-mj_); gs_[256 + tid] = __expf(greg.w - mn_); \
      if (tid == 0) gs_[320] = __expf(((const float*)(smem + M_MS))[(n)] + mp_ - mn_); } \
    wreg = __expf(wreg - mn_); \
    *(uint4*)(Vs + row * MVS + part * 16) = vreg; \
    uint4 wv; \
    wv.x = pk2(bf2f((u16)(vreg.x & 0xffff)) * wreg, bf2f((u16)(vreg.x >> 16)) * wreg); \
    wv.y = pk2(bf2f((u16)(vreg.y & 0xffff)) * wreg, bf2f((u16)(vreg.y >> 16)) * wreg); \
    wv.z = pk2(bf2f((u16)(vreg.z & 0xffff)) * wreg, bf2f((u16)(vreg.z >> 16)) * wreg); \
    wv.w = pk2(bf2f((u16)(vreg.w & 0xffff)) * wreg, bf2f((u16)(vreg.w >> 16)) * wreg); \
    *(uint4*)(Vw + row * MVS + part * 16) = wv; \
    if (part == 0) { \
      *(uint4*)(Vs + row * MVS + 64) = make_uint4(0x3f80u, 0, 0, 0); \
      *(uint4*)(Vs + row * MVS + 80) = make_uint4(0, 0, 0, 0); \
      *(uint4*)(Vw + row * MVS + 64) = make_uint4((unsigned)f2bf(wreg), 0, 0, 0); \
      *(uint4*)(Vw + row * MVS + 80) = make_uint4(0, 0, 0, 0); \
    } }
#define M_QLOAD(n) { \
    const u16* qp = qc + (size_t)ROW_OF(n, 16 * w + fr) * D + hd * 256 + fq * 8; \
    _Pragma("unroll") for (int ks = 0; ks < 8; ++ks) qf[ks] = *(const bf16x8*)(qp + ks * 32); }
  bf16x8 qf[8];
  M_GLOAD(0) M_QLOAD(0)
  {
    float* ms = (float*)(smem + M_MS);
    if (tid < NCH) { ms[tid] = G[(size_t)tid * 512 + 256]; ms[68 + tid] = G[(size_t)tid * 512 + 257]; }
    __syncthreads();
    if (tid == 0) { float m = 0.f; for (int i = 0; i < NCH; ++i) { const float mn = fmaxf(ms[i] + m, ms[68 + i]); ms[136 + i] = m; ms[204 + i] = mn; m = mn; } }
    __syncthreads();
  }
  M_SSTORE(0)
  __syncthreads();
  for (int n = 0; n < NCH; ++n) {
    const bool more = n + 1 < NCH;
    if (more) M_GLOAD(n + 1)
    const float* g = (const float*)(smem + M_GS);
    const int jpos = 16 * w + fr;
    const float u_j = g[jpos], e_j = g[128 + jpos], rd_j = g[192 + jpos];
    const float a_state = g[320];
    f32x4 xs[4];
#pragma unroll
    for (int st = 0; st < 4; ++st) {
      xs[st] = f32x4{0.f, 0.f, 0.f, 0.f};
      if (st <= w) {
#pragma unroll
        for (int ks = 0; ks < 8; ++ks) {
          const bf16x8 a = *(const bf16x8*)(Ks + (16 * st + fr) * MKS + ks * 64 + fq * 16);
          xs[st] = MFMA16(a, qf[ks], xs[st]);
        }
        const float4 wv4 = *(const float4*)(g + 64 + 16 * st + 4 * fq);
        const int sb = 16 * st + 4 * fq;
        xs[st][0] *= (sb + 0 <= jpos) ? __expf(u_j + wv4.x) : 0.f;
        xs[st][1] *= (sb + 1 <= jpos) ? __expf(u_j + wv4.y) : 0.f;
        xs[st][2] *= (sb + 2 <= jpos) ? __expf(u_j + wv4.z) : 0.f;
        xs[st][3] *= (sb + 3 <= jpos) ? __expf(u_j + wv4.w) : 0.f;
      }
    }
    bf16x8 pb[2];
#pragma unroll
    for (int u = 0; u < 2; ++u) {
      u32x4 pu;
      pu[0] = pk2(xs[2 * u][0], xs[2 * u][1]); pu[1] = pk2(xs[2 * u][2], xs[2 * u][3]);
      pu[2] = pk2(xs[2 * u + 1][0], xs[2 * u + 1][1]); pu[3] = pk2(xs[2 * u + 1][2], xs[2 * u + 1][3]);
      pb[u] = __builtin_bit_cast(bf16x8, pu);
    }
    f32x4 num[3];
#pragma unroll
    for (int vt = 0; vt < 3; ++vt) {
      f32x4 n1 = {0.f, 0.f, 0.f, 0.f}, n2 = {0.f, 0.f, 0.f, 0.f};
#pragma unroll
      for (int u = 0; u < 2; ++u) {
        const char* lo = Vs + (32 * u + 4 * fq + tq) * MVS + (16 * vt) * 2 + 8 * tp;
        const bf16x8 a = tr8(lo, lo + 16 * MVS);
        n1 = MFMA16(a, pb[u], n1);
      }
#pragma unroll
      for (int ks = 0; ks < 8; ++ks) {
        const bf16x8 a = *(const bf16x8*)(Ct + (16 * vt + fr) * MKS + ks * 64 + fq * 16);
        n2 = MFMA16(a, qf[ks], n2);
      }
#pragma unroll
      for (int r = 0; r < 4; ++r) num[vt][r] = n1[r] + e_j * n2[r];
    }
    const float den = __shfl(num[2][0], fr);
    const float inv = 1.f / fmaxf(fabsf(den), rd_j);
    {
      _Float16* hp = hout + (size_t)ROW_OF(n, jpos) * D + hd * 256 + c * 32 + 4 * fq;
#pragma unroll
      for (int vt = 0; vt < 2; ++vt) {
        h16x4 hv;
#pragma unroll
        for (int r = 0; r < 4; ++r) hv[r] = (_Float16)(num[vt][r] * inv);
        *(h16x4*)(hp + 16 * vt) = hv;
      }
    }
    if (more) M_QLOAD(n + 1)
    __syncthreads();
#pragma unroll
    for (int kt = 0; kt < 4; ++kt)
#pragma unroll
      for (int vt = 0; vt < 3; ++vt) cacc[kt][vt] *= a_state;
#pragma unroll
    for (int u = 0; u < 2; ++u) {
      bf16x8 bfr[3];
#pragma unroll
      for (int vt = 0; vt < 3; ++vt) {
        const char* lo = Vw + (32 * u + 8 * fq + tq) * MVS + (16 * vt) * 2 + 8 * tp;
        bfr[vt] = tr8(lo, lo + 4 * MVS);
      }
#pragma unroll
      for (int kt = 0; kt < 4; ++kt) {
        const char* lo = Ks + (32 * u + 8 * fq + tq) * MKS + (64 * w + 16 * kt) * 2 + 8 * tp;
        const bf16x8 af = tr8(lo, lo + 4 * MKS);
#pragma unroll
        for (int vt = 0; vt < 3; ++vt) cacc[kt][vt] = MFMA16(af, bfr[vt], cacc[kt][vt]);
      }
    }
#pragma unroll
    for (int kt = 0; kt < 4; ++kt)
#pragma unroll
      for (int vt = 0; vt < 3; ++vt) {
        uint2 o2; o2.x = pk2(cacc[kt][vt][0], cacc[kt][vt][1]); o2.y = pk2(cacc[kt][vt][2], cacc[kt][vt][3]);
        *(uint2*)(Ct + (16 * vt + fr) * MKS + (64 * w + 16 * kt + 4 * fq) * 2) = o2;
      }
    __syncthreads();
    if (more) M_SSTORE(n + 1)
    __syncthreads();
  }
}

DI int q_pull(int* head, volatile LAS unsigned* s_task_p) {
  __syncthreads();
  if (threadIdx.x == 0) *s_task_p = (unsigned)atomicAdd(head, 1);
  __syncthreads();
  return (int)*s_task_p;
}
DI void phase_mix(const Params& p, int l, char* smem, volatile LAS unsigned* s_task_p, int bid, int nb) {
  int* C = (int*)(p.ws + OFF_CTR) + l * 16;
  const bool last = (l & 3) == NL - 1;
  const int per_g = last ? 32 : 34;
  const int n_cv = last ? 0 : NCONV;
  const int xcd = (int)(xb_xcc_id() & 7u);
  for (;;) { const int t = q_pull(C, s_task_p); if (t >= 256) break; mlstm_task(p, t, smem); }
  for (int j = 0; j < 8; ++j) {
    const int x = (xcd + j) & 7;
    for (;;) {
      const int e = q_pull(C + 1 + x, s_task_p);
      if (e >= 4 * per_g) break;
      const int gi = e / per_g, r = e - gi * per_g, g = x + 8 * gi, b = g >> 3, h = g & 7;
      if (r < 32) attn_task(p, b, h, b * SEQ + r * 128, 68, true, smem);
      else attn_task(p, b, h, RL + b * CTX + (r - 32) * 128, 4, false, smem);
    }
  }
  for (;;) { const int t = q_pull(C + 9, s_task_p); if (t >= n_cv) break; const int c0 = t * CONV_PER_TASK; convert_range(p, (l & 3) + 1, smem, c0, c0 + CONV_PER_TASK, 1); }
}

DI void phase_mout(const Params& p, int l, int bid, int nb) {
  const int tid_ = tidx(), lane = tid_ & 63, wid = tid_ >> 6;
  char* ws = p.ws;
  const _Float16* hf = (const _Float16*)(ws + OFF_ZQ); const _Float16* hb = (const _Float16*)(ws + OFF_ZK);
  const u16* zo = (const u16*)(ws + OFF_ZO);
  u16* hm = (u16*)(ws + OFF_KC);
  for (int r = bid * 4 + wid; r < R; r += nb * 4) {
#pragma unroll
    for (int hd = 0; hd < 4; ++hd) {
      const size_t off = (size_t)r * D + hd * 256 + lane * 4;
      const h16x4 a = *(const h16x4*)(hf + off), bb = *(const h16x4*)(hb + off);
      float v[4]; float ss = 0.f;
#pragma unroll
      for (int e = 0; e < 4; ++e) { v[e] = (float)a[e] + (float)bb[e]; ss += v[e] * v[e]; }
      ss = wave_sum(ss);
      const float rstd = rsqrtf(ss * (1.f / 256.f) + EPS);
      const uint2 z = *(const uint2*)(zo + off);
      const float4 g4 = *(const float4*)(p.g_mh + (size_t)l * D + hd * 256 + lane * 4);
      const float o0 = sigmf(bf2f((u16)(z.x & 0xffff))) * v[0] * rstd * g4.x;
      const float o1 = sigmf(bf2f((u16)(z.x >> 16))) * v[1] * rstd * g4.y;
      const float o2 = sigmf(bf2f((u16)(z.y & 0xffff))) * v[2] * rstd * g4.z;
      const float o3 = sigmf(bf2f((u16)(z.y >> 16))) * v[3] * rstd * g4.w;
      uint2 o; o.x = pk2(o0, o1); o.y = pk2(o2, o3);
      *(uint2*)(hm + bko(r, hd * 256 + lane * 4, D / 64)) = o;
    }
  }
}

DI void phase_merge(const Params& p, const u16* wb, int mtn, char* smem, int bid, int nb) {
  constexpr int NTN = D / 128;
  char* ws = p.ws;
  const u16* hm = (const u16*)(ws + OFF_KC);
  const u16* ao = (const u16*)(ws + OFF_H) + (size_t)R * 1536;
  const u16* zbr = (const u16*)(ws + OFF_ZBR);
  u16* tt = (u16*)(ws + OFF_AN);
  G_DECL;
  for (int tile = vbid(bid, nb); tile < mtn * NTN; tile += nb) {
    int mt, nt; tile_of(tile, NTN, mt, nt);
    f32x4 acc[4][4]; ZERO_ACC(acc);
    gemm_prefetch(G_ARGS, hm, D, wb + WB_BM, D, mt * 128, nt * 128);
    gemm_mainloop(G_ARGS, hm, D, wb + WB_BM, D, D / 64, mt * 128, nt * 128, acc, smem);
    const unsigned rbase = mt * 128;
    {
      const int tid = tidx(), lane = tid & 63, wid = tid >> 6, wr = wid >> 1, wc = wid & 1, fr = lane & 15, fq = lane >> 4;
      stage_bf16(acc, smem, wr, wc, fr, fq);
      __syncthreads();
#pragma unroll
      for (int i = 0; i < 8; ++i) {
        const unsigned id = tid + 256 * i, row = id >> 4, ch = id & 15;
        const uint4 a = *(const uint4*)(smem + row * ST16 + ch * 16);
        const unsigned grow = rbase + row, col = nt * 128 + ch * 8;
        const uint4 gm = *(const uint4*)(zbr + grow * 2048u + col);
        uint4 o;
#define MRG1(F) o.F = pk2(sigmf(bf2f((u16)(gm.F & 0xffff))) * bf2f((u16)(a.F & 0xffff)), sigmf(bf2f((u16)(gm.F >> 16))) * bf2f((u16)(a.F >> 16)));
        MRG1(x) MRG1(y) MRG1(z) MRG1(w)
#undef MRG1
        *(uint4*)(tt + bko(grow, col, D / 64)) = o;
      }
      __syncthreads();
    }
    ZERO_ACC(acc);
    gemm_prefetch(G_ARGS, ao, D, wb + WB_BA, D, mt * 128, nt * 128);
    gemm_mainloop(G_ARGS, ao, D, wb + WB_BA, D, D / 64, mt * 128, nt * 128, acc, smem);
    const int tid = tidx(), lane = tid & 63, wid = tid >> 6, wr = wid >> 1, wc = wid & 1, fr = lane & 15, fq = lane >> 4;
    stage_bf16(acc, smem, wr, wc, fr, fq);
    __syncthreads();
#pragma unroll
    for (int i = 0; i < 8; ++i) {
      const unsigned id = tid + 256 * i, row = id >> 4, ch = id & 15;
      const uint4 b = *(const uint4*)(smem + row * ST16 + ch * 16);
      const unsigned grow = rbase + row, col = nt * 128 + ch * 8;
      const uint4 a = *(const uint4*)(tt + bko(grow, col, D / 64));
      const uint4 ga = *(const uint4*)(zbr + grow * 2048u + 1024u + col);
      uint4 o;
#define MRG(F) { \
      const float o0 = bf2f((u16)(a.F & 0xffff)) + sigmf(bf2f((u16)(ga.F & 0xffff))) * bf2f((u16)(b.F & 0xffff)); \
      const float o1 = bf2f((u16)(a.F >> 16)) + sigmf(bf2f((u16)(ga.F >> 16))) * bf2f((u16)(b.F >> 16)); \
      o.F = pk2(o0, o1); }
      MRG(x) MRG(y) MRG(z) MRG(w)
#undef MRG
      *(uint4*)(tt + bko(grow, col, D / 64)) = o;
    }
    __syncthreads();
  }
}

__global__ void __launch_bounds__(256, 2) fwd_kernel(Params p) {
  extern __shared__ __attribute__((aligned(16))) char smem[];
  __shared__ __attribute__((aligned(16))) unsigned xbw[4];
  const int bid = blockIdx.x, nb = gridDim.x;
  char* ws = p.ws;
  u16* an = (u16*)(ws + OFF_AN);
  u16* hbuf = (u16*)(ws + OFF_H);
  if (threadIdx.x < 4) xbw[threadIdx.x] = 0u;
  __syncthreads();
  XcdBarrier xb = xcd_barrier_post((unsigned*)(ws + OFF_BAR), (volatile LAS unsigned*)xbw);
  for (int ph = p.ph_lo; ph < p.ph_hi; ++ph) {
    if (ph == NPH - 1) {
      phase_final(p, bid, nb);
    } else {
      const int l = ph / NPH_LAYER, k = ph - l * NPH_LAYER;
      if (k == 0 && l > 0) continue;
      const u16* wb = (const u16*)(ws + OFF_WB) + (size_t)(l & 1) * WB_END;
      const float* mods_l = (const float*)(ws + OFF_MODS) + (size_t)l * 5 * NMOD * D;
      const int mtl = (l == NL - 1) ? RL / 128 : MT;
      const int nrep = ((DUP_MASK >> k) & 1) ? 2 : 1;
      for (int rep = 0; rep < nrep; ++rep) {
      if (rep) xcd_barrier(xb);
      switch (k) {
        case 0:
          if (l == 0) phase_init(p, smem, bid, nb);
          phase_convert(p, l, smem, bid, nb);
          break;
        case 1: phase_norm(p, R, p.g_n1 + l * D, mods_l, 0, 1, an, bid, nb); break;
        case 2: phase_ffn_up(p, MT, an, wb + WB_UP1, hbuf, smem, bid, nb); break;
        case 3: phase_gemm_resid(p, MT, hbuf, DFF, wb + WB_DN1, mods_l, 2, 0.5f, smem, bid, nb); break;
        case 4: phase_norm(p, R, p.g_n2 + l * D, mods_l, 3, 4, an, bid, nb); break;
        case 5: phase_inproj(p, l, an, wb + WB_IN, smem, bid, nb); break;
        case 6: phase_prep(p, l, bid, nb); break;
        case 7: phase_upproj(p, wb, smem, bid, nb); break;
        case 8: phase_mix(p, l + 4 * rep, smem, (volatile LAS unsigned*)&xbw[2], bid, nb); break;
        case 9: phase_mout(p, l, bid, nb); break;
        case 10: phase_merge(p, wb, mtl, smem, bid, nb); break;
        case 11: phase_gemm_resid(p, mtl, an, D, wb + WB_OUT, mods_l, 5, 1.0f, smem, bid, nb); break;
        case 12: phase_norm(p, mtl * 128, p.g_n3 + l * D, mods_l, 6, 7, an, bid, nb); break;
        case 13: phase_ffn_up(p, mtl, an, wb + WB_UP2, hbuf, smem, bid, nb); break;
        case 14: phase_gemm_resid(p, mtl, hbuf, DFF, wb + WB_DN2, mods_l, 8, 0.5f, smem, bid, nb); break;
      }
      }
    }
    if (ph + 1 < p.ph_hi) { if (ph == 0) cg::this_grid().sync(); else xcd_barrier(xb); }
  }
}

extern "C" void kernel_launch(void* const* d_in, const int* in_sizes, int n_in, void* d_out, int out_size, void* d_ws, size_t ws_size, hipStream_t stream) {
  static int grid = 0;
  if (grid == 0) {
    if (n_in != 25 || ws_size < WS_END) { fprintf(stderr, "kernel_launch: unexpected n_in %d or ws_size %zu (< %zu)\n", n_in, ws_size, (size_t)WS_END); grid = -1; return; }
    int dev = 0, cus = 0, per_cu = 0;
    hipGetDevice(&dev);
    hipDeviceGetAttribute(&cus, hipDeviceAttributeMultiprocessorCount, dev);
    hipFuncSetAttribute((const void*)fwd_kernel, hipFuncAttributeMaxDynamicSharedMemorySize, SMEM_BYTES);
    hipOccupancyMaxActiveBlocksPerMultiprocessor(&per_cu, (const void*)fwd_kernel, 256, SMEM_BYTES);
    if (per_cu < 1) per_cu = 1;
    if (per_cu > 2) per_cu = 2;
    grid = cus * per_cu;
    fprintf(stderr, "kernel_launch: grid %d (%d CUs x %d), ws need %zu have %zu\n", grid, cus, per_cu, (size_t)WS_END, ws_size);
  }
  if (grid < 0) return;
  Params p{};
  const float** f = (const float**)&p;
  for (int i = 0; i < 25; ++i) f[i] = (const float*)d_in[i];
  p.out = (float*)d_out; p.ws = (char*)d_ws;
  hipMemsetAsync((char*)d_ws + OFF_CTR, 0, (OFF_WB - OFF_CTR), stream);
#if ONE_LAUNCH
  p.ph_lo = 0; p.ph_hi = NPH;
  void* args[] = {&p};
  hipError_t e = hipLaunchCooperativeKernel((const void*)fwd_kernel, dim3(grid), dim3(256), args, SMEM_BYTES, stream);
  if (e != hipSuccess) fprintf(stderr, "cooperative launch failed: %s (grid %d)\n", hipGetErrorString(e), grid);
#else
  for (int ph = 0; ph < NPH; ++ph) {
    p.ph_lo = ph; p.ph_hi = ph + 1;
    hipLaunchKernelGGL(fwd_kernel, dim3(grid), dim3(256), SMEM_BYTES, stream, p);
  }
#endif
}
```

```cpp
#include <hip/hip_runtime.h>
#include <hip/hip_cooperative_groups.h>
#include <cstdio>
namespace cg = cooperative_groups;

#ifndef DUP_MASK
#define DUP_MASK 0
#endif
#ifndef ONE_LAUNCH
#define ONE_LAUNCH 1
#endif

typedef unsigned short u16;
typedef __attribute__((ext_vector_type(8))) short bf16x8;
typedef __attribute__((ext_vector_type(4))) short s16x4;
typedef __attribute__((ext_vector_type(4))) float f32x4;
typedef __attribute__((ext_vector_type(16))) float f32x16;
typedef __attribute__((ext_vector_type(4))) _Float16 h16x4;
typedef __attribute__((ext_vector_type(4))) unsigned u32x4;
#define DI __device__ __forceinline__
#define MFMA16(a, b, c) __builtin_amdgcn_mfma_f32_16x16x32_bf16((a), (b), (c), 0, 0, 0)
#define MFMA32(a, b, c) __builtin_amdgcn_mfma_f32_32x32x16_bf16((a), (b), (c), 0, 0, 0)

constexpr int D = 1024, NB = 4, SEQ = 4096, NL = 4, CTX = 256;
constexpr int RL = NB * SEQ;
constexpr int RC = NB * CTX;
constexpr int R = RL + RC;
constexpr int DFF = 2816, INW = 6864, ZW = 6912, NMOD = 9;
constexpr float EPS = 1e-6f;
constexpr int NCH = 68;
constexpr int MT = R / 128;

constexpr size_t al(size_t x) { return (x + 255) & ~(size_t)255; }
constexpr size_t OFF_XC = 0;
constexpr size_t OFF_MODS = al(OFF_XC + (size_t)RC * D * 4);
constexpr size_t OFF_ROPE = al(OFF_MODS + (size_t)NL * 5 * NMOD * D * 4);
constexpr size_t OFF_G = al(OFF_ROPE + (size_t)SEQ * 32 * 8);
constexpr size_t OFF_CTR = al(OFF_G + (size_t)32 * NCH * 512 * 4);
constexpr size_t OFF_BAR = al(OFF_CTR + 8 * 16 * 4);
constexpr size_t OFF_WB = al(OFF_BAR + 3456 * 4);
constexpr size_t WB_UP1 = 0;
constexpr size_t WB_DN1 = WB_UP1 + (size_t)2 * DFF * D;
constexpr size_t WB_UP2 = WB_DN1 + (size_t)D * DFF;
constexpr size_t WB_DN2 = WB_UP2 + (size_t)2 * DFF * D;
constexpr size_t WB_IN = WB_DN2 + (size_t)D * DFF;
constexpr size_t WB_UQ = WB_IN + (size_t)ZW * D;
constexpr size_t WB_UKV = WB_UQ + (size_t)1536 * 384;
constexpr size_t WB_BM = WB_UKV + (size_t)2048 * 256;
constexpr size_t WB_BA = WB_BM + (size_t)D * D;
constexpr size_t WB_OUT = WB_BA + (size_t)D * D;
constexpr size_t WB_END = WB_OUT + (size_t)D * D;
constexpr size_t OFF_AN = al(OFF_WB + 2 * WB_END * 2);
constexpr size_t OFF_H = al(OFF_AN + (size_t)R * D * 2);
constexpr size_t OFF_ZQ = al(OFF_H + (size_t)R * DFF * 2);
constexpr size_t OFF_ZK = al(OFF_ZQ + (size_t)R * D * 2);
constexpr size_t OFF_ZV = al(OFF_ZK + (size_t)R * D * 2);
constexpr size_t OFF_ZO = al(OFF_ZV + (size_t)R * D * 2);
constexpr size_t OFF_ZCQ = al(OFF_ZO + (size_t)R * D * 2);
constexpr size_t OFF_ZCKV = al(OFF_ZCQ + (size_t)R * 384 * 2);
constexpr size_t OFF_ZKR = al(OFF_ZCKV + (size_t)R * 256 * 2);
constexpr size_t OFF_ZG = al(OFF_ZKR + (size_t)R * 64 * 2);
constexpr size_t OFF_ZBR = al(OFF_ZG + (size_t)R * 16 * 4);
constexpr size_t OFF_KC = al(OFF_ZBR + (size_t)R * 2048 * 2);
constexpr size_t OFF_KV = al(OFF_KC + (size_t)R * D * 2);
constexpr size_t OFF_CQN = al(OFF_KV + (size_t)R * 2048 * 2);
constexpr size_t OFF_CKVN = al(OFF_CQN + (size_t)R * 384 * 2);
constexpr size_t OFF_KROPE = al(OFF_CKVN + (size_t)R * 256 * 2);
constexpr size_t WS_END = al(OFF_KROPE + (size_t)R * 64 * 2);

constexpr int SMEM_BYTES = 76800;
constexpr int NPH_LAYER = 15;
constexpr int NPH = NL * NPH_LAYER + 1;

struct Params {
  const float *x, *c, *ctx, *c_ctx, *w_ada, *b_ada, *g_n1, *g_n2, *g_n3, *w_ff1_up, *w_ff1_dn, *w_ff2_up, *w_ff2_dn,
      *w_in, *b_gate, *w_conv, *g_mh, *g_qa, *g_kva, *w_uq, *w_ukv, *w_bm, *w_ba, *w_out, *g_final;
  float* out;
  char* ws;
  int ph_lo, ph_hi;
};

DI float bf2f(u16 u) { return __uint_as_float(((unsigned)u) << 16); }
DI u16 f2bf(float x) { return __builtin_bit_cast(u16, (__bf16)x); }
DI unsigned pk2(float a, float b) { return (unsigned)f2bf(a) | ((unsigned)f2bf(b) << 16); }
DI float siluf(float x) { return x / (1.f + __expf(-x)); }
DI float sigmf(float x) { return 1.f / (1.f + __expf(-x)); }
DI float wave_sum(float v) {
#pragma unroll
  for (int o = 32; o > 0; o >>= 1) v += __shfl_xor(v, o);
  return v;
}
DI float wave_max(float v) {
#pragma unroll
  for (int o = 32; o > 0; o >>= 1) v = fmaxf(v, __shfl_xor(v, o));
  return v;
}
DI int tidx() { int t = threadIdx.x; asm volatile("" : "+v"(t)); return t; }
DI unsigned bko(unsigned r, unsigned k, unsigned nkt) { return ((r >> 7) * nkt + (k >> 6)) * 8192u + ((r & 127u) << 6) + (k & 63u); }
DI float* xptr(const Params& p, int r) { return r < RL ? p.out + (size_t)r * D : (float*)(p.ws + OFF_XC) + (size_t)(r - RL) * D; }
DI int modrow(int r) { return r < RL ? (r >> 12) : 4; }
DI bf16x8 tr8(const char* lo, const char* hi) {
  s16x4 a = __builtin_amdgcn_ds_read_tr16_b64_v4i16((s16x4 __attribute__((address_space(3)))*)(lo));
  s16x4 b = __builtin_amdgcn_ds_read_tr16_b64_v4i16((s16x4 __attribute__((address_space(3)))*)(hi));
  return __builtin_shufflevector(a, b, 0, 1, 2, 3, 4, 5, 6, 7);
}


#define XB_TMO      128
#define XB_XCNT(j)  (256  + 64 * (j))
#define XB_XSUB(j)  (1280 + 64 * (j))
#define XB_XGEN(j)  (2304 + 64 * (j))
#define XB_TOP      3328
#define XB_TOPGEN   3392
#define XCD_BAR_WORDS 3456
#define XB_SPIN_CAP (1u << 22)
#define LAS __attribute__((address_space(3)))
DI unsigned xb_ld(unsigned* p) { return __hip_atomic_load(p, __ATOMIC_RELAXED, __HIP_MEMORY_SCOPE_AGENT); }
DI unsigned xb_add(unsigned* p, unsigned v) { return __hip_atomic_fetch_add(p, v, __ATOMIC_RELAXED, __HIP_MEMORY_SCOPE_AGENT); }
DI unsigned xb_xcc_id() { return (unsigned)__builtin_amdgcn_s_getreg((3 << 11) | 20) & 0xFu; }
#define XB_SPIN(cond, bar) do { unsigned _sp = 0; while (cond) { __builtin_amdgcn_s_sleep(1); \
    if ((++_sp & 255u) == 0u) { if (xb_ld(&(bar)[XB_TMO])) break; if (_sp > XB_SPIN_CAP) { atomicAdd(&(bar)[XB_TMO], 1u); break; } } } } while (0)
struct XcdBarrier { unsigned* bar; unsigned x; volatile LAS unsigned* st; };
DI XcdBarrier xcd_barrier_post(unsigned* bar, volatile LAS unsigned* st) {
  XcdBarrier b; b.bar = bar; b.x = xb_xcc_id(); b.st = st;
  if (threadIdx.x == 0) (void)xb_add(&bar[XB_XCNT(b.x)], 1u);
  return b;
}
DI void xcd_barrier_complete(unsigned* bar, unsigned x, unsigned& nloc, unsigned& nx) {
  const unsigned G = gridDim.x * gridDim.y * gridDim.z;
  unsigned sum, cnt, mine, sp = 0u;
  for (;;) {
    sum = 0u; cnt = 0u; mine = 0u;
#pragma unroll
    for (unsigned j = 0; j < 16; ++j) { const unsigned c = xb_ld(&bar[XB_XCNT(j)]); sum += c; cnt += (c > 0u) ? 1u : 0u; mine = (j == x) ? c : mine; }
    if (sum == G) break;
    __builtin_amdgcn_s_sleep(1);
    if ((++sp & 255u) == 0u) { if (xb_ld(&bar[XB_TMO])) break; if (sp > XB_SPIN_CAP) { atomicAdd(&bar[XB_TMO], 1u); break; } }
  }
  nloc = mine > 0u ? mine : 1u; nx = cnt > 0u ? cnt : 1u;
}
DI void xcd_barrier(const XcdBarrier& b) {
  asm volatile("s_waitcnt vmcnt(0)" ::: "memory");
  __syncthreads();
  if (threadIdx.x == 0) {
    unsigned* bar = b.bar;
    __builtin_amdgcn_s_waitcnt(0);
    unsigned nloc = b.st[0], nx = b.st[1];
    if (nloc == 0u) { xcd_barrier_complete(bar, b.x, nloc, nx); b.st[0] = nloc; b.st[1] = nx; }
    const unsigned old = xb_add(&bar[XB_XSUB(b.x)], 1u);
    const unsigned gen = old / nloc;
    if (old + 1u == (gen + 1u) * nloc) {
      __builtin_amdgcn_fence(__ATOMIC_RELEASE, "agent");
      asm volatile("s_waitcnt vmcnt(0)" ::: "memory");
      const unsigned og = xb_add(&bar[XB_TOP], 1u);
      const unsigned tg = og / nx;
      if (og + 1u == (tg + 1u) * nx) xb_add(&bar[XB_TOPGEN], 1u);
      else XB_SPIN(xb_ld(&bar[XB_TOPGEN]) == tg, bar);
      __builtin_amdgcn_fence(__ATOMIC_ACQUIRE, "agent");
      xb_add(&bar[XB_XGEN(b.x)], 1u);
      asm volatile("s_waitcnt vmcnt(0)" ::: "memory");
    } else {
      XB_SPIN(xb_ld(&bar[XB_XGEN(b.x)]) == gen, bar);
      __builtin_amdgcn_fence(__ATOMIC_ACQUIRE, "agent");
      asm volatile("s_waitcnt vmcnt(0)" ::: "memory");
    }
  }
  __syncthreads();
}

DI int src_col(int perm, int r) {
  if (perm == 0) return r;
  if (perm == 1) { int grp = r >> 6, j = r & 63; return j < 32 ? grp * 32 + j : DFF + grp * 32 + (j - 32); }
  if (r < 4096) return r;
  if (r < 4800) return r + 16;
  if (r < 4816) return r - 704;
  if (r < 4864) return -1;
  return r - 48;
}

DI void convert_tile(const float* __restrict__ W, int Nsrc, int K, int perm, u16* __restrict__ Wt, int tile, char* smem) {
  const int nkt = K >> 6;
  const int rt = tile / nkt, kt = tile - rt * nkt;
  const int r0 = rt * 32, k0 = kt * 64;
  u16* t = (u16*)smem;
  const int tid = tidx();
  {
    const int j = tid & 31, i = tid >> 5;
    const int sc = src_col(perm, r0 + j);
#pragma unroll
    for (int s = 0; s < 8; ++s) {
      const int k = i + 8 * s;
      float v = sc >= 0 ? W[(size_t)(k0 + k) * Nsrc + sc] : 0.f;
      t[j * 72 + k] = f2bf(v);
    }
  }
  __syncthreads();
  {
    const int row = tid >> 3, c8 = tid & 7;
    uint4 v = *(const uint4*)(t + row * 72 + c8 * 8);
    *(uint4*)(Wt + bko(r0 + row, k0 + c8 * 8, K >> 6)) = v;
  }
  __syncthreads();
}

DI void convert_range(const Params& p, int l, char* smem, int t0, int t1, int tstep) {
  u16* wb = (u16*)(p.ws + OFF_WB) + (size_t)(l & 1) * WB_END;
  constexpr int T_UP = (2 * DFF / 32) * (D / 64);
  constexpr int T_DN = (D / 32) * (DFF / 64);
  constexpr int T_IN = (ZW / 32) * (D / 64);
  constexpr int T_UQ = (1536 / 32) * (384 / 64);
  constexpr int T_UKV = (2048 / 32) * (256 / 64);
  constexpr int T_SQ = (D / 32) * (D / 64);
  constexpr int C1 = T_UP, C2 = C1 + T_DN, C3 = C2 + T_UP, C4 = C3 + T_DN, C5 = C4 + T_IN, C6 = C5 + T_UQ, C7 = C6 + T_UKV,
                C8 = C7 + T_SQ, C9 = C8 + T_SQ, C10 = C9 + T_SQ;
  if (t1 > C10) t1 = C10;
  for (int t = t0; t < t1; t += tstep) {
    if (t < C1) convert_tile(p.w_ff1_up + (size_t)l * D * 2 * DFF, 2 * DFF, D, 1, wb + WB_UP1, t, smem);
    else if (t < C2) convert_tile(p.w_ff1_dn + (size_t)l * DFF * D, D, DFF, 0, wb + WB_DN1, t - C1, smem);
    else if (t < C3) convert_tile(p.w_ff2_up + (size_t)l * D * 2 * DFF, 2 * DFF, D, 1, wb + WB_UP2, t - C2, smem);
    else if (t < C4) convert_tile(p.w_ff2_dn + (size_t)l * DFF * D, D, DFF, 0, wb + WB_DN2, t - C3, smem);
    else if (t < C5) convert_tile(p.w_in + (size_t)l * D * INW, INW, D, 2, wb + WB_IN, t - C4, smem);
    else if (t < C6) convert_tile(p.w_uq + (size_t)l * 384 * 1536, 1536, 384, 0, wb + WB_UQ, t - C5, smem);
    else if (t < C7) convert_tile(p.w_ukv + (size_t)l * 256 * 2048, 2048, 256, 0, wb + WB_UKV, t - C6, smem);
    else if (t < C8) convert_tile(p.w_bm + (size_t)l * D * D, D, D, 0, wb + WB_BM, t - C7, smem);
    else if (t < C9) convert_tile(p.w_ba + (size_t)l * D * D, D, D, 0, wb + WB_BA, t - C8, smem);
    else convert_tile(p.w_out + (size_t)l * D * D, D, D, 0, wb + WB_OUT, t - C9, smem);
  }
}
constexpr int CONV_TILES = 13984;
constexpr int CONV_PER_TASK = 16;
constexpr int NCONV = (CONV_TILES + CONV_PER_TASK - 1) / CONV_PER_TASK;
DI void phase_convert(const Params& p, int l, char* smem, int bid, int nb) { convert_range(p, l, smem, bid, CONV_TILES, nb); }

DI void phase_init(const Params& p, char* smem, int bid, int nb) {
  const int tid = tidx(), lane = tid & 63, wid = tid >> 6;
  {
    const float4* xs = (const float4*)p.x; float4* xd = (float4*)p.out;
    const size_t n4 = (size_t)RL * D / 4;
    for (size_t i = (size_t)bid * 256 + tid; i < n4; i += (size_t)nb * 256) xd[i] = xs[i];
    const float4* cs = (const float4*)p.ctx; float4* cd = (float4*)(p.ws + OFF_XC);
    const size_t m4 = (size_t)RC * D / 4;
    for (size_t i = (size_t)bid * 256 + tid; i < m4; i += (size_t)nb * 256) cd[i] = cs[i];
  }
  {
    float2* tab = (float2*)(p.ws + OFF_ROPE);
    for (int idx = bid * 256 + tid; idx < SEQ * 32; idx += nb * 256) {
      const int t = idx >> 5, i = idx & 31, f = i & 15;
      const float pos = (float)(i < 16 ? (t >> 6) : (t & 63));
      const float inv = powf(10000.f, -(float)(2 * f) / 32.f);
      const float ang = pos * inv;
      tab[idx] = make_float2(cosf(ang), sinf(ang));
    }
  }
  float* sc = (float*)smem;
  float* red = sc + 5 * D;
  for (int i = tid; i < 5 * D; i += 256) {
    const int row = i >> 10, k = i & 1023;
    const float v = row < 4 ? p.c[row * D + k] : p.c_ctx[k];
    sc[i] = siluf(v);
  }
  __syncthreads();
  float* mods = (float*)(p.ws + OFF_MODS);
  constexpr int NG = NMOD * D / 64;
  for (int t = bid; t < NL * NG; t += nb) {
    const int l = t / NG, n = (t - l * NG) * 64 + lane;
    const float* w = p.w_ada + (size_t)l * D * NMOD * D + n;
    float a0 = 0, a1 = 0, a2 = 0, a3 = 0, a4 = 0;
    const int kb = wid * 256;
#pragma unroll 8
    for (int k = 0; k < 256; ++k) {
      const float wv = w[(size_t)(kb + k) * (NMOD * D)];
      a0 += sc[kb + k] * wv; a1 += sc[D + kb + k] * wv; a2 += sc[2 * D + kb + k] * wv; a3 += sc[3 * D + kb + k] * wv; a4 += sc[4 * D + kb + k] * wv;
    }
    red[(wid * 5 + 0) * 64 + lane] = a0; red[(wid * 5 + 1) * 64 + lane] = a1; red[(wid * 5 + 2) * 64 + lane] = a2;
    red[(wid * 5 + 3) * 64 + lane] = a3; red[(wid * 5 + 4) * 64 + lane] = a4;
    __syncthreads();
    for (int i = tid; i < 320; i += 256) {
      const int row = i >> 6, ln = i & 63;
      const int nn = (t - l * NG) * 64 + ln;
      float s = red[(0 * 5 + row) * 64 + ln] + red[(1 * 5 + row) * 64 + ln] + red[(2 * 5 + row) * 64 + ln] + red[(3 * 5 + row) * 64 + ln];
      mods[((size_t)l * 5 + row) * (NMOD * D) + nn] = s + p.b_ada[(size_t)l * NMOD * D + nn];
    }
    __syncthreads();
  }
}

DI void phase_norm(const Params& p, int nrows, const float* __restrict__ g, const float* __restrict__ mods_l, int shift_idx, int scale_idx, u16* __restrict__ an, int bid, int nb) {
  const int tid_ = tidx(), lane = tid_ & 63, wid = tid_ >> 6;
  for (int r = bid * 4 + wid; r < nrows; r += nb * 4) {
    const float* x = xptr(p, r);
    float4 v[4]; float ss = 0.f;
#pragma unroll
    for (int i = 0; i < 4; ++i) { v[i] = *(const float4*)(x + i * 256 + lane * 4); ss += v[i].x * v[i].x + v[i].y * v[i].y + v[i].z * v[i].z + v[i].w * v[i].w; }
    ss = wave_sum(ss);
    const float rstd = rsqrtf(ss * (1.f / D) + EPS);
    const float* md = mods_l + (size_t)modrow(r) * (NMOD * D);
#pragma unroll
    for (int i = 0; i < 4; ++i) {
      const int col = i * 256 + lane * 4;
      const float4 g4 = *(const float4*)(g + col);
      const float4 sh = *(const float4*)(md + shift_idx * D + col);
      const float4 sc = *(const float4*)(md + scale_idx * D + col);
      const float y0 = v[i].x * rstd * g4.x * (1.f + sc.x) + sh.x;
      const float y1 = v[i].y * rstd * g4.y * (1.f + sc.y) + sh.y;
      const float y2 = v[i].z * rstd * g4.z * (1.f + sc.z) + sh.z;
      const float y3 = v[i].w * rstd * g4.w * (1.f + sc.w) + sh.w;
      uint2 o; o.x = pk2(y0, y1); o.y = pk2(y2, y3);
      *(uint2*)(an + bko(r, col, D / 64)) = o;
    }
  }
}

DI void phase_final(const Params& p, int bid, int nb) {
  const int tid_ = tidx(), lane = tid_ & 63, wid = tid_ >> 6;
  for (int r = bid * 4 + wid; r < RL; r += nb * 4) {
    float* x = p.out + (size_t)r * D;
    float4 v[4]; float ss = 0.f;
#pragma unroll
    for (int i = 0; i < 4; ++i) { v[i] = *(const float4*)(x + i * 256 + lane * 4); ss += v[i].x * v[i].x + v[i].y * v[i].y + v[i].z * v[i].z + v[i].w * v[i].w; }
    ss = wave_sum(ss);
    const float rstd = rsqrtf(ss * (1.f / D) + EPS);
#pragma unroll
    for (int i = 0; i < 4; ++i) {
      const int col = i * 256 + lane * 4;
      const float4 g4 = *(const float4*)(p.g_final + col);
      float4 o; o.x = v[i].x * rstd * g4.x; o.y = v[i].y * rstd * g4.y; o.z = v[i].z * rstd * g4.z; o.w = v[i].w * rstd * g4.w;
      *(float4*)(x + col) = o;
    }
  }
}

constexpr int GSTR = 128;
constexpr int GBUF = 128 * GSTR;

#define G_PARAMS uint4 &ra00, uint4 &ra01, uint4 &ra02, uint4 &ra03, uint4 &rb00, uint4 &rb01, uint4 &rb02, uint4 &rb03, \
                 uint4 &ra10, uint4 &ra11, uint4 &ra12, uint4 &ra13, uint4 &rb10, uint4 &rb11, uint4 &rb12, uint4 &rb13
#define G_DECL uint4 g_a00, g_a01, g_a02, g_a03, g_b00, g_b01, g_b02, g_b03, g_a10, g_a11, g_a12, g_a13, g_b10, g_b11, g_b12, g_b13
#define G_ARGS g_a00, g_a01, g_a02, g_a03, g_b00, g_b01, g_b02, g_b03, g_a10, g_a11, g_a12, g_a13, g_b10, g_b11, g_b12, g_b13
#define G_L1(S, i, kt) ra##S##i = *(const uint4*)(ap + (size_t)(kt) * 8192 + i * 2048); rb##S##i = *(const uint4*)(bp + (size_t)(kt) * 8192 + i * 2048);
#define G_LOAD(S, kt) { G_L1(S, 0, kt) G_L1(S, 1, kt) G_L1(S, 2, kt) G_L1(S, 3, kt) }
#define G_S1(S, i, buf) *(uint4*)(sA + (buf) * GBUF + soff + i * 32 * GSTR) = ra##S##i; *(uint4*)(sB + (buf) * GBUF + soff + i * 32 * GSTR) = rb##S##i;
#define G_STORE(S, buf) { G_S1(S, 0, buf) G_S1(S, 1, buf) G_S1(S, 2, buf) G_S1(S, 3, buf) }
DI void gemm_prefetch(G_PARAMS, const u16* __restrict__ A, int lda, const u16* __restrict__ Bt, int ldb, int m0, int n0) {
  const int tid = tidx();
  const int lr = tid >> 3, lc = tid & 7;
  const u16* ap = A + (size_t)((m0 >> 7) * (lda >> 6)) * 8192 + lr * 64 + lc * 8;
  const u16* bp = Bt + (size_t)((n0 >> 7) * (ldb >> 6)) * 8192 + lr * 64 + lc * 8;
  G_LOAD(0, 0)
  G_LOAD(1, 1)
}
DI void gemm_mainloop(G_PARAMS, const u16* __restrict__ A, int lda, const u16* __restrict__ Bt, int ldb, int nk, int m0, int n0, f32x4 (&acc)[4][4], char* smem) {
  const int tid = tidx(), lane = tid & 63, wid = tid >> 6, wr = wid >> 1, wc = wid & 1;
  const int lr = tid >> 3, lc = tid & 7;
  const u16* ap = A + (size_t)((m0 >> 7) * (lda >> 6)) * 8192 + lr * 64 + lc * 8;
  const u16* bp = Bt + (size_t)((n0 >> 7) * (ldb >> 6)) * 8192 + lr * 64 + lc * 8;
#define G_COMPUTE(buf) { const char* cA = sA + (buf) * GBUF; const char* cB = sB + (buf) * GBUF; \
    _Pragma("unroll") for (int ks = 0; ks < 2; ++ks) { \
      bf16x8 a[4], b[4]; \
      _Pragma("unroll") for (int m = 0; m < 4; ++m) a[m] = *(const bf16x8*)(cA + (aoff ^ (ks * 64)) + m * 16 * GSTR); \
      _Pragma("unroll") for (int n = 0; n < 4; ++n) b[n] = *(const bf16x8*)(cB + (boff ^ (ks * 64)) + n * 16 * GSTR); \
      _Pragma("unroll") for (int m = 0; m < 4; ++m) _Pragma("unroll") for (int n = 0; n < 4; ++n) acc[m][n] = MFMA16(b[n], a[m], acc[m][n]); \
    } }
  char* sA = smem; char* sB = smem + 2 * GBUF;
  const int soff = lr * GSTR + ((lc ^ ((lr >> 1) & 7)) << 4);
  const int fr = lane & 15, fq = lane >> 4;
  const int swz = (fq ^ ((fr >> 1) & 7)) << 4;
  const int aoff = (wr * 64 + fr) * GSTR + swz;
  const int boff = (wc * 64 + fr) * GSTR + swz;
  uint4 ra20, ra21, ra22, ra23, rb20, rb21, rb22, rb23;
  if (2 < nk) G_LOAD(2, 2)
  G_STORE(0, 0)
  __syncthreads();
  if (3 < nk) G_LOAD(0, 3)
#define G_STEP(i, SN, BN) if (kt + (i) < nk) { \
    G_COMPUTE((i) & 1) \
    if (kt + (i) + 1 < nk) G_STORE(SN, BN) \
    __syncthreads(); \
    if (kt + (i) + 4 < nk) G_LOAD(SN, kt + (i) + 4) }
  for (int kt = 0; kt < nk; kt += 6) {
    G_STEP(0, 1, 1)
    G_STEP(1, 2, 0)
    G_STEP(2, 0, 1)
    G_STEP(3, 1, 0)
    G_STEP(4, 2, 1)
    G_STEP(5, 0, 0)
  }
#undef G_STEP
#undef G_COMPUTE
}
#undef G_L1
#undef G_S1
#undef G_LOAD
#undef G_STORE

DI int vbid(int bid, int nb) { return bid; }
DI void tile_of(int tile, int ntn, int& mt, int& nt) {
  const int gm = tile / (4 * ntn), rem = tile - gm * 4 * ntn;
  nt = rem >> 2; mt = gm * 4 + (rem & 3);
}
#define ZERO_ACC(acc) _Pragma("unroll") for (int m_ = 0; m_ < 4; ++m_) _Pragma("unroll") for (int n_ = 0; n_ < 4; ++n_) acc[m_][n_] = f32x4{0.f, 0.f, 0.f, 0.f}

constexpr int ST16 = 272;
constexpr int ST32 = 528;
DI void stage_bf16(const f32x4 (&acc)[4][4], char* st, int wr, int wc, int fr, int fq) {
#pragma unroll
  for (int m = 0; m < 4; ++m)
#pragma unroll
    for (int n = 0; n < 4; ++n) {
      uint2 v; v.x = pk2(acc[m][n][0], acc[m][n][1]); v.y = pk2(acc[m][n][2], acc[m][n][3]);
      *(uint2*)(st + (wr * 64 + 16 * m + fr) * ST16 + (wc * 64 + 16 * n + 4 * fq) * 2) = v;
    }
}
DI void stage_f32(const f32x4 (&acc)[4][4], char* st, int wr, int wc, int fr, int fq) {
#pragma unroll
  for (int m = 0; m < 4; ++m)
#pragma unroll
    for (int n = 0; n < 4; ++n) *(f32x4*)(st + (wr * 64 + 16 * m + fr) * ST32 + (wc * 64 + 16 * n + 4 * fq) * 4) = acc[m][n];
}

DI void phase_ffn_up(const Params& p, int mtn, const u16* an, const u16* wt, u16* h, char* smem, int bid, int nb) {
  constexpr int NTN = 2 * DFF / 128;
  G_DECL;
  { int tile = vbid(bid, nb); if (tile < mtn * NTN) { int mt, nt; tile_of(tile, NTN, mt, nt); gemm_prefetch(G_ARGS, an, D, wt, D, mt * 128, nt * 128); } }
  for (int tile = vbid(bid, nb); tile < mtn * NTN; tile += nb) {
    int mt, nt; tile_of(tile, NTN, mt, nt);
    f32x4 acc[4][4]; ZERO_ACC(acc);
    gemm_mainloop(G_ARGS, an, D, wt, D, D / 64, mt * 128, nt * 128, acc, smem);
    if (tile + nb < mtn * NTN) { int mt2, nt2; tile_of(tile + nb, NTN, mt2, nt2); gemm_prefetch(G_ARGS, an, D, wt, D, mt2 * 128, nt2 * 128); }
    const int tid = tidx(), lane = tid & 63, wid = tid >> 6, wr = wid >> 1, wc = wid & 1, fr = lane & 15, fq = lane >> 4;
#pragma unroll
    for (int m = 0; m < 4; ++m)
#pragma unroll
      for (int n = 0; n < 2; ++n) {
        float o[4];
#pragma unroll
        for (int r = 0; r < 4; ++r) o[r] = siluf(acc[m][n][r]) * acc[m][n + 2][r];
        uint2 v; v.x = pk2(o[0], o[1]); v.y = pk2(o[2], o[3]);
        *(uint2*)(smem + (wr * 64 + 16 * m + fr) * ST16 + (wc * 32 + 16 * n + 4 * fq) * 2) = v;
      }
    __syncthreads();
    const unsigned rbase = mt * 128, cbase = nt * 64;
#pragma unroll
    for (int i = 0; i < 4; ++i) {
      const unsigned id = tid + 256 * i, row = id >> 3, ch = id & 7;
      const uint4 v = *(const uint4*)(smem + row * ST16 + ch * 16);
      *(uint4*)(h + bko(rbase + row, cbase + ch * 8, DFF / 64)) = v;
    }
    __syncthreads();
  }
}

DI void phase_gemm_resid(const Params& p, int mtn, const u16* a, int K, const u16* wt, const float* mods_l, int gate_idx, float coef, char* smem, int bid, int nb) {
  constexpr int NTN = D / 128;
  G_DECL;
  { int tile = vbid(bid, nb); if (tile < mtn * NTN) { int mt, nt; tile_of(tile, NTN, mt, nt); gemm_prefetch(G_ARGS, a, K, wt, K, mt * 128, nt * 128); } }
  for (int tile = vbid(bid, nb); tile < mtn * NTN; tile += nb) {
    int mt, nt; tile_of(tile, NTN, mt, nt);
    f32x4 acc[4][4]; ZERO_ACC(acc);
    gemm_mainloop(G_ARGS, a, K, wt, K, K / 64, mt * 128, nt * 128, acc, smem);
    if (tile + nb < mtn * NTN) { int mt2, nt2; tile_of(tile + nb, NTN, mt2, nt2); gemm_prefetch(G_ARGS, a, K, wt, K, mt2 * 128, nt2 * 128); }
    const int tid = tidx(), lane = tid & 63, wid = tid >> 6, wr = wid >> 1, wc = wid & 1, fr = lane & 15, fq = lane >> 4;
    stage_f32(acc, smem, wr, wc, fr, fq);
    __syncthreads();
    const int r0 = mt * 128;
    const float* md = mods_l + (size_t)modrow(r0) * (NMOD * D) + gate_idx * D + nt * 128;
    float* xb = xptr(p, r0) + nt * 128;
    const unsigned ch = tid & 31;
    const float4 g4 = *(const float4*)(md + ch * 4);
#pragma unroll 4
    for (int i = 0; i < 16; ++i) {
      const unsigned row = (tid >> 5) + 8 * i;
      const float4 v = *(const float4*)(smem + row * ST32 + ch * 16);
      float4* xp = (float4*)(xb + row * (unsigned)D + ch * 4);
      float4 x = *xp;
      x.x += coef * g4.x * v.x; x.y += coef * g4.y * v.y; x.z += coef * g4.z * v.z; x.w += coef * g4.w * v.w;
      *xp = x;
    }
    __syncthreads();
  }
}

DI void phase_inproj(const Params& p, int l, const u16* an, const u16* wt, char* smem, int bid, int nb) {
  constexpr int NTN = ZW / 128;
  char* ws = p.ws;
  G_DECL;
  { int tile = vbid(bid, nb); if (tile < MT * NTN) { int mt, nt; tile_of(tile, NTN, mt, nt); gemm_prefetch(G_ARGS, an, D, wt, D, mt * 128, nt * 128); } }
  for (int tile = vbid(bid, nb); tile < MT * NTN; tile += nb) {
    int mt, nt; tile_of(tile, NTN, mt, nt);
    f32x4 acc[4][4]; ZERO_ACC(acc);
    gemm_mainloop(G_ARGS, an, D, wt, D, D / 64, mt * 128, nt * 128, acc, smem);
    if (tile + nb < MT * NTN) { int mt2, nt2; tile_of(tile + nb, NTN, mt2, nt2); gemm_prefetch(G_ARGS, an, D, wt, D, mt2 * 128, nt2 * 128); }
    const int tid = tidx(), lane = tid & 63, wid = tid >> 6, wr = wid >> 1, wc = wid & 1, fr = lane & 15, fq = lane >> 4;
    if (nt == 37) {
      if (wc == 0) {
        u16* zkr = (u16*)(ws + OFF_ZKR);
#pragma unroll
        for (int m = 0; m < 4; ++m)
#pragma unroll
          for (int n = 0; n < 4; ++n) {
            const unsigned row = mt * 128 + wr * 64 + 16 * m + fr;
            uint2 v; v.x = pk2(acc[m][n][0], acc[m][n][1]); v.y = pk2(acc[m][n][2], acc[m][n][3]);
            *(uint2*)(zkr + row * 64u + 16 * n + 4 * fq) = v;
          }
      } else {
        float* zg = (float*)(ws + OFF_ZG);
        const float4 b4 = *(const float4*)(p.b_gate + l * 16 + 4 * fq);
#pragma unroll
        for (int m = 0; m < 4; ++m) {
          const unsigned row = mt * 128 + wr * 64 + 16 * m + fr;
          float4 v; v.x = acc[m][0][0] + b4.x; v.y = acc[m][0][1] + b4.y; v.z = acc[m][0][2] + b4.z; v.w = acc[m][0][3] + b4.w;
          *(float4*)(zg + row * 16u + 4 * fq) = v;
        }
      }
      continue;
    }
    stage_bf16(acc, smem, wr, wc, fr, fq);
    __syncthreads();
    const int c = nt * 128;
    u16* dst; unsigned ld, c0;
    if (c < 4096) { dst = (u16*)(ws + OFF_ZQ) + (size_t)(c >> 10) * R * D; ld = D; c0 = c & 1023; }
    else if (c < 4480) { dst = (u16*)(ws + OFF_ZCQ); ld = 384; c0 = c - 4096; }
    else if (c < 4736) { dst = (u16*)(ws + OFF_ZCKV); ld = 256; c0 = c - 4480; }
    else { dst = (u16*)(ws + OFF_ZBR); ld = 2048; c0 = c - 4864; }
    const unsigned rbase = mt * 128;
#pragma unroll
    for (int i = 0; i < 8; ++i) {
      const unsigned id = tid + 256 * i, row = id >> 4, ch = id & 15;
      const uint4 v = *(const uint4*)(smem + row * ST16 + ch * 16);
      *(uint4*)(dst + (rbase + row) * ld + c0 + ch * 8) = v;
    }
    __syncthreads();
  }
}

DI void phase_prep(const Params& p, int l, int bid, int nb) {
  const int tid_ = tidx(), lane = tid_ & 63, wid = tid_ >> 6;
  char* ws = p.ws;
  const u16* zq = (const u16*)(ws + OFF_ZQ); const u16* zk = (const u16*)(ws + OFF_ZK);
  u16* qc = (u16*)(ws + OFF_AN); u16* kc = (u16*)(ws + OFF_KC);
  const float* wcv = p.w_conv + (size_t)l * 3 * 2048;
  const float2* tab = (const float2*)(ws + OFF_ROPE);
  for (int r = bid * 4 + wid; r < R; r += nb * 4) {
    int t, T;
    if (r < RL) { t = r & 4095; T = SEQ; } else { t = (r - RL) & 255; T = CTX; }
    const bool hp = t > 0, hn = t < T - 1;
#pragma unroll
    for (int c4 = 0; c4 < 4; ++c4) {
      const int ch = c4 * 512 + lane * 8;
      const bool isq = ch < 1024;
      const u16* src = isq ? zq : zk;
      const int cc = isq ? ch : ch - 1024;
      const uint4 zero = make_uint4(0, 0, 0, 0);
      const uint4 vc = *(const uint4*)(src + (size_t)r * D + cc);
      const uint4 vp = hp ? *(const uint4*)(src + (size_t)(r - 1) * D + cc) : zero;
      const uint4 vn = hn ? *(const uint4*)(src + (size_t)(r + 1) * D + cc) : zero;
      const unsigned pc[4] = {vc.x, vc.y, vc.z, vc.w}, pp[4] = {vp.x, vp.y, vp.z, vp.w}, pn[4] = {vn.x, vn.y, vn.z, vn.w};
      float o[8];
#pragma unroll
      for (int e = 0; e < 8; ++e) {
        const int sh = (e & 1) * 16;
        const float xc = bf2f((u16)(pc[e >> 1] >> sh)), xp = bf2f((u16)(pp[e >> 1] >> sh)), xn = bf2f((u16)(pn[e >> 1] >> sh));
        const float w0 = wcv[ch + e], w1 = wcv[2048 + ch + e], w2 = wcv[4096 + ch + e];
        float y = siluf(xp * w0 + xc * w1 + xn * w2);
        o[e] = isq ? y * 0.0625f : y;
      }
      uint4 ov; ov.x = pk2(o[0], o[1]); ov.y = pk2(o[2], o[3]); ov.z = pk2(o[4], o[5]); ov.w = pk2(o[6], o[7]);
      *(uint4*)((isq ? qc : kc) + (size_t)r * D + cc) = ov;
    }
    {
      const u16* z = (const u16*)(ws + OFF_ZCQ) + (size_t)r * 384;
      float v[6]; float ss = 0.f;
#pragma unroll
      for (int i = 0; i < 6; ++i) { v[i] = bf2f(z[lane + 64 * i]); ss += v[i] * v[i]; }
      ss = wave_sum(ss);
      const float rstd = rsqrtf(ss * (1.f / 384.f) + EPS);
      u16* o = (u16*)(ws + OFF_CQN);
#pragma unroll
      for (int i = 0; i < 6; ++i) o[bko(r, lane + 64 * i, 6)] = f2bf(v[i] * rstd * p.g_qa[l * 384 + lane + 64 * i]);
    }
    {
      const u16* z = (const u16*)(ws + OFF_ZCKV) + (size_t)r * 256;
      float v[4]; float ss = 0.f;
#pragma unroll
      for (int i = 0; i < 4; ++i) { v[i] = bf2f(z[lane + 64 * i]); ss += v[i] * v[i]; }
      ss = wave_sum(ss);
      const float rstd = rsqrtf(ss * (1.f / 256.f) + EPS);
      u16* o = (u16*)(ws + OFF_CKVN);
#pragma unroll
      for (int i = 0; i < 4; ++i) o[bko(r, lane + 64 * i, 4)] = f2bf(v[i] * rstd * p.g_kva[l * 256 + lane + 64 * i]);
    }
    {
      const float v = bf2f(((const u16*)(ws + OFF_ZKR))[(size_t)r * 64 + lane]);
      const float pv = __shfl_xor(v, 1);
      float o = v;
      if (r < RL) {
        const float2 cs = tab[t * 32 + (lane >> 1)];
        o = (lane & 1) ? (pv * cs.y + v * cs.x) : (v * cs.x - pv * cs.y);
      }
      ((u16*)(ws + OFF_KROPE))[(size_t)r * 64 + lane] = f2bf(o);
    }
  }
  {
    const float* zg = (const float*)(ws + OFF_ZG);
    for (int item = bid * 4 + wid; item < 32 * NCH; item += nb * 4) {
      const int stream = item / NCH, n = item - stream * NCH;
      const int b = stream >> 3, hd = (stream >> 1) & 3, dir = stream & 1;
      int base, T, cc;
      if (n < 4) { base = RL + b * CTX; T = CTX; cc = n; } else { base = b * SEQ; T = SEQ; cc = n - 4; }
      const int pos = cc * 64 + lane;
      const int row = base + (dir ? T - 1 - pos : pos);
      const float ig = zg[(size_t)row * 16 + dir * 8 + hd];
      const float fg = zg[(size_t)row * 16 + dir * 8 + 4 + hd];
      const float lf = fminf(fg, 0.f) - log1pf(__expf(-fabsf(fg)));
      float bc = lf;
#pragma unroll
      for (int d = 1; d < 64; d <<= 1) { const float tt = __shfl_up(bc, d); if (lane >= d) bc += tt; }
      const float bL = __shfl(bc, 63);
      const float wv = ig - bc;
      float pm = wv;
#pragma unroll
      for (int d = 1; d < 64; d <<= 1) { const float tt = __shfl_up(pm, d); if (lane >= d) pm = fmaxf(pm, tt); }
      const float endl = bL + wv;
      const float me = wave_max(endl);
      float* g = (float*)(ws + OFF_G) + ((size_t)stream * NCH + n) * 512;
      g[lane] = bc; g[64 + lane] = wv; g[128 + lane] = pm; g[192 + lane] = endl;
      if (lane == 0) { g[256] = bL; g[257] = me; }
    }
  }
}

DI void phase_upproj(const Params& p, const u16* wb, char* smem, int bid, int nb) {
  char* ws = p.ws;
  const float2* tab = (const float2*)(ws + OFF_ROPE);
  u16* qa = (u16*)(ws + OFF_H);
  u16* kv = (u16*)(ws + OFF_KV);
  constexpr int NQ = 12, NKV = 16;
  const int total = MT * (NQ + NKV);
  G_DECL;
#define UP_PREFETCH(T) { const int t_ = (T); if (t_ < MT * NQ) { int m_, n_; tile_of(t_, NQ, m_, n_); gemm_prefetch(G_ARGS, (const u16*)(ws + OFF_CQN), 384, wb + WB_UQ, 384, m_ * 128, n_ * 128); } \
    else if (t_ < total) { int m_, n_; tile_of(t_ - MT * NQ, NKV, m_, n_); gemm_prefetch(G_ARGS, (const u16*)(ws + OFF_CKVN), 256, wb + WB_UKV, 256, m_ * 128, n_ * 128); } }
  for (int tile = vbid(bid, nb); tile < total; tile += nb) {
    const bool isq = tile < MT * NQ;
    int mt, nt;
    f32x4 acc[4][4]; ZERO_ACC(acc);
    UP_PREFETCH(tile)
    if (isq) { tile_of(tile, NQ, mt, nt); gemm_mainloop(G_ARGS, (const u16*)(ws + OFF_CQN), 384, wb + WB_UQ, 384, 6, mt * 128, nt * 128, acc, smem); }
    else { tile_of(tile - MT * NQ, NKV, mt, nt); gemm_mainloop(G_ARGS, (const u16*)(ws + OFF_CKVN), 256, wb + WB_UKV, 256, 4, mt * 128, nt * 128, acc, smem); }
    const int tid = tidx(), lane = tid & 63, wid = tid >> 6, wr = wid >> 1, wc = wid & 1, fr = lane & 15, fq = lane >> 4;
    stage_bf16(acc, smem, wr, wc, fr, fq);
    __syncthreads();
    const unsigned rbase = mt * 128;
    if (isq) {
#pragma unroll
      for (int i = 0; i < 8; ++i) {
        const unsigned id = tid + 256 * i, row = id >> 4, ch = id & 15;
        uint4 v = *(const uint4*)(smem + row * ST16 + ch * 16);
        const unsigned col = nt * 128 + ch * 8, d0 = col % 192u, grow = rbase + row;
        if (d0 >= 128u && grow < (unsigned)RL) {
          const float4* tp = (const float4*)(tab + (grow & 4095u) * 32u + ((d0 - 128u) >> 1));
          const float4 t0 = tp[0], t1 = tp[1];
          float x0, x1;
          x0 = bf2f((u16)(v.x & 0xffff)); x1 = bf2f((u16)(v.x >> 16)); v.x = pk2(x0 * t0.x - x1 * t0.y, x0 * t0.y + x1 * t0.x);
          x0 = bf2f((u16)(v.y & 0xffff)); x1 = bf2f((u16)(v.y >> 16)); v.y = pk2(x0 * t0.z - x1 * t0.w, x0 * t0.w + x1 * t0.z);
          x0 = bf2f((u16)(v.z & 0xffff)); x1 = bf2f((u16)(v.z >> 16)); v.z = pk2(x0 * t1.x - x1 * t1.y, x0 * t1.y + x1 * t1.x);
          x0 = bf2f((u16)(v.w & 0xffff)); x1 = bf2f((u16)(v.w >> 16)); v.w = pk2(x0 * t1.z - x1 * t1.w, x0 * t1.w + x1 * t1.z);
        }
        *(uint4*)(qa + grow * 1536u + col) = v;
      }
    } else {
#pragma unroll
      for (int i = 0; i < 8; ++i) {
        const unsigned id = tid + 256 * i, row = id >> 4, ch = id & 15;
        const uint4 v = *(const uint4*)(smem + row * ST16 + ch * 16);
        *(uint4*)(kv + (rbase + row) * 2048u + nt * 128 + ch * 8) = v;
      }
    }
    __syncthreads();
  }
#undef UP_PREFETCH
}

constexpr int AKS = 400;
constexpr int AVS = 320;
DI void attn_task(const Params& p, int b, int h, int qrow0, int nkt, bool with_latent, char* smem) {
  const int tid = tidx(), lane = tid & 63, wid = tid >> 6, l31 = lane & 31, h2 = lane >> 5;
  char* ws = p.ws;
  const u16* qa = (const u16*)(ws + OFF_H);
  const u16* kvb = (const u16*)(ws + OFF_KV);
  const u16* krp = (const u16*)(ws + OFF_KROPE);
  u16* ao = (u16*)(ws + OFF_H) + (size_t)R * 1536;
  char* Ks = smem; char* Vs = smem + 64 * AKS;
  bf16x8 qf[12];
  {
    const u16* qp = qa + (size_t)(qrow0 + wid * 32 + l31) * 1536 + h * 192 + h2 * 8;
#pragma unroll
    for (int st = 0; st < 12; ++st) qf[st] = *(const bf16x8*)(qp + st * 16);
  }
  uint4 kreg0, kreg1, kreg2, kreg3, kreg4, kreg5, vreg0, vreg1, vreg2, vreg3;
#define KEY_ROW(kt, i) ((kt) < 4 ? (RL + b * CTX + (kt) * 64 + (i)) : (b * SEQ + ((kt) - 4) * 64 + (i)))
#define ATT_KL(kt, i) { const int id = tid + 256 * i, row = id / 24, ch = id - row * 24; const int kr = KEY_ROW(kt, row); \
    const u16* src = ch < 16 ? (kvb + (size_t)kr * 2048 + h * 256 + ch * 8) : (krp + (size_t)kr * 64 + (ch - 16) * 8); kreg##i = *(const uint4*)src; }
#define ATT_VL(kt, i) { const int id = tid + 256 * i, row = id >> 4, ch = id & 15; const int kr = KEY_ROW(kt, row); \
    vreg##i = *(const uint4*)(kvb + (size_t)kr * 2048 + h * 256 + 128 + ch * 8); }
#define ATT_GLOADK(kt) ATT_KL(kt, 0) ATT_KL(kt, 1) ATT_KL(kt, 2) ATT_KL(kt, 3) ATT_KL(kt, 4) ATT_KL(kt, 5)
#define ATT_GLOADV(kt) ATT_VL(kt, 0) ATT_VL(kt, 1) ATT_VL(kt, 2) ATT_VL(kt, 3)
#define ATT_GLOAD(kt) ATT_GLOADK(kt) ATT_GLOADV(kt)
#define ATT_KS(i) { const int id = tid + 256 * i, row = id / 24, ch = id - row * 24; *(uint4*)(Ks + row * AKS + ch * 16) = kreg##i; }
#define ATT_VS(i) { const int id = tid + 256 * i, row = id >> 4, ch = id & 15; *(uint4*)(Vs + row * AVS + ch * 16) = vreg##i; }
#define ATT_SSTORE() ATT_KS(0) ATT_KS(1) ATT_KS(2) ATT_KS(3) ATT_KS(4) ATT_KS(5) ATT_VS(0) ATT_VS(1) ATT_VS(2) ATT_VS(3)
  f32x16 o[4];
#pragma unroll
  for (int n = 0; n < 4; ++n)
#pragma unroll
    for (int i = 0; i < 16; ++i) o[n][i] = 0.f;
  float mrun = -1e30f, lrun = 0.f;
  const float sc = 0.07216878364870322f * 1.4426950408889634f;
  const int i16 = lane & 15, tq = i16 >> 2, tp = i16 & 3, blk = (lane >> 4) & 1;
  ATT_GLOAD(0)
  __syncthreads();
  ATT_SSTORE()
  __syncthreads();
  for (int kt = 0; kt < nkt; ++kt) {
    if (kt + 1 < nkt) { ATT_GLOADK(kt + 1) }
    f32x16 s0, s1;
#pragma unroll
    for (int i = 0; i < 16; ++i) { s0[i] = 0.f; s1[i] = 0.f; }
#pragma unroll
    for (int st = 0; st < 12; ++st) {
      const bf16x8 a0 = *(const bf16x8*)(Ks + l31 * AKS + st * 32 + h2 * 16);
      const bf16x8 a1 = *(const bf16x8*)(Ks + (32 + l31) * AKS + st * 32 + h2 * 16);
      s0 = MFMA32(a0, qf[st], s0);
      s1 = MFMA32(a1, qf[st], s1);
    }
    __builtin_amdgcn_sched_group_barrier(0x100, 4, 0);
#pragma unroll
    for (int i = 0; i < 10; ++i) { __builtin_amdgcn_sched_group_barrier(0x008, 2, 0); __builtin_amdgcn_sched_group_barrier(0x100, 2, 0); }
    __builtin_amdgcn_sched_group_barrier(0x008, 4, 0);
    __builtin_amdgcn_sched_barrier(0);
    float mx = s0[0];
#pragma unroll
    for (int i = 0; i < 16; ++i) { mx = fmaxf(mx, s0[i]); mx = fmaxf(mx, s1[i]); }
    mx = fmaxf(mx, __shfl_xor(mx, 32));
    const float mnew = fmaxf(mrun, mx * sc);
    const float alpha = __builtin_amdgcn_exp2f(mrun - mnew);
    mrun = mnew;
    float ls = 0.f;
#pragma unroll
    for (int i = 0; i < 16; ++i) { s0[i] = __builtin_amdgcn_exp2f(s0[i] * sc - mnew); s1[i] = __builtin_amdgcn_exp2f(s1[i] * sc - mnew); ls += s0[i] + s1[i]; }
    lrun = lrun * alpha + ls;
    if (__any(alpha != 1.f)) {
#pragma unroll
      for (int n = 0; n < 4; ++n)
#pragma unroll
        for (int i = 0; i < 16; ++i) o[n][i] *= alpha;
    }
    bf16x8 pbv[4];
#define ATT_PACK(SV, HH) \
    _Pragma("unroll") for (int s = 0; s < 2; ++s) { \
      u32x4 pu; \
      pu[0] = pk2(SV[8 * s + 0], SV[8 * s + 1]); pu[1] = pk2(SV[8 * s + 2], SV[8 * s + 3]); \
      pu[2] = pk2(SV[8 * s + 4], SV[8 * s + 5]); pu[3] = pk2(SV[8 * s + 6], SV[8 * s + 7]); \
      pbv[2 * HH + s] = __builtin_bit_cast(bf16x8, pu); \
    }
    ATT_PACK(s0, 0)
    ATT_PACK(s1, 1)
#undef ATT_PACK
    if (kt + 1 < nkt) { ATT_GLOADV(kt + 1) }
#pragma unroll
    for (int hs = 0; hs < 4; ++hs) {
      const char* vlo = Vs + (16 * hs + 4 * h2 + tq) * AVS + (16 * blk) * 2 + 8 * tp;
#pragma unroll
      for (int n = 0; n < 4; ++n) {
        const bf16x8 va = tr8(vlo + n * 64, vlo + n * 64 + 8 * AVS);
        o[n] = MFMA32(va, pbv[hs], o[n]);
      }
    }
    __syncthreads();
    if (kt + 1 < nkt) { ATT_SSTORE() }
    __syncthreads();
  }
  const float ltot = lrun + __shfl_xor(lrun, 32);
  const float inv = 1.f / ltot;
  const unsigned orow = qrow0 + wid * 32 + l31;
#pragma unroll
  for (int n = 0; n < 4; ++n)
#pragma unroll
    for (int g = 0; g < 4; ++g) {
      uint2 w; w.x = pk2(o[n][4 * g] * inv, o[n][4 * g + 1] * inv); w.y = pk2(o[n][4 * g + 2] * inv, o[n][4 * g + 3] * inv);
      *(uint2*)(ao + bko(orow, h * 128 + 32 * n + 8 * g + 4 * h2, D / 64)) = w;
    }
}

constexpr int MKS = 528;
constexpr int MVS = 112;
constexpr int M_CT = 64 * MKS;
constexpr int M_VS = M_CT + 48 * MKS;
constexpr int M_VW = M_VS + 64 * MVS;
constexpr int M_GS = 73728;
constexpr int M_MS = M_GS + 1536;
DI void mlstm_task(const Params& p, int task, char* smem) {
  const int tid = tidx(), lane = tid & 63, w = tid >> 6, fr = lane & 15, fq = lane >> 4, tq = fr >> 2, tp = fr & 3;
  const int stream = task >> 3, c = task & 7, b = stream >> 3, hd = (stream >> 1) & 3, dir = stream & 1;
  char* ws = p.ws;
  const u16* qc = (const u16*)(ws + OFF_AN); const u16* kc = (const u16*)(ws + OFF_KC); const u16* zv = (const u16*)(ws + OFF_ZV);
  const float* G = (const float*)(ws + OFF_G) + (size_t)stream * NCH * 512;
  _Float16* hout = (_Float16*)(ws + (dir ? OFF_ZK : OFF_ZQ));
  char* Ks = smem; char* Ct = smem + M_CT; char* Vs = smem + M_VS; char* Vw = smem + M_VW;
#define ROW_OF(n, pos) ((n) < 4 ? (RL + b * CTX + (dir ? CTX - 1 - ((n) * 64 + (pos)) : ((n) * 64 + (pos)))) : (b * SEQ + (dir ? SEQ - 1 - (((n) - 4) * 64 + (pos)) : (((n) - 4) * 64 + (pos)))))
  __syncthreads();
  for (int i = tid; i < 48 * MKS / 16; i += 256) ((uint4*)Ct)[i] = make_uint4(0, 0, 0, 0);
  f32x4 cacc[4][3];
#pragma unroll
  for (int kt = 0; kt < 4; ++kt)
#pragma unroll
    for (int vt = 0; vt < 3; ++vt) cacc[kt][vt] = f32x4{0.f, 0.f, 0.f, 0.f};
  uint4 kreg0, kreg1, kreg2, kreg3, kreg4, kreg5, kreg6, kreg7; uint4 vreg; float wreg; float4 greg = make_float4(0.f, 0.f, 0.f, 0.f);
#define M_KL(n, i) { const int id = tid + 256 * i, row = id >> 5, ch = id & 31; kreg##i = *(const uint4*)(kc + (size_t)ROW_OF(n, row) * D + hd * 256 + ch * 8); }
#define M_GLOAD(n) { M_KL(n, 0) M_KL(n, 1) M_KL(n, 2) M_KL(n, 3) M_KL(n, 4) M_KL(n, 5) M_KL(n, 6) M_KL(n, 7) \
    const int row_ = tid >> 2, part_ = tid & 3; \
    vreg = *(const uint4*)(zv + (size_t)ROW_OF(n, row_) * D + hd * 256 + c * 32 + part_ * 8); \
    wreg = G[(size_t)(n) * 512 + 192 + row_]; \
    if (tid < 64) { greg.x = G[(size_t)(n) * 512 + tid]; greg.y = G[(size_t)(n) * 512 + 64 + tid]; greg.z = G[(size_t)(n) * 512 + 128 + tid]; greg.w = G[(size_t)(n) * 512 + 192 + tid]; } }
#define M_KS(i) { const int id = tid + 256 * i, row = id >> 5, ch = id & 31; *(uint4*)(Ks + row * MKS + ch * 16) = kreg##i; }
#define M_SSTORE(n) { M_KS(0) M_KS(1) M_KS(2) M_KS(3) M_KS(4) M_KS(5) M_KS(6) M_KS(7) \
    const int row = tid >> 2, part = tid & 3; \
    const float mp_ = ((const float*)(smem + M_MS))[136 + (n)], mn_ = ((const float*)(smem + M_MS))[204 + (n)]; \
    if (tid < 64) { float* gs_ = (float*)(smem + M_GS); const float mj_ = fmaxf(greg.x + mp_, greg.x + greg.z); \
      gs_[tid] = greg.x - mj_; gs_[64 + tid] = greg.y; gs_[128 + tid] = __expf(greg.x + mp_ - mj_); gs_[192 + tid] = __expf(-mj_); gs_[256 + tid] = __expf(greg.w - mn_); \
      if (tid == 0) gs_[320] = __expf(((const float*)(smem + M_MS))[(n)] + mp_ - mn_); } \
    wreg = __expf(wreg - mn_); \
    *(uint4*)(Vs + row * MVS + part * 16) = vreg; \
    uint4 wv; \
    wv.x = pk2(bf2f((u16)(vreg.x & 0xffff)) * wreg, bf2f((u16)(vreg.x >> 16)) * wreg); \
    wv.y = pk2(bf2f((u16)(vreg.y & 0xffff)) * wreg, bf2f((u16)(vreg.y >> 16)) * wreg); \
    wv.z = pk2(bf2f((u16)(vreg.z & 0xffff)) * wreg, bf2f((u16)(vreg.z >> 16)) * wreg); \
    wv.w = pk2(bf2f((u16)(vreg.w & 0xffff)) * wreg, bf2f((u16)(vreg.w >> 16)) * wreg); \
    *(uint4*)(Vw + row * MVS + part * 16) = wv; \
    if (part == 0) { \
      *(uint4*)(Vs + row * MVS + 64) = make_uint4(0x3f80u, 0, 0, 0); \
      *(uint4*)(Vs + row * MVS + 80) = make_uint4(0, 0, 0, 0); \
      *(uint4*)(Vw + row * MVS + 64) = make_uint4((unsigned)f2bf(wreg), 0, 0, 0); \
      *(uint4*)(Vw + row * MVS + 80) = make_uint4(0, 0, 0, 0); \
    } }
#define M_QLOAD(n) { \
    const u16* qp = qc + (size_t)ROW_OF(n, 16 * w + fr) * D + hd * 256 + fq * 8; \
    _Pragma("unroll") for (int ks = 0; ks < 8; ++ks) qf[ks] = *(const bf16x8*)(qp + ks * 32); }
  bf16x8 qf[8];
  M_GLOAD(0) M_QLOAD(0)
  {
    float* ms = (float*)(smem + M_MS);
    if (tid < NCH) { ms[tid] = G[(size_t)tid * 512 + 256]; ms[68 + tid] = G[(size_t)tid * 512 + 257]; }
    __syncthreads();
    if (tid == 0) { float m = 0.f; for (int i = 0; i < NCH; ++i) { const float mn = fmaxf(ms[i] + m, ms[68 + i]); ms[136 + i] = m; ms[204 + i] = mn; m = mn; } }
    __syncthreads();
  }
  M_SSTORE(0)
  __syncthreads();
  for (int n = 0; n < NCH; ++n) {
    const bool more = n + 1 < NCH;
    if (more) M_GLOAD(n + 1)
    const float* g = (const float*)(smem + M_GS);
    const int jpos = 16 * w + fr;
    const float u_j = g[jpos], e_j = g[128 + jpos], rd_j = g[192 + jpos];
    const float a_state = g[320];
    f32x4 xs[4];
#pragma unroll
    for (int st = 0; st < 4; ++st) {
      xs[st] = f32x4{0.f, 0.f, 0.f, 0.f};
      if (st <= w) {
#pragma unroll
        for (int ks = 0; ks < 8; ++ks) {
          const bf16x8 a = *(const bf16x8*)(Ks + (16 * st + fr) * MKS + ks * 64 + fq * 16);
          xs[st] = MFMA16(a, qf[ks], xs[st]);
        }
        const float4 wv4 = *(const float4*)(g + 64 + 16 * st + 4 * fq);
        const int sb = 16 * st + 4 * fq;
        xs[st][0] *= (sb + 0 <= jpos) ? __expf(u_j + wv4.x) : 0.f;
        xs[st][1] *= (sb + 1 <= jpos) ? __expf(u_j + wv4.y) : 0.f;
        xs[st][2] *= (sb + 2 <= jpos) ? __expf(u_j + wv4.z) : 0.f;
        xs[st][3] *= (sb + 3 <= jpos) ? __expf(u_j + wv4.w) : 0.f;
      }
    }
    bf16x8 pb[2];
#pragma unroll
    for (int u = 0; u < 2; ++u) {
      u32x4 pu;
      pu[0] = pk2(xs[2 * u][0], xs[2 * u][1]); pu[1] = pk2(xs[2 * u][2], xs[2 * u][3]);
      pu[2] = pk2(xs[2 * u + 1][0], xs[2 * u + 1][1]); pu[3] = pk2(xs[2 * u + 1][2], xs[2 * u + 1][3]);
      pb[u] = __builtin_bit_cast(bf16x8, pu);
    }
    f32x4 num[3];
#pragma unroll
    for (int vt = 0; vt < 3; ++vt) {
      f32x4 n1 = {0.f, 0.f, 0.f, 0.f}, n2 = {0.f, 0.f, 0.f, 0.f};
#pragma unroll
      for (int u = 0; u < 2; ++u) {
        const char* lo = Vs + (32 * u + 4 * fq + tq) * MVS + (16 * vt) * 2 + 8 * tp;
        const bf16x8 a = tr8(lo, lo + 16 * MVS);
        n1 = MFMA16(a, pb[u], n1);
      }
#pragma unroll
      for (int ks = 0; ks < 8; ++ks) {
        const bf16x8 a = *(const bf16x8*)(Ct + (16 * vt + fr) * MKS + ks * 64 + fq * 16);
        n2 = MFMA16(a, qf[ks], n2);
      }
#pragma unroll
      for (int r = 0; r < 4; ++r) num[vt][r] = n1[r] + e_j * n2[r];
    }
    const float den = __shfl(num[2][0], fr);
    const float inv = 1.f / fmaxf(fabsf(den), rd_j);
    {
      _Float16* hp = hout + (size_t)ROW_OF(n, jpos) * D + hd * 256 + c * 32 + 4 * fq;
#pragma unroll
      for (int vt = 0; vt < 2; ++vt) {
        h16x4 hv;
#pragma unroll
        for (int r = 0; r < 4; ++r) hv[r] = (_Float16)(num[vt][r] * inv);
        *(h16x4*)(hp + 16 * vt) = hv;
      }
    }
    if (more) M_QLOAD(n + 1)
    __syncthreads();
#pragma unroll
    for (int kt = 0; kt < 4; ++kt)
#pragma unroll
      for (int vt = 0; vt < 3; ++vt) cacc[kt][vt] *= a_state;
#pragma unroll
    for (int u = 0; u < 2; ++u) {
      bf16x8 bfr[3];
#pragma unroll
      for (int vt = 0; vt < 3; ++vt) {
        const char* lo = Vw + (32 * u + 8 * fq + tq) * MVS + (16 * vt) * 2 + 8 * tp;
        bfr[vt] = tr8(lo, lo + 4 * MVS);
      }
#pragma unroll
      for (int kt = 0; kt < 4; ++kt) {
        const char* lo = Ks + (32 * u + 8 * fq + tq) * MKS + (64 * w + 16 * kt) * 2 + 8 * tp;
        const bf16x8 af = tr8(lo, lo + 4 * MKS);
#pragma unroll
        for (int vt = 0; vt < 3; ++vt) cacc[kt][vt] = MFMA16(af, bfr[vt], cacc[kt][vt]);
      }
    }
#pragma unroll
    for (int kt = 0; kt < 4; ++kt)
#pragma unroll
      for (int vt = 0; vt < 3; ++vt) {
        uint2 o2; o2.x = pk2(cacc[kt][vt][0], cacc[kt][vt][1]); o2.y = pk2(cacc[kt][vt][2], cacc[kt][vt][3]);
        *(uint2*)(Ct + (16 * vt + fr) * MKS + (64 * w + 16 * kt + 4 * fq) * 2) = o2;
      }
    __syncthreads();
    if (more) M_SSTORE(n + 1)
    __syncthreads();
  }
}

DI int q_pull(int* head, volatile LAS unsigned* s_task_p) {
  __syncthreads();
  if (threadIdx.x == 0) *s_task_p = (unsigned)atomicAdd(head, 1);
  __syncthreads();
  return (int)*s_task_p;
}
DI void phase_mix(const Params& p, int l, char* smem, volatile LAS unsigned* s_task_p, int bid, int nb) {
  int* C = (int*)(p.ws + OFF_CTR) + l * 16;
  const bool last = (l & 3) == NL - 1;
  const int per_g = last ? 32 : 34;
  const int n_cv = last ? 0 : NCONV;
  const int xcd = (int)(xb_xcc_id() & 7u);
  for (;;) { const int t = q_pull(C, s_task_p); if (t >= 256) break; mlstm_task(p, t, smem); }
  for (int j = 0; j < 8; ++j) {
    const int x = (xcd + j) & 7;
    for (;;) {
      const int e = q_pull(C + 1 + x, s_task_p);
      if (e >= 4 * per_g) break;
      const int gi = e / per_g, r = e - gi * per_g, g = x + 8 * gi, b = g >> 3, h = g & 7;
      if (r < 32) attn_task(p, b, h, b * SEQ + r * 128, 68, true, smem);
      else attn_task(p, b, h, RL + b * CTX + (r - 32) * 128, 4, false, smem);
    }
  }
  for (;;) { const int t = q_pull(C + 9, s_task_p); if (t >= n_cv) break; const int c0 = t * CONV_PER_TASK; convert_range(p, (l & 3) + 1, smem, c0, c0 + CONV_PER_TASK, 1); }
}

DI void phase_mout(const Params& p, int l, int bid, int nb) {
  const int tid_ = tidx(), lane = tid_ & 63, wid = tid_ >> 6;
  char* ws = p.ws;
  const _Float16* hf = (const _Float16*)(ws + OFF_ZQ); const _Float16* hb = (const _Float16*)(ws + OFF_ZK);
  const u16* zo = (const u16*)(ws + OFF_ZO);
  u16* hm = (u16*)(ws + OFF_KC);
  for (int r = bid * 4 + wid; r < R; r += nb * 4) {
#pragma unroll
    for (int hd = 0; hd < 4; ++hd) {
      const size_t off = (size_t)r * D + hd * 256 + lane * 4;
      const h16x4 a = *(const h16x4*)(hf + off), bb = *(const h16x4*)(hb + off);
      float v[4]; float ss = 0.f;
#pragma unroll
      for (int e = 0; e < 4; ++e) { v[e] = (float)a[e] + (float)bb[e]; ss += v[e] * v[e]; }
      ss = wave_sum(ss);
      const float rstd = rsqrtf(ss * (1.f / 256.f) + EPS);
      const uint2 z = *(const uint2*)(zo + off);
      const float4 g4 = *(const float4*)(p.g_mh + (size_t)l * D + hd * 256 + lane * 4);
      const float o0 = sigmf(bf2f((u16)(z.x & 0xffff))) * v[0] * rstd * g4.x;
      const float o1 = sigmf(bf2f((u16)(z.x >> 16))) * v[1] * rstd * g4.y;
      const float o2 = sigmf(bf2f((u16)(z.y & 0xffff))) * v[2] * rstd * g4.z;
      const float o3 = sigmf(bf2f((u16)(z.y >> 16))) * v[3] * rstd * g4.w;
      uint2 o; o.x = pk2(o0, o1); o.y = pk2(o2, o3);
      *(uint2*)(hm + bko(r, hd * 256 + lane * 4, D / 64)) = o;
    }
  }
}

DI void phase_merge(const Params& p, const u16* wb, int mtn, char* smem, int bid, int nb) {
  constexpr int NTN = D / 128;
  char* ws = p.ws;
  const u16* hm = (const u16*)(ws + OFF_KC);
  const u16* ao = (const u16*)(ws + OFF_H) + (size_t)R * 1536;
  const u16* zbr = (const u16*)(ws + OFF_ZBR);
  u16* tt = (u16*)(ws + OFF_AN);
  G_DECL;
  for (int tile = vbid(bid, nb); tile < mtn * NTN; tile += nb) {
    int mt, nt; tile_of(tile, NTN, mt, nt);
    f32x4 acc[4][4]; ZERO_ACC(acc);
    gemm_prefetch(G_ARGS, hm, D, wb + WB_BM, D, mt * 128, nt * 128);
    gemm_mainloop(G_ARGS, hm, D, wb + WB_BM, D, D / 64, mt * 128, nt * 128, acc, smem);
    const unsigned rbase = mt * 128;
    {
      const int tid = tidx(), lane = tid & 63, wid = tid >> 6, wr = wid >> 1, wc = wid & 1, fr = lane & 15, fq = lane >> 4;
      stage_bf16(acc, smem, wr, wc, fr, fq);
      __syncthreads();
#pragma unroll
      for (int i = 0; i < 8; ++i) {
        const unsigned id = tid + 256 * i, row = id >> 4, ch = id & 15;
        const uint4 a = *(const uint4*)(smem + row * ST16 + ch * 16);
        const unsigned grow = rbase + row, col = nt * 128 + ch * 8;
        const uint4 gm = *(const uint4*)(zbr + grow * 2048u + col);
        uint4 o;
#define MRG1(F) o.F = pk2(sigmf(bf2f((u16)(gm.F & 0xffff))) * bf2f((u16)(a.F & 0xffff)), sigmf(bf2f((u16)(gm.F >> 16))) * bf2f((u16)(a.F >> 16)));
        MRG1(x) MRG1(y) MRG1(z) MRG1(w)
#undef MRG1
        *(uint4*)(tt + bko(grow, col, D / 64)) = o;
      }
      __syncthreads();
    }
    ZERO_ACC(acc);
    gemm_prefetch(G_ARGS, ao, D, wb + WB_BA, D, mt * 128, nt * 128);
    gemm_mainloop(G_ARGS, ao, D, wb + WB_BA, D, D / 64, mt * 128, nt * 128, acc, smem);
    const int tid = tidx(), lane = tid & 63, wid = tid >> 6, wr = wid >> 1, wc = wid & 1, fr = lane & 15, fq = lane >> 4;
    stage_bf16(acc, smem, wr, wc, fr, fq);
    __syncthreads();
#pragma unroll
    for (int i = 0; i < 8; ++i) {
      const unsigned id = tid + 256 * i, row = id >> 4, ch = id & 15;
      const uint4 b = *(const uint4*)(smem + row * ST16 + ch * 16);
      const unsigned grow = rbase + row, col = nt * 128 + ch * 8;
      const uint4 a = *(const uint4*)(tt + bko(grow, col, D / 64));
      const uint4 ga = *(const uint4*)(zbr + grow * 2048u + 1024u + col);
      uint4 o;
#define MRG(F) { \
      const float o0 = bf2f((u16)(a.F & 0xffff)) + sigmf(bf2f((u16)(ga.F & 0xffff))) * bf2f((u16)(b.F & 0xffff)); \
      const float o1 = bf2f((u16)(a.F >> 16)) + sigmf(bf2f((u16)(ga.F >> 16))) * bf2f((u16)(b.F >> 16)); \
      o.F = pk2(o0, o1); }
      MRG(x) MRG(y) MRG(z) MRG(w)
#undef MRG
      *(uint4*)(tt + bko(grow, col, D / 64)) = o;
    }
    __syncthreads();
  }
}

__global__ void __launch_bounds__(256, 2) fwd_kernel(Params p) {
  extern __shared__ __attribute__((aligned(16))) char smem[];
  __shared__ __attribute__((aligned(16))) unsigned xbw[4];
  const int bid = blockIdx.x, nb = gridDim.x;
  char* ws = p.ws;
  u16* an = (u16*)(ws + OFF_AN);
  u16* hbuf = (u16*)(ws + OFF_H);
  if (threadIdx.x < 4) xbw[threadIdx.x] = 0u;
  __syncthreads();
  XcdBarrier xb = xcd_barrier_post((unsigned*)(ws + OFF_BAR), (volatile LAS unsigned*)xbw);
  for (int ph = p.ph_lo; ph < p.ph_hi; ++ph) {
    if (ph == NPH - 1) {
      phase_final(p, bid, nb);
    } else {
      const int l = ph / NPH_LAYER, k = ph - l * NPH_LAYER;
      if (k == 0 && l > 0) continue;
      const u16* wb = (const u16*)(ws + OFF_WB) + (size_t)(l & 1) * WB_END;
      const float* mods_l = (const float*)(ws + OFF_MODS) + (size_t)l * 5 * NMOD * D;
      const int mtl = (l == NL - 1) ? RL / 128 : MT;
      const int nrep = ((DUP_MASK >> k) & 1) ? 2 : 1;
      for (int rep = 0; rep < nrep; ++rep) {
      if (rep) xcd_barrier(xb);
      switch (k) {
        case 0:
          if (l == 0) phase_init(p, smem, bid, nb);
          phase_convert(p, l, smem, bid, nb);
          break;
        case 1: phase_norm(p, R, p.g_n1 + l * D, mods_l, 0, 1, an, bid, nb); break;
        case 2: phase_ffn_up(p, MT, an, wb + WB_UP1, hbuf, smem, bid, nb); break;
        case 3: phase_gemm_resid(p, MT, hbuf, DFF, wb + WB_DN1, mods_l, 2, 0.5f, smem, bid, nb); break;
        case 4: phase_norm(p, R, p.g_n2 + l * D, mods_l, 3, 4, an, bid, nb); break;
        case 5: phase_inproj(p, l, an, wb + WB_IN, smem, bid, nb); break;
        case 6: phase_prep(p, l, bid, nb); break;
        case 7: phase_upproj(p, wb, smem, bid, nb); break;
        case 8: phase_mix(p, l + 4 * rep, smem, (volatile LAS unsigned*)&xbw[2], bid, nb); break;
        case 9: phase_mout(p, l, bid, nb); break;
        case 10: phase_merge(p, wb, mtl, smem, bid, nb); break;
        case 11: phase_gemm_resid(p, mtl, an, D, wb + WB_OUT, mods_l, 5, 1.0f, smem, bid, nb); break;
        case 12: phase_norm(p, mtl * 128, p.g_n3 + l * D, mods_l, 6, 7, an, bid, nb); break;
        case 13: phase_ffn_up(p, mtl, an, wb + WB_UP2, hbuf, smem, bid, nb); break;
        case 14: phase_gemm_resid(p, mtl, hbuf, DFF, wb + WB_DN2, mods_l, 8, 0.5f, smem, bid, nb); break;
      }
      }
    }
    if (ph + 1 < p.ph_hi) { if (ph == 0) cg::this_grid().sync(); else xcd_barrier(xb); }
  }
}

extern "C" void kernel_launch(void* const* d_in, const int* in_sizes, int n_in, void* d_out, int out_size, void* d_ws, size_t ws_size, hipStream_t stream) {
  static int grid = 0;
  if (grid == 0) {
    if (n_in != 25 || ws_size < WS_END) { fprintf(stderr, "kernel_launch: unexpected n_in %d or ws_size %zu (< %zu)\n", n_in, ws_size, (size_t)WS_END); grid = -1; return; }
    int dev = 0, cus = 0, per_cu = 0;
    hipGetDevice(&dev);
    hipDeviceGetAttribute(&cus, hipDeviceAttributeMultiprocessorCount, dev);
    hipFuncSetAttribute((const void*)fwd_kernel, hipFuncAttributeMaxDynamicSharedMemorySize, SMEM_BYTES);
    hipOccupancyMaxActiveBlocksPerMultiprocessor(&per_cu, (const void*)fwd_kernel, 256, SMEM_BYTES);
    if (per_cu < 1) per_cu = 1;
    if (per_cu > 2) per_cu = 2;
    grid = cus * per_cu;
    fprintf(stderr, "kernel_launch: grid %d (%d CUs x %d), ws need %zu have %zu\n", grid, cus, per_cu, (size_t)WS_END, ws_size);
  }
  if (grid < 0) return;
  Params p{};
  const float** f = (const float**)&p;
  for (int i = 0; i < 25; ++i) f[i] = (const float*)d_in[i];
  p.out = (float*)d_out; p.ws = (char*)d_ws;
  hipMemsetAsync((char*)d_ws + OFF_CTR, 0, (OFF_WB - OFF_CTR), stream);
#if ONE_LAUNCH
  p.ph_lo = 0; p.ph_hi = NPH;
  void* args[] = {&p};
  hipError_t e = hipLaunchCooperativeKernel((const void*)fwd_kernel, dim3(grid), dim3(256), args, SMEM_BYTES, stream);
  if (e != hipSuccess) fprintf(stderr, "cooperative launch failed: %s (grid %d)\n", hipGetErrorString(e), grid);
#else
  for (int ph = 0; ph < NPH; ++ph) {
    p.ph_lo = ph; p.ph_hi = ph + 1;
    hipLaunchKernelGGL(fwd_kernel, dim3(grid), dim3(256), SMEM_BYTES, stream, p);
  }
#endif
}
```

```cpp
#include <hip/hip_runtime.h>
#include <hip/hip_cooperative_groups.h>
#include <cstdio>
namespace cg = cooperative_groups;

#ifndef DUP_MASK
#define DUP_MASK 0
#endif
#ifndef ONE_LAUNCH
#define ONE_LAUNCH 1
#endif

typedef unsigned short u16;
typedef __attribute__((ext_vector_type(8))) short bf16x8;
typedef __attribute__((ext_vector_type(4))) short s16x4;
typedef __attribute__((ext_vector_type(4))) float f32x4;
typedef __attribute__((ext_vector_type(16))) float f32x16;
typedef __attribute__((ext_vector_type(4))) _Float16 h16x4;
typedef __attribute__((ext_vector_type(4))) unsigned u32x4;
#define DI __device__ __forceinline__
#define MFMA16(a, b, c) __builtin_amdgcn_mfma_f32_16x16x32_bf16((a), (b), (c), 0, 0, 0)
#define MFMA32(a, b, c) __builtin_amdgcn_mfma_f32_32x32x16_bf16((a), (b), (c), 0, 0, 0)

constexpr int D = 1024, NB = 4, SEQ = 4096, NL = 4, CTX = 256;
constexpr int RL = NB * SEQ;
constexpr int RC = NB * CTX;
constexpr int R = RL + RC;
constexpr int DFF = 2816, INW = 6864, ZW = 6912, NMOD = 9;
constexpr float EPS = 1e-6f;
constexpr int NCH = 68;
constexpr int MT = R / 128;

constexpr size_t al(size_t x) { return (x + 255) & ~(size_t)255; }
constexpr size_t OFF_XC = 0;
constexpr size_t OFF_MODS = al(OFF_XC + (size_t)RC * D * 4);
constexpr size_t OFF_ROPE = al(OFF_MODS + (size_t)NL * 5 * NMOD * D * 4);
constexpr size_t OFF_G = al(OFF_ROPE + (size_t)SEQ * 32 * 8);
constexpr size_t OFF_CTR = al(OFF_G + (size_t)32 * NCH * 512 * 4);
constexpr size_t OFF_BAR = al(OFF_CTR + 8 * 16 * 4);
constexpr size_t OFF_WB = al(OFF_BAR + 3456 * 4);
constexpr size_t WB_UP1 = 0;
constexpr size_t WB_DN1 = WB_UP1 + (size_t)2 * DFF * D;
constexpr size_t WB_UP2 = WB_DN1 + (size_t)D * DFF;
constexpr size_t WB_DN2 = WB_UP2 + (size_t)2 * DFF * D;
constexpr size_t WB_IN = WB_DN2 + (size_t)D * DFF;
constexpr size_t WB_UQ = WB_IN + (size_t)ZW * D;
constexpr size_t WB_UKV = WB_UQ + (size_t)1536 * 384;
constexpr size_t WB_BM = WB_UKV + (size_t)2048 * 256;
constexpr size_t WB_BA = WB_BM + (size_t)D * D;
constexpr size_t WB_OUT = WB_BA + (size_t)D * D;
constexpr size_t WB_END = WB_OUT + (size_t)D * D;
constexpr size_t OFF_AN = al(OFF_WB + 2 * WB_END * 2);
constexpr size_t OFF_H = al(OFF_AN + (size_t)R * D * 2);
constexpr size_t OFF_ZQ = al(OFF_H + (size_t)R * DFF * 2);
constexpr size_t OFF_ZK = al(OFF_ZQ + (size_t)R * D * 2);
constexpr size_t OFF_ZV = al(OFF_ZK + (size_t)R * D * 2);
constexpr size_t OFF_ZO = al(OFF_ZV + (size_t)R * D * 2);
constexpr size_t OFF_ZCQ = al(OFF_ZO + (size_t)R * D * 2);
constexpr size_t OFF_ZCKV = al(OFF_ZCQ + (size_t)R * 384 * 2);
constexpr size_t OFF_ZKR = al(OFF_ZCKV + (size_t)R * 256 * 2);
constexpr size_t OFF_ZG = al(OFF_ZKR + (size_t)R * 64 * 2);
constexpr size_t OFF_ZBR = al(OFF_ZG + (size_t)R * 16 * 4);
constexpr size_t OFF_KC = al(OFF_ZBR + (size_t)R * 2048 * 2);
constexpr size_t OFF_KV = al(OFF_KC + (size_t)R * D * 2);
constexpr size_t OFF_CQN = al(OFF_KV + (size_t)R * 2048 * 2);
constexpr size_t OFF_CKVN = al(OFF_CQN + (size_t)R * 384 * 2);
constexpr size_t OFF_KROPE = al(OFF_CKVN + (size_t)R * 256 * 2);
constexpr size_t OFF_SS2 = al(OFF_KROPE + (size_t)R * 64 * 2);
constexpr size_t WS_END = al(OFF_SS2 + (size_t)R * 16 * 4);

constexpr int SMEM_BYTES = 76800;
constexpr int NPH_LAYER = 15;
constexpr int NPH = NL * NPH_LAYER + 1;

struct Params {
  const float *x, *c, *ctx, *c_ctx, *w_ada, *b_ada, *g_n1, *g_n2, *g_n3, *w_ff1_up, *w_ff1_dn, *w_ff2_up, *w_ff2_dn,
      *w_in, *b_gate, *w_conv, *g_mh, *g_qa, *g_kva, *w_uq, *w_ukv, *w_bm, *w_ba, *w_out, *g_final;
  float* out;
  char* ws;
  int ph_lo, ph_hi;
};

DI float bf2f(u16 u) { return __uint_as_float(((unsigned)u) << 16); }
DI u16 f2bf(float x) { return __builtin_bit_cast(u16, (__bf16)x); }
DI unsigned pk2(float a, float b) { return (unsigned)f2bf(a) | ((unsigned)f2bf(b) << 16); }
DI float siluf(float x) { return x / (1.f + __expf(-x)); }
DI float sigmf(float x) { return 1.f / (1.f + __expf(-x)); }
DI float wave_sum(float v) {
#pragma unroll
  for (int o = 32; o > 0; o >>= 1) v += __shfl_xor(v, o);
  return v;
}
DI float wave_max(float v) {
#pragma unroll
  for (int o = 32; o > 0; o >>= 1) v = fmaxf(v, __shfl_xor(v, o));
  return v;
}
DI int tidx() { int t = threadIdx.x; asm volatile("" : "+v"(t)); return t; }
DI unsigned bko(unsigned r, unsigned k, unsigned nkt) { return ((r >> 7) * nkt + (k >> 6)) * 8192u + ((r & 127u) << 6) + (k & 63u); }
DI float* xptr(const Params& p, int r) { return r < RL ? p.out + (size_t)r * D : (float*)(p.ws + OFF_XC) + (size_t)(r - RL) * D; }
DI int modrow(int r) { return r < RL ? (r >> 12) : 4; }
DI bf16x8 tr8(const char* lo, const char* hi) {
  s16x4 a = __builtin_amdgcn_ds_read_tr16_b64_v4i16((s16x4 __attribute__((address_space(3)))*)(lo));
  s16x4 b = __builtin_amdgcn_ds_read_tr16_b64_v4i16((s16x4 __attribute__((address_space(3)))*)(hi));
  return __builtin_shufflevector(a, b, 0, 1, 2, 3, 4, 5, 6, 7);
}


#define XB_TMO      128
#define XB_XCNT(j)  (256  + 64 * (j))
#define XB_XSUB(j)  (1280 + 64 * (j))
#define XB_XGEN(j)  (2304 + 64 * (j))
#define XB_TOP      3328
#define XB_TOPGEN   3392
#define XCD_BAR_WORDS 3456
#define XB_SPIN_CAP (1u << 22)
#define LAS __attribute__((address_space(3)))
DI unsigned xb_ld(unsigned* p) { return __hip_atomic_load(p, __ATOMIC_RELAXED, __HIP_MEMORY_SCOPE_AGENT); }
DI unsigned xb_add(unsigned* p, unsigned v) { return __hip_atomic_fetch_add(p, v, __ATOMIC_RELAXED, __HIP_MEMORY_SCOPE_AGENT); }
DI unsigned xb_xcc_id() { return (unsigned)__builtin_amdgcn_s_getreg((3 << 11) | 20) & 0xFu; }
#define XB_SPIN(cond, bar) do { unsigned _sp = 0; while (cond) { __builtin_amdgcn_s_sleep(1); \
    if ((++_sp & 255u) == 0u) { if (xb_ld(&(bar)[XB_TMO])) break; if (_sp > XB_SPIN_CAP) { atomicAdd(&(bar)[XB_TMO], 1u); break; } } } } while (0)
struct XcdBarrier { unsigned* bar; unsigned x; volatile LAS unsigned* st; };
DI XcdBarrier xcd_barrier_post(unsigned* bar, volatile LAS unsigned* st) {
  XcdBarrier b; b.bar = bar; b.x = xb_xcc_id(); b.st = st;
  if (threadIdx.x == 0) (void)xb_add(&bar[XB_XCNT(b.x)], 1u);
  return b;
}
DI void xcd_barrier_complete(unsigned* bar, unsigned x, unsigned& nloc, unsigned& nx) {
  const unsigned G = gridDim.x * gridDim.y * gridDim.z;
  unsigned sum, cnt, mine, sp = 0u;
  for (;;) {
    sum = 0u; cnt = 0u; mine = 0u;
#pragma unroll
    for (unsigned j = 0; j < 16; ++j) { const unsigned c = xb_ld(&bar[XB_XCNT(j)]); sum += c; cnt += (c > 0u) ? 1u : 0u; mine = (j == x) ? c : mine; }
    if (sum == G) break;
    __builtin_amdgcn_s_sleep(1);
    if ((++sp & 255u) == 0u) { if (xb_ld(&bar[XB_TMO])) break; if (sp > XB_SPIN_CAP) { atomicAdd(&bar[XB_TMO], 1u); break; } }
  }
  nloc = mine > 0u ? mine : 1u; nx = cnt > 0u ? cnt : 1u;
}
DI void xcd_barrier(const XcdBarrier& b) {
  asm volatile("s_waitcnt vmcnt(0)" ::: "memory");
  __syncthreads();
  if (threadIdx.x == 0) {
    unsigned* bar = b.bar;
    __builtin_amdgcn_s_waitcnt(0);
    unsigned nloc = b.st[0], nx = b.st[1];
    if (nloc == 0u) { xcd_barrier_complete(bar, b.x, nloc, nx); b.st[0] = nloc; b.st[1] = nx; }
    const unsigned old = xb_add(&bar[XB_XSUB(b.x)], 1u);
    const unsigned gen = old / nloc;
    if (old + 1u == (gen + 1u) * nloc) {
      __builtin_amdgcn_fence(__ATOMIC_RELEASE, "agent");
      asm volatile("s_waitcnt vmcnt(0)" ::: "memory");
      const unsigned og = xb_add(&bar[XB_TOP], 1u);
      const unsigned tg = og / nx;
      if (og + 1u == (tg + 1u) * nx) xb_add(&bar[XB_TOPGEN], 1u);
      else XB_SPIN(xb_ld(&bar[XB_TOPGEN]) == tg, bar);
      __builtin_amdgcn_fence(__ATOMIC_ACQUIRE, "agent");
      xb_add(&bar[XB_XGEN(b.x)], 1u);
      asm volatile("s_waitcnt vmcnt(0)" ::: "memory");
    } else {
      XB_SPIN(xb_ld(&bar[XB_XGEN(b.x)]) == gen, bar);
      __builtin_amdgcn_fence(__ATOMIC_ACQUIRE, "agent");
      asm volatile("s_waitcnt vmcnt(0)" ::: "memory");
    }
  }
  __syncthreads();
}

DI int src_col(int perm, int r) {
  if (perm == 0) return r;
  if (perm == 1) { int grp = r >> 6, j = r & 63; return j < 32 ? grp * 32 + j : DFF + grp * 32 + (j - 32); }
  if (r < 4096) return r;
  if (r < 4800) return r + 16;
  if (r < 4816) return r - 704;
  if (r < 4864) return -1;
  return r - 48;
}

DI void convert_tile(const float* __restrict__ W, int Nsrc, int K, int perm, u16* __restrict__ Wt, int tile, char* smem) {
  const int nkt = K >> 6;
  const int rt = tile / nkt, kt = tile - rt * nkt;
  const int r0 = rt * 32, k0 = kt * 64;
  u16* t = (u16*)smem;
  const int tid = tidx();
  {
    const int j = tid & 31, i = tid >> 5;
    const int sc = src_col(perm, r0 + j);
#pragma unroll
    for (int s = 0; s < 8; ++s) {
      const int k = i + 8 * s;
      float v = sc >= 0 ? W[(size_t)(k0 + k) * Nsrc + sc] : 0.f;
      t[j * 72 + k] = f2bf(v);
    }
  }
  __syncthreads();
  {
    const int row = tid >> 3, c8 = tid & 7;
    uint4 v = *(const uint4*)(t + row * 72 + c8 * 8);
    *(uint4*)(Wt + bko(r0 + row, k0 + c8 * 8, K >> 6)) = v;
  }
  __syncthreads();
}

DI void convert_range(const Params& p, int l, char* smem, int t0, int t1, int tstep) {
  u16* wb = (u16*)(p.ws + OFF_WB) + (size_t)(l & 1) * WB_END;
  constexpr int T_UP = (2 * DFF / 32) * (D / 64);
  constexpr int T_DN = (D / 32) * (DFF / 64);
  constexpr int T_IN = (ZW / 32) * (D / 64);
  constexpr int T_UQ = (1536 / 32) * (384 / 64);
  constexpr int T_UKV = (2048 / 32) * (256 / 64);
  constexpr int T_SQ = (D / 32) * (D / 64);
  constexpr int C1 = T_UP, C2 = C1 + T_DN, C3 = C2 + T_UP, C4 = C3 + T_DN, C5 = C4 + T_IN, C6 = C5 + T_UQ, C7 = C6 + T_UKV,
                C8 = C7 + T_SQ, C9 = C8 + T_SQ, C10 = C9 + T_SQ;
  if (t1 > C10) t1 = C10;
  for (int t = t0; t < t1; t += tstep) {
    if (t < C1) convert_tile(p.w_ff1_up + (size_t)l * D * 2 * DFF, 2 * DFF, D, 1, wb + WB_UP1, t, smem);
    else if (t < C2) convert_tile(p.w_ff1_dn + (size_t)l * DFF * D, D, DFF, 0, wb + WB_DN1, t - C1, smem);
    else if (t < C3) convert_tile(p.w_ff2_up + (size_t)l * D * 2 * DFF, 2 * DFF, D, 1, wb + WB_UP2, t - C2, smem);
    else if (t < C4) convert_tile(p.w_ff2_dn + (size_t)l * DFF * D, D, DFF, 0, wb + WB_DN2, t - C3, smem);
    else if (t < C5) convert_tile(p.w_in + (size_t)l * D * INW, INW, D, 2, wb + WB_IN, t - C4, smem);
    else if (t < C6) convert_tile(p.w_uq + (size_t)l * 384 * 1536, 1536, 384, 0, wb + WB_UQ, t - C5, smem);
    else if (t < C7) convert_tile(p.w_ukv + (size_t)l * 256 * 2048, 2048, 256, 0, wb + WB_UKV, t - C6, smem);
    else if (t < C8) convert_tile(p.w_bm + (size_t)l * D * D, D, D, 0, wb + WB_BM, t - C7, smem);
    else if (t < C9) convert_tile(p.w_ba + (size_t)l * D * D, D, D, 0, wb + WB_BA, t - C8, smem);
    else convert_tile(p.w_out + (size_t)l * D * D, D, D, 0, wb + WB_OUT, t - C9, smem);
  }
}
constexpr int CONV_TILES = 13984;
constexpr int CONV_PER_TASK = 16;
constexpr int NCONV = (CONV_TILES + CONV_PER_TASK - 1) / CONV_PER_TASK;
DI void phase_convert(const Params& p, int l, char* smem, int bid, int nb) { convert_range(p, l, smem, bid, CONV_TILES, nb); }

DI void phase_init(const Params& p, char* smem, int bid, int nb) {
  const int tid = tidx(), lane = tid & 63, wid = tid >> 6;
  {
    const float4* xs = (const float4*)p.x; float4* xd = (float4*)p.out;
    const size_t n4 = (size_t)RL * D / 4;
    for (size_t i = (size_t)bid * 256 + tid; i < n4; i += (size_t)nb * 256) xd[i] = xs[i];
    const float4* cs = (const float4*)p.ctx; float4* cd = (float4*)(p.ws + OFF_XC);
    const size_t m4 = (size_t)RC * D / 4;
    for (size_t i = (size_t)bid * 256 + tid; i < m4; i += (size_t)nb * 256) cd[i] = cs[i];
  }
  {
    float2* tab = (float2*)(p.ws + OFF_ROPE);
    for (int idx = bid * 256 + tid; idx < SEQ * 32; idx += nb * 256) {
      const int t = idx >> 5, i = idx & 31, f = i & 15;
      const float pos = (float)(i < 16 ? (t >> 6) : (t & 63));
      const float inv = powf(10000.f, -(float)(2 * f) / 32.f);
      const float ang = pos * inv;
      tab[idx] = make_float2(cosf(ang), sinf(ang));
    }
  }
  float* sc = (float*)smem;
  float* red = sc + 5 * D;
  for (int i = tid; i < 5 * D; i += 256) {
    const int row = i >> 10, k = i & 1023;
    const float v = row < 4 ? p.c[row * D + k] : p.c_ctx[k];
    sc[i] = siluf(v);
  }
  __syncthreads();
  float* mods = (float*)(p.ws + OFF_MODS);
  constexpr int NG = NMOD * D / 64;
  for (int t = bid; t < NL * NG; t += nb) {
    const int l = t / NG, n = (t - l * NG) * 64 + lane;
    const float* w = p.w_ada + (size_t)l * D * NMOD * D + n;
    float a0 = 0, a1 = 0, a2 = 0, a3 = 0, a4 = 0;
    const int kb = wid * 256;
#pragma unroll 8
    for (int k = 0; k < 256; ++k) {
      const float wv = w[(size_t)(kb + k) * (NMOD * D)];
      a0 += sc[kb + k] * wv; a1 += sc[D + kb + k] * wv; a2 += sc[2 * D + kb + k] * wv; a3 += sc[3 * D + kb + k] * wv; a4 += sc[4 * D + kb + k] * wv;
    }
    red[(wid * 5 + 0) * 64 + lane] = a0; red[(wid * 5 + 1) * 64 + lane] = a1; red[(wid * 5 + 2) * 64 + lane] = a2;
    red[(wid * 5 + 3) * 64 + lane] = a3; red[(wid * 5 + 4) * 64 + lane] = a4;
    __syncthreads();
    for (int i = tid; i < 320; i += 256) {
      const int row = i >> 6, ln = i & 63;
      const int nn = (t - l * NG) * 64 + ln;
      float s = red[(0 * 5 + row) * 64 + ln] + red[(1 * 5 + row) * 64 + ln] + red[(2 * 5 + row) * 64 + ln] + red[(3 * 5 + row) * 64 + ln];
      mods[((size_t)l * 5 + row) * (NMOD * D) + nn] = s + p.b_ada[(size_t)l * NMOD * D + nn];
    }
    __syncthreads();
  }
}

DI void phase_norm(const Params& p, int nrows, const float* __restrict__ g, const float* __restrict__ mods_l, int shift_idx, int scale_idx, u16* __restrict__ an, int bid, int nb) {
  const int tid_ = tidx(), lane = tid_ & 63, wid = tid_ >> 6;
  for (int r = bid * 4 + wid; r < nrows; r += nb * 4) {
    const float* x = xptr(p, r);
    float4 v[4]; float ss = 0.f;
#pragma unroll
    for (int i = 0; i < 4; ++i) { v[i] = *(const float4*)(x + i * 256 + lane * 4); ss += v[i].x * v[i].x + v[i].y * v[i].y + v[i].z * v[i].z + v[i].w * v[i].w; }
    ss = wave_sum(ss);
    const float rstd = rsqrtf(ss * (1.f / D) + EPS);
    const float* md = mods_l + (size_t)modrow(r) * (NMOD * D);
#pragma unroll
    for (int i = 0; i < 4; ++i) {
      const int col = i * 256 + lane * 4;
      const float4 g4 = *(const float4*)(g + col);
      const float4 sh = *(const float4*)(md + shift_idx * D + col);
      const float4 sc = *(const float4*)(md + scale_idx * D + col);
      const float y0 = v[i].x * rstd * g4.x * (1.f + sc.x) + sh.x;
      const float y1 = v[i].y * rstd * g4.y * (1.f + sc.y) + sh.y;
      const float y2 = v[i].z * rstd * g4.z * (1.f + sc.z) + sh.z;
      const float y3 = v[i].w * rstd * g4.w * (1.f + sc.w) + sh.w;
      uint2 o; o.x = pk2(y0, y1); o.y = pk2(y2, y3);
      *(uint2*)(an + bko(r, col, D / 64)) = o;
    }
  }
}

DI void phase_final(const Params& p, int bid, int nb) {
  const int tid_ = tidx(), lane = tid_ & 63, wid = tid_ >> 6;
  for (int r = bid * 4 + wid; r < RL; r += nb * 4) {
    float* x = p.out + (size_t)r * D;
    float4 v[4]; float ss = 0.f;
#pragma unroll
    for (int i = 0; i < 4; ++i) { v[i] = *(const float4*)(x + i * 256 + lane * 4); ss += v[i].x * v[i].x + v[i].y * v[i].y + v[i].z * v[i].z + v[i].w * v[i].w; }
    ss = wave_sum(ss);
    const float rstd = rsqrtf(ss * (1.f / D) + EPS);
#pragma unroll
    for (int i = 0; i < 4; ++i) {
      const int col = i * 256 + lane * 4;
      const float4 g4 = *(const float4*)(p.g_final + col);
      float4 o; o.x = v[i].x * rstd * g4.x; o.y = v[i].y * rstd * g4.y; o.z = v[i].z * rstd * g4.z; o.w = v[i].w * rstd * g4.w;
      *(float4*)(x + col) = o;
    }
  }
}

constexpr int GSTR = 128;
constexpr int GBUF = 128 * GSTR;

#define G_PARAMS uint4 &ra00, uint4 &ra01, uint4 &ra02, uint4 &ra03, uint4 &rb00, uint4 &rb01, uint4 &rb02, uint4 &rb03, \
                 uint4 &ra10, uint4 &ra11, uint4 &ra12, uint4 &ra13, uint4 &rb10, uint4 &rb11, uint4 &rb12, uint4 &rb13
#define G_DECL uint4 g_a00, g_a01, g_a02, g_a03, g_b00, g_b01, g_b02, g_b03, g_a10, g_a11, g_a12, g_a13, g_b10, g_b11, g_b12, g_b13
#define G_ARGS g_a00, g_a01, g_a02, g_a03, g_b00, g_b01, g_b02, g_b03, g_a10, g_a11, g_a12, g_a13, g_b10, g_b11, g_b12, g_b13
#define G_L1(S, i, kt) ra##S##i = *(const uint4*)(ap + (size_t)(kt) * 8192 + i * 2048); rb##S##i = *(const uint4*)(bp + (size_t)(kt) * 8192 + i * 2048);
#define G_LOAD(S, kt) { G_L1(S, 0, kt) G_L1(S, 1, kt) G_L1(S, 2, kt) G_L1(S, 3, kt) }
#define G_S1(S, i, buf) *(uint4*)(sA + (buf) * GBUF + soff + i * 32 * GSTR) = ra##S##i; *(uint4*)(sB + (buf) * GBUF + soff + i * 32 * GSTR) = rb##S##i;
#define G_STORE(S, buf) { G_S1(S, 0, buf) G_S1(S, 1, buf) G_S1(S, 2, buf) G_S1(S, 3, buf) }
DI void gemm_prefetch(G_PARAMS, const u16* __restrict__ A, int lda, const u16* __restrict__ Bt, int ldb, int m0, int n0) {
  const int tid = tidx();
  const int lr = tid >> 3, lc = tid & 7;
  const u16* ap = A + (size_t)((m0 >> 7) * (lda >> 6)) * 8192 + lr * 64 + lc * 8;
  const u16* bp = Bt + (size_t)((n0 >> 7) * (ldb >> 6)) * 8192 + lr * 64 + lc * 8;
  G_LOAD(0, 0)
  G_LOAD(1, 1)
}
DI void gemm_mainloop(G_PARAMS, const u16* __restrict__ A, int lda, const u16* __restrict__ Bt, int ldb, int nk, int m0, int n0, f32x4 (&acc)[4][4], char* smem) {
  const int tid = tidx(), lane = tid & 63, wid = tid >> 6, wr = wid >> 1, wc = wid & 1;
  const int lr = tid >> 3, lc = tid & 7;
  const u16* ap = A + (size_t)((m0 >> 7) * (lda >> 6)) * 8192 + lr * 64 + lc * 8;
  const u16* bp = Bt + (size_t)((n0 >> 7) * (ldb >> 6)) * 8192 + lr * 64 + lc * 8;
#define G_COMPUTE(buf) { const char* cA = sA + (buf) * GBUF; const char* cB = sB + (buf) * GBUF; \
    _Pragma("unroll") for (int ks = 0; ks < 2; ++ks) { \
      bf16x8 a[4], b[4]; \
      _Pragma("unroll") for (int m = 0; m < 4; ++m) a[m] = *(const bf16x8*)(cA + (aoff ^ (ks * 64)) + m * 16 * GSTR); \
      _Pragma("unroll") for (int n = 0; n < 4; ++n) b[n] = *(const bf16x8*)(cB + (boff ^ (ks * 64)) + n * 16 * GSTR); \
      _Pragma("unroll") for (int m = 0; m < 4; ++m) _Pragma("unroll") for (int n = 0; n < 4; ++n) acc[m][n] = MFMA16(b[n], a[m], acc[m][n]); \
    } }
  char* sA = smem; char* sB = smem + 2 * GBUF;
  const int soff = lr * GSTR + ((lc ^ ((lr >> 1) & 7)) << 4);
  const int fr = lane & 15, fq = lane >> 4;
  const int swz = (fq ^ ((fr >> 1) & 7)) << 4;
  const int aoff = (wr * 64 + fr) * GSTR + swz;
  const int boff = (wc * 64 + fr) * GSTR + swz;
  uint4 ra20, ra21, ra22, ra23, rb20, rb21, rb22, rb23;
  if (2 < nk) G_LOAD(2, 2)
  G_STORE(0, 0)
  __syncthreads();
  if (3 < nk) G_LOAD(0, 3)
#define G_STEP(i, SN, BN) if (kt + (i) < nk) { \
    G_COMPUTE((i) & 1) \
    if (kt + (i) + 1 < nk) G_STORE(SN, BN) \
    __syncthreads(); \
    if (kt + (i) + 4 < nk) G_LOAD(SN, kt + (i) + 4) }
  for (int kt = 0; kt < nk; kt += 6) {
    G_STEP(0, 1, 1)
    G_STEP(1, 2, 0)
    G_STEP(2, 0, 1)
    G_STEP(3, 1, 0)
    G_STEP(4, 2, 1)
    G_STEP(5, 0, 0)
  }
#undef G_STEP
#undef G_COMPUTE
}
#undef G_L1
#undef G_S1
#undef G_LOAD
#undef G_STORE

DI int vbid(int bid, int nb) { return bid; }
DI void tile_of(int tile, int ntn, int& mt, int& nt) {
  const int gm = tile / (4 * ntn), rem = tile - gm * 4 * ntn;
  nt = rem >> 2; mt = gm * 4 + (rem & 3);
}
#define ZERO_ACC(acc) _Pragma("unroll") for (int m_ = 0; m_ < 4; ++m_) _Pragma("unroll") for (int n_ = 0; n_ < 4; ++n_) acc[m_][n_] = f32x4{0.f, 0.f, 0.f, 0.f}

constexpr int ST16 = 272;
constexpr int ST32 = 528;
DI void stage_bf16(const f32x4 (&acc)[4][4], char* st, int wr, int wc, int fr, int fq) {
#pragma unroll
  for (int m = 0; m < 4; ++m)
#pragma unroll
    for (int n = 0; n < 4; ++n) {
      uint2 v; v.x = pk2(acc[m][n][0], acc[m][n][1]); v.y = pk2(acc[m][n][2], acc[m][n][3]);
      *(uint2*)(st + (wr * 64 + 16 * m + fr) * ST16 + (wc * 64 + 16 * n + 4 * fq) * 2) = v;
    }
}
DI void stage_f32(const f32x4 (&acc)[4][4], char* st, int wr, int wc, int fr, int fq) {
#pragma unroll
  for (int m = 0; m < 4; ++m)
#pragma unroll
    for (int n = 0; n < 4; ++n) *(f32x4*)(st + (wr * 64 + 16 * m + fr) * ST32 + (wc * 64 + 16 * n + 4 * fq) * 4) = acc[m][n];
}

DI void phase_ffn_up(const Params& p, int mtn, const u16* an, const u16* wt, u16* h, char* smem, int bid, int nb) {
  constexpr int NTN = 2 * DFF / 128;
  G_DECL;
  { int tile = vbid(bid, nb); if (tile < mtn * NTN) { int mt, nt; tile_of(tile, NTN, mt, nt); gemm_prefetch(G_ARGS, an, D, wt, D, mt * 128, nt * 128); } }
  for (int tile = vbid(bid, nb); tile < mtn * NTN; tile += nb) {
    int mt, nt; tile_of(tile, NTN, mt, nt);
    f32x4 acc[4][4]; ZERO_ACC(acc);
    gemm_mainloop(G_ARGS, an, D, wt, D, D / 64, mt * 128, nt * 128, acc, smem);
    if (tile + nb < mtn * NTN) { int mt2, nt2; tile_of(tile + nb, NTN, mt2, nt2); gemm_prefetch(G_ARGS, an, D, wt, D, mt2 * 128, nt2 * 128); }
    const int tid = tidx(), lane = tid & 63, wid = tid >> 6, wr = wid >> 1, wc = wid & 1, fr = lane & 15, fq = lane >> 4;
#pragma unroll
    for (int m = 0; m < 4; ++m)
#pragma unroll
      for (int n = 0; n < 2; ++n) {
        float o[4];
#pragma unroll
        for (int r = 0; r < 4; ++r) o[r] = siluf(acc[m][n][r]) * acc[m][n + 2][r];
        uint2 v; v.x = pk2(o[0], o[1]); v.y = pk2(o[2], o[3]);
        *(uint2*)(smem + (wr * 64 + 16 * m + fr) * ST16 + (wc * 32 + 16 * n + 4 * fq) * 2) = v;
      }
    __syncthreads();
    const unsigned rbase = mt * 128, cbase = nt * 64;
#pragma unroll
    for (int i = 0; i < 4; ++i) {
      const unsigned id = tid + 256 * i, row = id >> 3, ch = id & 7;
      const uint4 v = *(const uint4*)(smem + row * ST16 + ch * 16);
      *(uint4*)(h + bko(rbase + row, cbase + ch * 8, DFF / 64)) = v;
    }
    __syncthreads();
  }
}

DI void phase_gemm_resid(const Params& p, int mtn, const u16* a, int K, const u16* wt, const float* mods_l, int gate_idx, float coef, char* smem, int bid, int nb) {
  constexpr int NTN = D / 128;
  G_DECL;
  { int tile = vbid(bid, nb); if (tile < mtn * NTN) { int mt, nt; tile_of(tile, NTN, mt, nt); gemm_prefetch(G_ARGS, a, K, wt, K, mt * 128, nt * 128); } }
  for (int tile = vbid(bid, nb); tile < mtn * NTN; tile += nb) {
    int mt, nt; tile_of(tile, NTN, mt, nt);
    f32x4 acc[4][4]; ZERO_ACC(acc);
    gemm_mainloop(G_ARGS, a, K, wt, K, K / 64, mt * 128, nt * 128, acc, smem);
    if (tile + nb < mtn * NTN) { int mt2, nt2; tile_of(tile + nb, NTN, mt2, nt2); gemm_prefetch(G_ARGS, a, K, wt, K, mt2 * 128, nt2 * 128); }
    const int tid = tidx(), lane = tid & 63, wid = tid >> 6, wr = wid >> 1, wc = wid & 1, fr = lane & 15, fq = lane >> 4;
    stage_f32(acc, smem, wr, wc, fr, fq);
    __syncthreads();
    const int r0 = mt * 128;
    const float* md = mods_l + (size_t)modrow(r0) * (NMOD * D) + gate_idx * D + nt * 128;
    float* xb = xptr(p, r0) + nt * 128;
    const unsigned ch = tid & 31;
    const float4 g4 = *(const float4*)(md + ch * 4);
#pragma unroll 4
    for (int i = 0; i < 16; ++i) {
      const unsigned row = (tid >> 5) + 8 * i;
      const float4 v = *(const float4*)(smem + row * ST32 + ch * 16);
      float4* xp = (float4*)(xb + row * (unsigned)D + ch * 4);
      float4 x = *xp;
      x.x += coef * g4.x * v.x; x.y += coef * g4.y * v.y; x.z += coef * g4.z * v.z; x.w += coef * g4.w * v.w;
      *xp = x;
    }
    __syncthreads();
  }
}

DI void phase_inproj(const Params& p, int l, const u16* an, const u16* wt, char* smem, int bid, int nb) {
  constexpr int NTN = ZW / 128;
  char* ws = p.ws;
  G_DECL;
  { int tile = vbid(bid, nb); if (tile < MT * NTN) { int mt, nt; tile_of(tile, NTN, mt, nt); gemm_prefetch(G_ARGS, an, D, wt, D, mt * 128, nt * 128); } }
  for (int tile = vbid(bid, nb); tile < MT * NTN; tile += nb) {
    int mt, nt; tile_of(tile, NTN, mt, nt);
    f32x4 acc[4][4]; ZERO_ACC(acc);
    gemm_mainloop(G_ARGS, an, D, wt, D, D / 64, mt * 128, nt * 128, acc, smem);
    if (tile + nb < MT * NTN) { int mt2, nt2; tile_of(tile + nb, NTN, mt2, nt2); gemm_prefetch(G_ARGS, an, D, wt, D, mt2 * 128, nt2 * 128); }
    const int tid = tidx(), lane = tid & 63, wid = tid >> 6, wr = wid >> 1, wc = wid & 1, fr = lane & 15, fq = lane >> 4;
    if (nt == 37) {
      if (wc == 0) {
        u16* zkr = (u16*)(ws + OFF_ZKR);
#pragma unroll
        for (int m = 0; m < 4; ++m)
#pragma unroll
          for (int n = 0; n < 4; ++n) {
            const unsigned row = mt * 128 + wr * 64 + 16 * m + fr;
            uint2 v; v.x = pk2(acc[m][n][0], acc[m][n][1]); v.y = pk2(acc[m][n][2], acc[m][n][3]);
            *(uint2*)(zkr + row * 64u + 16 * n + 4 * fq) = v;
          }
      } else {
        float* zg = (float*)(ws + OFF_ZG);
        const float4 b4 = *(const float4*)(p.b_gate + l * 16 + 4 * fq);
#pragma unroll
        for (int m = 0; m < 4; ++m) {
          const unsigned row = mt * 128 + wr * 64 + 16 * m + fr;
          float4 v; v.x = acc[m][0][0] + b4.x; v.y = acc[m][0][1] + b4.y; v.z = acc[m][0][2] + b4.z; v.w = acc[m][0][3] + b4.w;
          *(float4*)(zg + row * 16u + 4 * fq) = v;
        }
      }
      continue;
    }
    if (nt >= 32 && nt < 37) {
      const bool isq = nt < 35;
      const float* gv = isq ? p.g_qa + l * 384 + (nt - 32) * 128 : p.g_kva + l * 256 + (nt - 35) * 128;
      float* ss2 = (float*)(ws + OFF_SS2);
      const int slot = isq ? (nt - 32) * 2 + wc : 8 + (nt - 35) * 2 + wc;
#pragma unroll
      for (int m = 0; m < 4; ++m) {
        float ssum = 0.f;
#pragma unroll
        for (int n = 0; n < 4; ++n) ssum += (acc[m][n][0] * acc[m][n][0] + acc[m][n][1] * acc[m][n][1]) + (acc[m][n][2] * acc[m][n][2] + acc[m][n][3] * acc[m][n][3]);
        ssum += __shfl_xor(ssum, 16); ssum += __shfl_xor(ssum, 32);
        if (fq == 0) ss2[(unsigned)(mt * 128 + wr * 64 + 16 * m + fr) * 16u + slot] = ssum;
      }
#pragma unroll
      for (int n = 0; n < 4; ++n) {
        const float4 g4 = *(const float4*)(gv + wc * 64 + 16 * n + 4 * fq);
#pragma unroll
        for (int m = 0; m < 4; ++m) { acc[m][n][0] *= g4.x; acc[m][n][1] *= g4.y; acc[m][n][2] *= g4.z; acc[m][n][3] *= g4.w; }
      }
    }
    stage_bf16(acc, smem, wr, wc, fr, fq);
    __syncthreads();
    const int c = nt * 128;
    u16* dst; unsigned ld, c0; unsigned nkb = 0;
    if (c < 4096) { dst = (u16*)(ws + OFF_ZQ) + (size_t)(c >> 10) * R * D; ld = D; c0 = c & 1023; }
    else if (c < 4480) { dst = (u16*)(ws + OFF_CQN); ld = 384; c0 = c - 4096; nkb = 6; }
    else if (c < 4736) { dst = (u16*)(ws + OFF_CKVN); ld = 256; c0 = c - 4480; nkb = 4; }
    else { dst = (u16*)(ws + OFF_ZBR); ld = 2048; c0 = c - 4864; }
    const unsigned rbase = mt * 128;
#pragma unroll
    for (int i = 0; i < 8; ++i) {
      const unsigned id = tid + 256 * i, row = id >> 4, ch = id & 15;
      const uint4 v = *(const uint4*)(smem + row * ST16 + ch * 16);
      *(uint4*)(dst + (nkb ? bko(rbase + row, c0 + ch * 8, nkb) : (rbase + row) * ld + c0 + ch * 8)) = v;
    }
    __syncthreads();
  }
}

DI void phase_prep(const Params& p, int l, int bid, int nb) {
  const int tid_ = tidx(), lane = tid_ & 63, wid = tid_ >> 6;
  char* ws = p.ws;
  const u16* zq = (const u16*)(ws + OFF_ZQ); const u16* zk = (const u16*)(ws + OFF_ZK);
  u16* qc = (u16*)(ws + OFF_AN); u16* kc = (u16*)(ws + OFF_KC);
  const float* wcv = p.w_conv + (size_t)l * 3 * 2048;
  const float2* tab = (const float2*)(ws + OFF_ROPE);
  for (int r = bid * 4 + wid; r < R; r += nb * 4) {
    int t, T;
    if (r < RL) { t = r & 4095; T = SEQ; } else { t = (r - RL) & 255; T = CTX; }
    const bool hp = t > 0, hn = t < T - 1;
#pragma unroll
    for (int c4 = 0; c4 < 4; ++c4) {
      const int ch = c4 * 512 + lane * 8;
      const bool isq = ch < 1024;
      const u16* src = isq ? zq : zk;
      const int cc = isq ? ch : ch - 1024;
      const uint4 zero = make_uint4(0, 0, 0, 0);
      const uint4 vc = *(const uint4*)(src + (size_t)r * D + cc);
      const uint4 vp = hp ? *(const uint4*)(src + (size_t)(r - 1) * D + cc) : zero;
      const uint4 vn = hn ? *(const uint4*)(src + (size_t)(r + 1) * D + cc) : zero;
      const unsigned pc[4] = {vc.x, vc.y, vc.z, vc.w}, pp[4] = {vp.x, vp.y, vp.z, vp.w}, pn[4] = {vn.x, vn.y, vn.z, vn.w};
      float o[8];
#pragma unroll
      for (int e = 0; e < 8; ++e) {
        const int sh = (e & 1) * 16;
        const float xc = bf2f((u16)(pc[e >> 1] >> sh)), xp = bf2f((u16)(pp[e >> 1] >> sh)), xn = bf2f((u16)(pn[e >> 1] >> sh));
        const float w0 = wcv[ch + e], w1 = wcv[2048 + ch + e], w2 = wcv[4096 + ch + e];
        float y = siluf(xp * w0 + xc * w1 + xn * w2);
        o[e] = isq ? y * 0.0625f : y;
      }
      uint4 ov; ov.x = pk2(o[0], o[1]); ov.y = pk2(o[2], o[3]); ov.z = pk2(o[4], o[5]); ov.w = pk2(o[6], o[7]);
      *(uint4*)((isq ? qc : kc) + (size_t)r * D + cc) = ov;
    }
    {
      const float v = bf2f(((const u16*)(ws + OFF_ZKR))[(size_t)r * 64 + lane]);
      const float pv = __shfl_xor(v, 1);
      float o = v;
      if (r < RL) {
        const float2 cs = tab[t * 32 + (lane >> 1)];
        o = (lane & 1) ? (pv * cs.y + v * cs.x) : (v * cs.x - pv * cs.y);
      }
      ((u16*)(ws + OFF_KROPE))[(size_t)r * 64 + lane] = f2bf(o);
    }
  }
  {
    const float* zg = (const float*)(ws + OFF_ZG);
    for (int item = bid * 4 + wid; item < 32 * NCH; item += nb * 4) {
      const int stream = item / NCH, n = item - stream * NCH;
      const int b = stream >> 3, hd = (stream >> 1) & 3, dir = stream & 1;
      int base, T, cc;
      if (n < 4) { base = RL + b * CTX; T = CTX; cc = n; } else { base = b * SEQ; T = SEQ; cc = n - 4; }
      const int pos = cc * 64 + lane;
      const int row = base + (dir ? T - 1 - pos : pos);
      const float ig = zg[(size_t)row * 16 + dir * 8 + hd];
      const float fg = zg[(size_t)row * 16 + dir * 8 + 4 + hd];
      const float lf = fminf(fg, 0.f) - log1pf(__expf(-fabsf(fg)));
      float bc = lf;
#pragma unroll
      for (int d = 1; d < 64; d <<= 1) { const float tt = __shfl_up(bc, d); if (lane >= d) bc += tt; }
      const float bL = __shfl(bc, 63);
      const float wv = ig - bc;
      float pm = wv;
#pragma unroll
      for (int d = 1; d < 64; d <<= 1) { const float tt = __shfl_up(pm, d); if (lane >= d) pm = fmaxf(pm, tt); }
      const float endl = bL + wv;
      const float me = wave_max(endl);
      float* g = (float*)(ws + OFF_G) + ((size_t)stream * NCH + n) * 512;
      g[lane] = bc; g[64 + lane] = wv; g[128 + lane] = pm; g[192 + lane] = endl;
      if (lane == 0) { g[256] = bL; g[257] = me; }
    }
  }
}

DI void phase_upproj(const Params& p, const u16* wb, char* smem, int bid, int nb) {
  char* ws = p.ws;
  const float2* tab = (const float2*)(ws + OFF_ROPE);
  u16* qa = (u16*)(ws + OFF_H);
  u16* kv = (u16*)(ws + OFF_KV);
  constexpr int NQ = 12, NKV = 16;
  const int total = MT * (NQ + NKV);
  G_DECL;
#define UP_PREFETCH(T) { const int t_ = (T); if (t_ < MT * NQ) { int m_, n_; tile_of(t_, NQ, m_, n_); gemm_prefetch(G_ARGS, (const u16*)(ws + OFF_CQN), 384, wb + WB_UQ, 384, m_ * 128, n_ * 128); } \
    else if (t_ < total) { int m_, n_; tile_of(t_ - MT * NQ, NKV, m_, n_); gemm_prefetch(G_ARGS, (const u16*)(ws + OFF_CKVN), 256, wb + WB_UKV, 256, m_ * 128, n_ * 128); } }
  for (int tile = vbid(bid, nb); tile < total; tile += nb) {
    const bool isq = tile < MT * NQ;
    int mt, nt;
    f32x4 acc[4][4]; ZERO_ACC(acc);
    UP_PREFETCH(tile)
    if (isq) { tile_of(tile, NQ, mt, nt); gemm_mainloop(G_ARGS, (const u16*)(ws + OFF_CQN), 384, wb + WB_UQ, 384, 6, mt * 128, nt * 128, acc, smem); }
    else { tile_of(tile - MT * NQ, NKV, mt, nt); gemm_mainloop(G_ARGS, (const u16*)(ws + OFF_CKVN), 256, wb + WB_UKV, 256, 4, mt * 128, nt * 128, acc, smem); }
    const int tid = tidx(), lane = tid & 63, wid = tid >> 6, wr = wid >> 1, wc = wid & 1, fr = lane & 15, fq = lane >> 4;
    {
      const float* ss2 = (const float*)(ws + OFF_SS2);
#pragma unroll
      for (int m = 0; m < 4; ++m) {
        const float* sp = ss2 + (unsigned)(mt * 128 + wr * 64 + 16 * m + fr) * 16u;
        float rstd;
        if (isq) { const float4 a = *(const float4*)sp; const float2 b = *(const float2*)(sp + 4); rstd = rsqrtf((((a.x + a.y) + (a.z + a.w)) + (b.x + b.y)) * (1.f / 384.f) + EPS); }
        else { const float4 a = *(const float4*)(sp + 8); rstd = rsqrtf(((a.x + a.y) + (a.z + a.w)) * (1.f / 256.f) + EPS); }
#pragma unroll
        for (int n = 0; n < 4; ++n) { acc[m][n][0] *= rstd; acc[m][n][1] *= rstd; acc[m][n][2] *= rstd; acc[m][n][3] *= rstd; }
      }
    }
    stage_bf16(acc, smem, wr, wc, fr, fq);
    __syncthreads();
    const unsigned rbase = mt * 128;
    if (isq) {
#pragma unroll
      for (int i = 0; i < 8; ++i) {
        const unsigned id = tid + 256 * i, row = id >> 4, ch = id & 15;
        uint4 v = *(const uint4*)(smem + row * ST16 + ch * 16);
        const unsigned col = nt * 128 + ch * 8, d0 = col % 192u, grow = rbase + row;
        if (d0 >= 128u && grow < (unsigned)RL) {
          const float4* tp = (const float4*)(tab + (grow & 4095u) * 32u + ((d0 - 128u) >> 1));
          const float4 t0 = tp[0], t1 = tp[1];
          float x0, x1;
          x0 = bf2f((u16)(v.x & 0xffff)); x1 = bf2f((u16)(v.x >> 16)); v.x = pk2(x0 * t0.x - x1 * t0.y, x0 * t0.y + x1 * t0.x);
          x0 = bf2f((u16)(v.y & 0xffff)); x1 = bf2f((u16)(v.y >> 16)); v.y = pk2(x0 * t0.z - x1 * t0.w, x0 * t0.w + x1 * t0.z);
          x0 = bf2f((u16)(v.z & 0xffff)); x1 = bf2f((u16)(v.z >> 16)); v.z = pk2(x0 * t1.x - x1 * t1.y, x0 * t1.y + x1 * t1.x);
          x0 = bf2f((u16)(v.w & 0xffff)); x1 = bf2f((u16)(v.w >> 16)); v.w = pk2(x0 * t1.z - x1 * t1.w, x0 * t1.w + x1 * t1.z);
        }
        *(uint4*)(qa + grow * 1536u + col) = v;
      }
    } else {
#pragma unroll
      for (int i = 0; i < 8; ++i) {
        const unsigned id = tid + 256 * i, row = id >> 4, ch = id & 15;
        const uint4 v = *(const uint4*)(smem + row * ST16 + ch * 16);
        *(uint4*)(kv + (rbase + row) * 2048u + nt * 128 + ch * 8) = v;
      }
    }
    __syncthreads();
  }
#undef UP_PREFETCH
}

constexpr int AKS = 400;
constexpr int AVS = 320;
DI void attn_task(const Params& p, int b, int h, int qrow0, int nkt, bool with_latent, char* smem) {
  const int tid = tidx(), lane = tid & 63, wid = tid >> 6, l31 = lane & 31, h2 = lane >> 5;
  char* ws = p.ws;
  const u16* qa = (const u16*)(ws + OFF_H);
  const u16* kvb = (const u16*)(ws + OFF_KV);
  const u16* krp = (const u16*)(ws + OFF_KROPE);
  u16* ao = (u16*)(ws + OFF_H) + (size_t)R * 1536;
  char* Ks = smem; char* Vs = smem + 64 * AKS;
  bf16x8 qf[12];
  {
    const u16* qp = qa + (size_t)(qrow0 + wid * 32 + l31) * 1536 + h * 192 + h2 * 8;
#pragma unroll
    for (int st = 0; st < 12; ++st) qf[st] = *(const bf16x8*)(qp + st * 16);
  }
  uint4 kreg0, kreg1, kreg2, kreg3, kreg4, kreg5, vreg0, vreg1, vreg2, vreg3;
#define KEY_ROW(kt, i) ((kt) < 4 ? (RL + b * CTX + (kt) * 64 + (i)) : (b * SEQ + ((kt) - 4) * 64 + (i)))
#define ATT_KL(kt, i) { const int id = tid + 256 * i, row = id / 24, ch = id - row * 24; const int kr = KEY_ROW(kt, row); \
    const u16* src = ch < 16 ? (kvb + (size_t)kr * 2048 + h * 256 + ch * 8) : (krp + (size_t)kr * 64 + (ch - 16) * 8); kreg##i = *(const uint4*)src; }
#define ATT_VL(kt, i) { const int id = tid + 256 * i, row = id >> 4, ch = id & 15; const int kr = KEY_ROW(kt, row); \
    vreg##i = *(const uint4*)(kvb + (size_t)kr * 2048 + h * 256 + 128 + ch * 8); }
#define ATT_GLOADK(kt) ATT_KL(kt, 0) ATT_KL(kt, 1) ATT_KL(kt, 2) ATT_KL(kt, 3) ATT_KL(kt, 4) ATT_KL(kt, 5)
#define ATT_GLOADV(kt) ATT_VL(kt, 0) ATT_VL(kt, 1) ATT_VL(kt, 2) ATT_VL(kt, 3)
#define ATT_GLOAD(kt) ATT_GLOADK(kt) ATT_GLOADV(kt)
#define ATT_KS(i) { const int id = tid + 256 * i, row = id / 24, ch = id - row * 24; *(uint4*)(Ks + row * AKS + ch * 16) = kreg##i; }
#define ATT_VS(i) { const int id = tid + 256 * i, row = id >> 4, ch = id & 15; *(uint4*)(Vs + row * AVS + ch * 16) = vreg##i; }
#define ATT_SSTORE() ATT_KS(0) ATT_KS(1) ATT_KS(2) ATT_KS(3) ATT_KS(4) ATT_KS(5) ATT_VS(0) ATT_VS(1) ATT_VS(2) ATT_VS(3)
  f32x16 o[4];
#pragma unroll
  for (int n = 0; n < 4; ++n)
#pragma unroll
    for (int i = 0; i < 16; ++i) o[n][i] = 0.f;
  float mrun = -1e30f, lrun = 0.f;
  const float sc = 0.07216878364870322f * 1.4426950408889634f;
  const int i16 = lane & 15, tq = i16 >> 2, tp = i16 & 3, blk = (lane >> 4) & 1;
  ATT_GLOAD(0)
  __syncthreads();
  ATT_SSTORE()
  __syncthreads();
  for (int kt = 0; kt < nkt; ++kt) {
    if (kt + 1 < nkt) { ATT_GLOADK(kt + 1) }
    f32x16 s0, s1;
#pragma unroll
    for (int i = 0; i < 16; ++i) { s0[i] = 0.f; s1[i] = 0.f; }
#pragma unroll
    for (int st = 0; st < 12; ++st) {
      const bf16x8 a0 = *(const bf16x8*)(Ks + l31 * AKS + st * 32 + h2 * 16);
      const bf16x8 a1 = *(const bf16x8*)(Ks + (32 + l31) * AKS + st * 32 + h2 * 16);
      s0 = MFMA32(a0, qf[st], s0);
      s1 = MFMA32(a1, qf[st], s1);
    }
    __builtin_amdgcn_sched_group_barrier(0x100, 4, 0);
#pragma unroll
    for (int i = 0; i < 10; ++i) { __builtin_amdgcn_sched_group_barrier(0x008, 2, 0); __builtin_amdgcn_sched_group_barrier(0x100, 2, 0); }
    __builtin_amdgcn_sched_group_barrier(0x008, 4, 0);
    __builtin_amdgcn_sched_barrier(0);
    float mx = s0[0];
#pragma unroll
    for (int i = 0; i < 16; ++i) { mx = fmaxf(mx, s0[i]); mx = fmaxf(mx, s1[i]); }
    mx = fmaxf(mx, __shfl_xor(mx, 32));
    const float mnew = fmaxf(mrun, mx * sc);
    const float alpha = __builtin_amdgcn_exp2f(mrun - mnew);
    mrun = mnew;
    float ls = 0.f;
#pragma unroll
    for (int i = 0; i < 16; ++i) { s0[i] = __builtin_amdgcn_exp2f(s0[i] * sc - mnew); s1[i] = __builtin_amdgcn_exp2f(s1[i] * sc - mnew); ls += s0[i] + s1[i]; }
    lrun = lrun * alpha + ls;
    if (__any(alpha != 1.f)) {
#pragma unroll
      for (int n = 0; n < 4; ++n)
#pragma unroll
        for (int i = 0; i < 16; ++i) o[n][i] *= alpha;
    }
    bf16x8 pbv[4];
#define ATT_PACK(SV, HH) \
    _Pragma("unroll") for (int s = 0; s < 2; ++s) { \
      u32x4 pu; \
      pu[0] = pk2(SV[8 * s + 0], SV[8 * s + 1]); pu[1] = pk2(SV[8 * s + 2], SV[8 * s + 3]); \
      pu[2] = pk2(SV[8 * s + 4], SV[8 * s + 5]); pu[3] = pk2(SV[8 * s + 6], SV[8 * s + 7]); \
      pbv[2 * HH + s] = __builtin_bit_cast(bf16x8, pu); \
    }
    ATT_PACK(s0, 0)
    ATT_PACK(s1, 1)
#undef ATT_PACK
    if (kt + 1 < nkt) { ATT_GLOADV(kt + 1) }
#pragma unroll
    for (int hs = 0; hs < 4; ++hs) {
      const char* vlo = Vs + (16 * hs + 4 * h2 + tq) * AVS + (16 * blk) * 2 + 8 * tp;
#pragma unroll
      for (int n = 0; n < 4; ++n) {
        const bf16x8 va = tr8(vlo + n * 64, vlo + n * 64 + 8 * AVS);
        o[n] = MFMA32(va, pbv[hs], o[n]);
      }
    }
    __syncthreads();
    if (kt + 1 < nkt) { ATT_SSTORE() }
    __syncthreads();
  }
  const float ltot = lrun + __shfl_xor(lrun, 32);
  const float inv = 1.f / ltot;
  const unsigned orow = qrow0 + wid * 32 + l31;
#pragma unroll
  for (int n = 0; n < 4; ++n)
#pragma unroll
    for (int g = 0; g < 4; ++g) {
      uint2 w; w.x = pk2(o[n][4 * g] * inv, o[n][4 * g + 1] * inv); w.y = pk2(o[n][4 * g + 2] * inv, o[n][4 * g + 3] * inv);
      *(uint2*)(ao + bko(orow, h * 128 + 32 * n + 8 * g + 4 * h2, D / 64)) = w;
    }
}

constexpr int MKS = 528;
constexpr int MVS = 112;
constexpr int M_CT = 64 * MKS;
constexpr int M_VS = M_CT + 48 * MKS;
constexpr int M_VW = M_VS + 64 * MVS;
constexpr int M_GS = 73728;
constexpr int M_MS = M_GS + 1536;
DI void mlstm_task(const Params& p, int task, char* smem) {
  const int tid = tidx(), lane = tid & 63, w = tid >> 6, fr = lane & 15, fq = lane >> 4, tq = fr >> 2, tp = fr & 3;
  const int stream = task >> 3, c = task & 7, b = stream >> 3, hd = (stream >> 1) & 3, dir = stream & 1;
  char* ws = p.ws;
  const u16* qc = (const u16*)(ws + OFF_AN); const u16* kc = (const u16*)(ws + OFF_KC); const u16* zv = (const u16*)(ws + OFF_ZV);
  const float* G = (const float*)(ws + OFF_G) + (size_t)stream * NCH * 512;
  _Float16* hout = (_Float16*)(ws + (dir ? OFF_ZK : OFF_ZQ));
  char* Ks = smem; char* Ct = smem + M_CT; char* Vs = smem + M_VS; char* Vw = smem + M_VW;
#define ROW_OF(n, pos) ((n) < 4 ? (RL + b * CTX + (dir ? CTX - 1 - ((n) * 64 + (pos)) : ((n) * 64 + (pos)))) : (b * SEQ + (dir ? SEQ - 1 - (((n) - 4) * 64 + (pos)) : (((n) - 4) * 64 + (pos)))))
  __syncthreads();
  for (int i = tid; i < 48 * MKS / 16; i += 256) ((uint4*)Ct)[i] = make_uint4(0, 0, 0, 0);
  f32x4 cacc[4][3];
#pragma unroll
  for (int kt = 0; kt < 4; ++kt)
#pragma unroll
    for (int vt = 0; vt < 3; ++vt) cacc[kt][vt] = f32x4{0.f, 0.f, 0.f, 0.f};
  uint4 kreg0, kreg1, kreg2, kreg3, kreg4, kreg5, kreg6, kreg7; uint4 vreg; float wreg; float4 greg = make_float4(0.f, 0.f, 0.f, 0.f);
#define M_KL(n, i) { const int id = tid + 256 * i, row = id >> 5, ch = id & 31; kreg##i = *(const uint4*)(kc + (size_t)ROW_OF(n, row) * D + hd * 256 + ch * 8); }
#define M_GLOAD(n) { M_KL(n, 0) M_KL(n, 1) M_KL(n, 2) M_KL(n, 3) M_KL(n, 4) M_KL(n, 5) M_KL(n, 6) M_KL(n, 7) \
    const int row_ = tid >> 2, part_ = tid & 3; \
    vreg = *(const uint4*)(zv + (size_t)ROW_OF(n, row_) * D + hd * 256 + c * 32 + part_ * 8); \
    wreg = G[(size_t)(n) * 512 + 192 + row_]; \
    if (tid < 64) { greg.x = G[(size_t)(n) * 512 + tid]; greg.y = G[(size_t)(n) * 512 + 64 + tid]; greg.z = G[(size_t)(n) * 512 + 128 + tid]; greg.w = G[(size_t)(n) * 512 + 192 + tid]; } }
#define M_KS(i) { const int id = tid + 256 * i, row = id >> 5, ch = id & 31; *(uint4*)(Ks + row * MKS + ch * 16) = kreg##i; }
#define M_SSTORE(n) { M_KS(0) M_KS(1) M_KS(2) M_KS(3) M_KS(4) M_KS(5) M_KS(6) M_KS(7) \
    const int row = tid >> 2, part = tid & 3; \
    const float mp_ = ((const float*)(smem + M_MS))[136 + (n)], mn_ = ((const float*)(smem + M_MS))[204 + (n)]; \
    if (tid < 64) { float* gs_ = (float*)(smem + M_GS); const float mj_ = fmaxf(greg.x + mp_, greg.x + greg.z); \
      gs_[tid] = greg.x - mj_; gs_[64 + tid] = greg.y; gs_[128 + tid] = __expf(greg.x + mp_ - mj_); gs_[192 + tid] = __expf(-mj_); gs_[256 + tid] = __expf(greg.w - mn_); \
      if (tid == 0) gs_[320] = __expf(((const float*)(smem + M_MS))[(n)] + mp_ - mn_); } \
    wreg = __expf(wreg - mn_); \
    *(uint4*)(Vs + row * MVS + part * 16) = vreg; \
    uint4 wv; \
    wv.x = pk2(bf2f((u16)(vreg.x & 0xffff)) * wreg, bf2f((u16)(vreg.x >> 16)) * wreg); \
    wv.y = pk2(bf2f((u16)(vreg.y & 0xffff)) * wreg, bf2f((u16)(vreg.y >> 16)) * wreg); \
    wv.z = pk2(bf2f((u16)(vreg.z & 0xffff)) * wreg, bf2f((u16)(vreg.z >> 16)) * wreg); \
    wv.w = pk2(bf2f((u16)(vreg.w & 0xffff)) * wreg, bf2f((u16)(vreg.w >> 16)) * wreg); \
    *(uint4*)(Vw + row * MVS + part * 16) = wv; \
    if (part == 0) { \
      *(uint4*)(Vs + row * MVS + 64) = make_uint4(0x3f80u, 0, 0, 0); \
      *(uint4*)(Vs + row * MVS + 80) = make_uint4(0, 0, 0, 0); \
      *(uint4*)(Vw + row * MVS + 64) = make_uint4((unsigned)f2bf(wreg), 0, 0, 0); \
      *(uint4*)(Vw + row * MVS + 80) = make_uint4(0, 0, 0, 0); \
    } }
#define M_QLOAD(n) { \
    const u16* qp = qc + (size_t)ROW_OF(n, 16 * w + fr) * D + hd * 256 + fq * 8; \
    _Pragma("unroll") for (int ks = 0; ks < 8; ++ks) qf[ks] = *(const bf16x8*)(qp + ks * 32); }
  bf16x8 qf[8];
  M_GLOAD(0) M_QLOAD(0)
  {
    float* ms = (float*)(smem + M_MS);
    if (tid < NCH) { ms[tid] = G[(size_t)tid * 512 + 256]; ms[68 + tid] = G[(size_t)tid * 512 + 257]; }
    __syncthreads();
    if (tid == 0) { float m = 0.f; for (int i = 0; i < NCH; ++i) { const float mn = fmaxf(ms[i] + m, ms[68 + i]); ms[136 + i] = m; ms[204 + i] = mn; m = mn; } }
    __syncthreads();
  }
  M_SSTORE(0)
  __syncthreads();
  for (int n = 0; n < NCH; ++n) {
    const bool more = n + 1 < NCH;
    if (more) M_GLOAD(n + 1)
    const float* g = (const float*)(smem + M_GS);
    const int jpos = 16 * w + fr;
    const float u_j = g[jpos], e_j = g[128 + jpos], rd_j = g[192 + jpos];
    const float a_state = g[320];
    f32x4 xs[4];
#pragma unroll
    for (int st = 0; st < 4; ++st) {
      xs[st] = f32x4{0.f, 0.f, 0.f, 0.f};
      if (st <= w) {
#pragma unroll
        for (int ks = 0; ks < 8; ++ks) {
          const bf16x8 a = *(const bf16x8*)(Ks + (16 * st + fr) * MKS + ks * 64 + fq * 16);
          xs[st] = MFMA16(a, qf[ks], xs[st]);
        }
        const float4 wv4 = *(const float4*)(g + 64 + 16 * st + 4 * fq);
        const int sb = 16 * st + 4 * fq;
        xs[st][0] *= (sb + 0 <= jpos) ? __expf(u_j + wv4.x) : 0.f;
        xs[st][1] *= (sb + 1 <= jpos) ? __expf(u_j + wv4.y) : 0.f;
        xs[st][2] *= (sb + 2 <= jpos) ? __expf(u_j + wv4.z) : 0.f;
        xs[st][3] *= (sb + 3 <= jpos) ? __expf(u_j + wv4.w) : 0.f;
      }
    }
    bf16x8 pb[2];
#pragma unroll
    for (int u = 0; u < 2; ++u) {
      u32x4 pu;
      pu[0] = pk2(xs[2 * u][0], xs[2 * u][1]); pu[1] = pk2(xs[2 * u][2], xs[2 * u][3]);
      pu[2] = pk2(xs[2 * u + 1][0], xs[2 * u + 1][1]); pu[3] = pk2(xs[2 * u + 1][2], xs[2 * u + 1][3]);
      pb[u] = __builtin_bit_cast(bf16x8, pu);
    }
    f32x4 num[3];
#pragma unroll
    for (int vt = 0; vt < 3; ++vt) {
      f32x4 n1 = {0.f, 0.f, 0.f, 0.f}, n2 = {0.f, 0.f, 0.f, 0.f};
#pragma unroll
      for (int u = 0; u < 2; ++u) {
        const char* lo = Vs + (32 * u + 4 * fq + tq) * MVS + (16 * vt) * 2 + 8 * tp;
        const bf16x8 a = tr8(lo, lo + 16 * MVS);
        n1 = MFMA16(a, pb[u], n1);
      }
#pragma unroll
      for (int ks = 0; ks < 8; ++ks) {
        const bf16x8 a = *(const bf16x8*)(Ct + (16 * vt + fr) * MKS + ks * 64 + fq * 16);
        n2 = MFMA16(a, qf[ks], n2);
      }
#pragma unroll
      for (int r = 0; r < 4; ++r) num[vt][r] = n1[r] + e_j * n2[r];
    }
    const float den = __shfl(num[2][0], fr);
    const float inv = 1.f / fmaxf(fabsf(den), rd_j);
    {
      _Float16* hp = hout + (size_t)ROW_OF(n, jpos) * D + hd * 256 + c * 32 + 4 * fq;
#pragma unroll
      for (int vt = 0; vt < 2; ++vt) {
        h16x4 hv;
#pragma unroll
        for (int r = 0; r < 4; ++r) hv[r] = (_Float16)(num[vt][r] * inv);
        *(h16x4*)(hp + 16 * vt) = hv;
      }
    }
    if (more) M_QLOAD(n + 1)
    __syncthreads();
#pragma unroll
    for (int kt = 0; kt < 4; ++kt)
#pragma unroll
      for (int vt = 0; vt < 3; ++vt) cacc[kt][vt] *= a_state;
#pragma unroll
    for (int u = 0; u < 2; ++u) {
      bf16x8 bfr[3];
#pragma unroll
      for (int vt = 0; vt < 3; ++vt) {
        const char* lo = Vw + (32 * u + 8 * fq + tq) * MVS + (16 * vt) * 2 + 8 * tp;
        bfr[vt] = tr8(lo, lo + 4 * MVS);
      }
#pragma unroll
      for (int kt = 0; kt < 4; ++kt) {
        const char* lo = Ks + (32 * u + 8 * fq + tq) * MKS + (64 * w + 16 * kt) * 2 + 8 * tp;
        const bf16x8 af = tr8(lo, lo + 4 * MKS);
#pragma unroll
        for (int vt = 0; vt < 3; ++vt) cacc[kt][vt] = MFMA16(af, bfr[vt], cacc[kt][vt]);
      }
    }
#pragma unroll
    for (int kt = 0; kt < 4; ++kt)
#pragma unroll
      for (int vt = 0; vt < 3; ++vt) {
        uint2 o2; o2.x = pk2(cacc[kt][vt][0], cacc[kt][vt][1]); o2.y = pk2(cacc[kt][vt][2], cacc[kt][vt][3]);
        *(uint2*)(Ct + (16 * vt + fr) * MKS + (64 * w + 16 * kt + 4 * fq) * 2) = o2;
      }
    __syncthreads();
    if (more) M_SSTORE(n + 1)
    __syncthreads();
  }
}

DI int q_pull(int* head, volatile LAS unsigned* s_task_p) {
  __syncthreads();
  if (threadIdx.x == 0) *s_task_p = (unsigned)atomicAdd(head, 1);
  __syncthreads();
  return (int)*s_task_p;
}
DI void phase_mix(const Params& p, int l, char* smem, volatile LAS unsigned* s_task_p, int bid, int nb) {
  int* C = (int*)(p.ws + OFF_CTR) + l * 16;
  const bool last = (l & 3) == NL - 1;
  const int per_g = last ? 32 : 34;
  const int n_cv = last ? 0 : NCONV;
  const int xcd = (int)(xb_xcc_id() & 7u);
  for (;;) { const int t = q_pull(C, s_task_p); if (t >= 256) break; mlstm_task(p, t, smem); }
  for (int j = 0; j < 8; ++j) {
    const int x = (xcd + j) & 7;
    for (;;) {
      const int e = q_pull(C + 1 + x, s_task_p);
      if (e >= 4 * per_g) break;
      const int gi = e / per_g, r = e - gi * per_g, g = x + 8 * gi, b = g >> 3, h = g & 7;
      if (r < 32) attn_task(p, b, h, b * SEQ + r * 128, 68, true, smem);
      else attn_task(p, b, h, RL + b * CTX + (r - 32) * 128, 4, false, smem);
    }
  }
  for (;;) { const int t = q_pull(C + 9, s_task_p); if (t >= n_cv) break; const int c0 = t * CONV_PER_TASK; convert_range(p, (l & 3) + 1, smem, c0, c0 + CONV_PER_TASK, 1); }
}

DI void phase_mout(const Params& p, int l, int bid, int nb) {
  const int tid_ = tidx(), lane = tid_ & 63, wid = tid_ >> 6;
  char* ws = p.ws;
  const _Float16* hf = (const _Float16*)(ws + OFF_ZQ); const _Float16* hb = (const _Float16*)(ws + OFF_ZK);
  const u16* zo = (const u16*)(ws + OFF_ZO);
  u16* hm = (u16*)(ws + OFF_KC);
  for (int r = bid * 4 + wid; r < R; r += nb * 4) {
#pragma unroll
    for (int hd = 0; hd < 4; ++hd) {
      const size_t off = (size_t)r * D + hd * 256 + lane * 4;
      const h16x4 a = *(const h16x4*)(hf + off), bb = *(const h16x4*)(hb + off);
      float v[4]; float ss = 0.f;
#pragma unroll
      for (int e = 0; e < 4; ++e) { v[e] = (float)a[e] + (float)bb[e]; ss += v[e] * v[e]; }
      ss = wave_sum(ss);
      const float rstd = rsqrtf(ss * (1.f / 256.f) + EPS);
      const uint2 z = *(const uint2*)(zo + off);
      const float4 g4 = *(const float4*)(p.g_mh + (size_t)l * D + hd * 256 + lane * 4);
      const float o0 = sigmf(bf2f((u16)(z.x & 0xffff))) * v[0] * rstd * g4.x;
      const float o1 = sigmf(bf2f((u16)(z.x >> 16))) * v[1] * rstd * g4.y;
      const float o2 = sigmf(bf2f((u16)(z.y & 0xffff))) * v[2] * rstd * g4.z;
      const float o3 = sigmf(bf2f((u16)(z.y >> 16))) * v[3] * rstd * g4.w;
      uint2 o; o.x = pk2(o0, o1); o.y = pk2(o2, o3);
      *(uint2*)(hm + bko(r, hd * 256 + lane * 4, D / 64)) = o;
    }
  }
}

DI void phase_merge(const Params& p, const u16* wb, int mtn, char* smem, int bid, int nb) {
  constexpr int NTN = D / 128;
  char* ws = p.ws;
  const u16* hm = (const u16*)(ws + OFF_KC);
  const u16* ao = (const u16*)(ws + OFF_H) + (size_t)R * 1536;
  const u16* zbr = (const u16*)(ws + OFF_ZBR);
  u16* tt = (u16*)(ws + OFF_AN);
  G_DECL;
  for (int tile = vbid(bid, nb); tile < mtn * NTN; tile += nb) {
    int mt, nt; tile_of(tile, NTN, mt, nt);
    f32x4 acc[4][4]; ZERO_ACC(acc);
    gemm_prefetch(G_ARGS, hm, D, wb + WB_BM, D, mt * 128, nt * 128);
    gemm_mainloop(G_ARGS, hm, D, wb + WB_BM, D, D / 64, mt * 128, nt * 128, acc, smem);
    const unsigned rbase = mt * 128;
    {
      const int tid = tidx(), lane = tid & 63, wid = tid >> 6, wr = wid >> 1, wc = wid & 1, fr = lane & 15, fq = lane >> 4;
      stage_bf16(acc, smem, wr, wc, fr, fq);
      __syncthreads();
#pragma unroll
      for (int i = 0; i < 8; ++i) {
        const unsigned id = tid + 256 * i, row = id >> 4, ch = id & 15;
        const uint4 a = *(const uint4*)(smem + row * ST16 + ch * 16);
        const unsigned grow = rbase + row, col = nt * 128 + ch * 8;
        const uint4 gm = *(const uint4*)(zbr + grow * 2048u + col);
        uint4 o;
#define MRG1(F) o.F = pk2(sigmf(bf2f((u16)(gm.F & 0xffff))) * bf2f((u16)(a.F & 0xffff)), sigmf(bf2f((u16)(gm.F >> 16))) * bf2f((u16)(a.F >> 16)));
        MRG1(x) MRG1(y) MRG1(z) MRG1(w)
#undef MRG1
        *(uint4*)(tt + bko(grow, col, D / 64)) = o;
      }
      __syncthreads();
    }
    ZERO_ACC(acc);
    gemm_prefetch(G_ARGS, ao, D, wb + WB_BA, D, mt * 128, nt * 128);
    gemm_mainloop(G_ARGS, ao, D, wb + WB_BA, D, D / 64, mt * 128, nt * 128, acc, smem);
    const int tid = tidx(), lane = tid & 63, wid = tid >> 6, wr = wid >> 1, wc = wid & 1, fr = lane & 15, fq = lane >> 4;
    stage_bf16(acc, smem, wr, wc, fr, fq);
    __syncthreads();
#pragma unroll
    for (int i = 0; i < 8; ++i) {
      const unsigned id = tid + 256 * i, row = id >> 4, ch = id & 15;
      const uint4 b = *(const uint4*)(smem + row * ST16 + ch * 16);
      const unsigned grow = rbase + row, col = nt * 128 + ch * 8;
      const uint4 a = *(const uint4*)(tt + bko(grow, col, D / 64));
      const uint4 ga = *(const uint4*)(zbr + grow * 2048u + 1024u + col);
      uint4 o;
#define MRG(F) { \
      const float o0 = bf2f((u16)(a.F & 0xffff)) + sigmf(bf2f((u16)(ga.F & 0xffff))) * bf2f((u16)(b.F & 0xffff)); \
      const float o1 = bf2f((u16)(a.F >> 16)) + sigmf(bf2f((u16)(ga.F >> 16))) * bf2f((u16)(b.F >> 16)); \
      o.F = pk2(o0, o1); }
      MRG(x) MRG(y) MRG(z) MRG(w)
#undef MRG
      *(uint4*)(tt + bko(grow, col, D / 64)) = o;
    }
    __syncthreads();
  }
}

__global__ void __launch_bounds__(256, 2) fwd_kernel(Params p) {
  extern __shared__ __attribute__((aligned(16))) char smem[];
  __shared__ __attribute__((aligned(16))) unsigned xbw[4];
  const int bid = blockIdx.x, nb = gridDim.x;
  char* ws = p.ws;
  u16* an = (u16*)(ws + OFF_AN);
  u16* hbuf = (u16*)(ws + OFF_H);
  if (threadIdx.x < 4) xbw[threadIdx.x] = 0u;
  __syncthreads();
  XcdBarrier xb = xcd_barrier_post((unsigned*)(ws + OFF_BAR), (volatile LAS unsigned*)xbw);
  for (int ph = p.ph_lo; ph < p.ph_hi; ++ph) {
    if (ph == NPH - 1) {
      phase_final(p, bid, nb);
    } else {
      const int l = ph / NPH_LAYER, k = ph - l * NPH_LAYER;
      if (k == 0 && l > 0) continue;
      if (k == 7) continue;
      const u16* wb = (const u16*)(ws + OFF_WB) + (size_t)(l & 1) * WB_END;
      const float* mods_l = (const float*)(ws + OFF_MODS) + (size_t)l * 5 * NMOD * D;
      const int mtl = (l == NL - 1) ? RL / 128 : MT;
      const int nrep = ((DUP_MASK >> k) & 1) ? 2 : 1;
      for (int rep = 0; rep < nrep; ++rep) {
      if (rep) xcd_barrier(xb);
      switch (k) {
        case 0:
          if (l == 0) phase_init(p, smem, bid, nb);
          phase_convert(p, l, smem, bid, nb);
          break;
        case 1: phase_norm(p, R, p.g_n1 + l * D, mods_l, 0, 1, an, bid, nb); break;
        case 2: phase_ffn_up(p, MT, an, wb + WB_UP1, hbuf, smem, bid, nb); break;
        case 3: phase_gemm_resid(p, MT, hbuf, DFF, wb + WB_DN1, mods_l, 2, 0.5f, smem, bid, nb); break;
        case 4: phase_norm(p, R, p.g_n2 + l * D, mods_l, 3, 4, an, bid, nb); break;
        case 5: phase_inproj(p, l, an, wb + WB_IN, smem, bid, nb); break;
        case 6: phase_prep(p, l, bid, nb); phase_upproj(p, wb, smem, bid, nb); break;
        case 7: phase_upproj(p, wb, smem, bid, nb); break;
        case 8: phase_mix(p, l + 4 * rep, smem, (volatile LAS unsigned*)&xbw[2], bid, nb); break;
        case 9: phase_mout(p, l, bid, nb); break;
        case 10: phase_merge(p, wb, mtl, smem, bid, nb); break;
        case 11: phase_gemm_resid(p, mtl, an, D, wb + WB_OUT, mods_l, 5, 1.0f, smem, bid, nb); break;
        case 12: phase_norm(p, mtl * 128, p.g_n3 + l * D, mods_l, 6, 7, an, bid, nb); break;
        case 13: phase_ffn_up(p, mtl, an, wb + WB_UP2, hbuf, smem, bid, nb); break;
        case 14: phase_gemm_resid(p, mtl, hbuf, DFF, wb + WB_DN2, mods_l, 8, 0.5f, smem, bid, nb); break;
      }
      }
    }
    if (ph + 1 < p.ph_hi) { if (ph == 0) cg::this_grid().sync(); else xcd_barrier(xb); }
  }
}

extern "C" void kernel_launch(void* const* d_in, const int* in_sizes, int n_in, void* d_out, int out_size, void* d_ws, size_t ws_size, hipStream_t stream) {
  static int grid = 0;
  if (grid == 0) {
    if (n_in != 25 || ws_size < WS_END) { fprintf(stderr, "kernel_launch: unexpected n_in %d or ws_size %zu (< %zu)\n", n_in, ws_size, (size_t)WS_END); grid = -1; return; }
    int dev = 0, cus = 0, per_cu = 0;
    hipGetDevice(&dev);
    hipDeviceGetAttribute(&cus, hipDeviceAttributeMultiprocessorCount, dev);
    hipFuncSetAttribute((const void*)fwd_kernel, hipFuncAttributeMaxDynamicSharedMemorySize, SMEM_BYTES);
    hipOccupancyMaxActiveBlocksPerMultiprocessor(&per_cu, (const void*)fwd_kernel, 256, SMEM_BYTES);
    if (per_cu < 1) per_cu = 1;
    if (per_cu > 2) per_cu = 2;
    grid = cus * per_cu;
    fprintf(stderr, "kernel_launch: grid %d (%d CUs x %d), ws need %zu have %zu\n", grid, cus, per_cu, (size_t)WS_END, ws_size);
  }
  if (grid < 0) return;
  Params p{};
  const float** f = (const float**)&p;
  for (int i = 0; i < 25; ++i) f[i] = (const float*)d_in[i];
  p.out = (float*)d_out; p.ws = (char*)d_ws;
  hipMemsetAsync((char*)d_ws + OFF_CTR, 0, (OFF_WB - OFF_CTR), stream);
#if ONE_LAUNCH
  p.ph_lo = 0; p.ph_hi = NPH;
  void* args[] = {&p};
  hipError_t e = hipLaunchCooperativeKernel((const void*)fwd_kernel, dim3(grid), dim3(256), args, SMEM_BYTES, stream);
  if (e != hipSuccess) fprintf(stderr, "cooperative launch failed: %s (grid %d)\n", hipGetErrorString(e), grid);
#else
  for (int ph = 0; ph < NPH; ++ph) {
    p.ph_lo = ph; p.ph_hi = ph + 1;
    hipLaunchKernelGGL(fwd_kernel, dim3(grid), dim3(256), SMEM_BYTES, stream, p);
  }
#endif
}
```

```cpp
#include <hip/hip_runtime.h>
#include <hip/hip_cooperative_groups.h>
#include <cstdio>
namespace cg = cooperative_groups;

#ifndef DUP_MASK
#define DUP_MASK 0
#endif
#ifndef ONE_LAUNCH
#define ONE_LAUNCH 1
#endif

typedef unsigned short u16;
typedef __attribute__((ext_vector_type(8))) short bf16x8;
typedef __attribute__((ext_vector_type(4))) short s16x4;
typedef __attribute__((ext_vector_type(4))) float f32x4;
typedef __attribute__((ext_vector_type(16))) float f32x16;
typedef __attribute__((ext_vector_type(4))) _Float16 h16x4;
typedef __attribute__((ext_vector_type(4))) unsigned u32x4;
#define DI __device__ __forceinline__
#define MFMA16(a, b, c) __builtin_amdgcn_mfma_f32_16x16x32_bf16((a), (b), (c), 0, 0, 0)
#define MFMA32(a, b, c) __builtin_amdgcn_mfma_f32_32x32x16_bf16((a), (b), (c), 0, 0, 0)

constexpr int D = 1024, NB = 4, SEQ = 4096, NL = 4, CTX = 256;
constexpr int RL = NB * SEQ;
constexpr int RC = NB * CTX;
constexpr int R = RL + RC;
constexpr int DFF = 2816, INW = 6864, ZW = 6912, NMOD = 9;
constexpr float EPS = 1e-6f;
constexpr int NCH = 68;
constexpr int MT = R / 128;

constexpr size_t al(size_t x) { return (x + 255) & ~(size_t)255; }
constexpr size_t OFF_XC = 0;
constexpr size_t OFF_MODS = al(OFF_XC + (size_t)RC * D * 4);
constexpr size_t OFF_ROPE = al(OFF_MODS + (size_t)NL * 5 * NMOD * D * 4);
constexpr size_t OFF_G = al(OFF_ROPE + (size_t)SEQ * 32 * 8);
constexpr size_t OFF_CTR = al(OFF_G + (size_t)32 * NCH * 512 * 4);
constexpr size_t OFF_BAR = al(OFF_CTR + 8 * 16 * 4);
constexpr size_t OFF_WB = al(OFF_BAR + 3456 * 4);
constexpr size_t WB_UP1 = 0;
constexpr size_t WB_DN1 = WB_UP1 + (size_t)2 * DFF * D;
constexpr size_t WB_UP2 = WB_DN1 + (size_t)D * DFF;
constexpr size_t WB_DN2 = WB_UP2 + (size_t)2 * DFF * D;
constexpr size_t WB_IN = WB_DN2 + (size_t)D * DFF;
constexpr size_t WB_UQ = WB_IN + (size_t)ZW * D;
constexpr size_t WB_UKV = WB_UQ + (size_t)1536 * 384;
constexpr size_t WB_BM = WB_UKV + (size_t)2048 * 256;
constexpr size_t WB_BA = WB_BM + (size_t)D * D;
constexpr size_t WB_OUT = WB_BA + (size_t)D * D;
constexpr size_t WB_END = WB_OUT + (size_t)D * D;
constexpr size_t OFF_AN = al(OFF_WB + 2 * WB_END * 2);
constexpr size_t OFF_H = al(OFF_AN + (size_t)R * D * 2);
constexpr size_t OFF_ZQ = al(OFF_H + (size_t)R * DFF * 2);
constexpr size_t OFF_ZK = al(OFF_ZQ + (size_t)R * D * 2);
constexpr size_t OFF_ZV = al(OFF_ZK + (size_t)R * D * 2);
constexpr size_t OFF_ZO = al(OFF_ZV + (size_t)R * D * 2);
constexpr size_t OFF_ZCQ = al(OFF_ZO + (size_t)R * D * 2);
constexpr size_t OFF_ZCKV = al(OFF_ZCQ + (size_t)R * 384 * 2);
constexpr size_t OFF_ZKR = al(OFF_ZCKV + (size_t)R * 256 * 2);
constexpr size_t OFF_ZG = al(OFF_ZKR + (size_t)R * 64 * 2);
constexpr size_t OFF_ZBR = al(OFF_ZG + (size_t)R * 16 * 4);
constexpr size_t OFF_KC = al(OFF_ZBR + (size_t)R * 2048 * 2);
constexpr size_t OFF_KV = al(OFF_KC + (size_t)R * D * 2);
constexpr size_t OFF_CQN = al(OFF_KV + (size_t)R * 2048 * 2);
constexpr size_t OFF_CKVN = al(OFF_CQN + (size_t)R * 384 * 2);
constexpr size_t OFF_KROPE = al(OFF_CKVN + (size_t)R * 256 * 2);
constexpr size_t OFF_SS2 = al(OFF_KROPE + (size_t)R * 64 * 2);
constexpr size_t WS_END = al(OFF_SS2 + (size_t)R * 16 * 4);

constexpr int SMEM_BYTES = 76800;
constexpr int NPH_LAYER = 15;
constexpr int NPH = NL * NPH_LAYER + 1;

struct Params {
  const float *x, *c, *ctx, *c_ctx, *w_ada, *b_ada, *g_n1, *g_n2, *g_n3, *w_ff1_up, *w_ff1_dn, *w_ff2_up, *w_ff2_dn,
      *w_in, *b_gate, *w_conv, *g_mh, *g_qa, *g_kva, *w_uq, *w_ukv, *w_bm, *w_ba, *w_out, *g_final;
  float* out;
  char* ws;
  int ph_lo, ph_hi;
};

DI float bf2f(u16 u) { return __uint_as_float(((unsigned)u) << 16); }
DI u16 f2bf(float x) { return __builtin_bit_cast(u16, (__bf16)x); }
DI unsigned pk2(float a, float b) { return (unsigned)f2bf(a) | ((unsigned)f2bf(b) << 16); }
DI float siluf(float x) { return x / (1.f + __expf(-x)); }
DI float sigmf(float x) { return 1.f / (1.f + __expf(-x)); }
DI float wave_sum(float v) {
#pragma unroll
  for (int o = 32; o > 0; o >>= 1) v += __shfl_xor(v, o);
  return v;
}
DI float wave_max(float v) {
#pragma unroll
  for (int o = 32; o > 0; o >>= 1) v = fmaxf(v, __shfl_xor(v, o));
  return v;
}
DI int tidx() { int t = threadIdx.x; asm volatile("" : "+v"(t)); return t; }
DI unsigned bko(unsigned r, unsigned k, unsigned nkt) { return ((r >> 7) * nkt + (k >> 6)) * 8192u + ((r & 127u) << 6) + (k & 63u); }
DI float* xptr(const Params& p, int r) { return r < RL ? p.out + (size_t)r * D : (float*)(p.ws + OFF_XC) + (size_t)(r - RL) * D; }
DI const float* xin_ptr(const Params& p, int r) { return r < RL ? p.x + (size_t)r * D : p.ctx + (size_t)(r - RL) * D; }
DI int modrow(int r) { return r < RL ? (r >> 12) : 4; }
DI bf16x8 tr8(const char* lo, const char* hi) {
  s16x4 a = __builtin_amdgcn_ds_read_tr16_b64_v4i16((s16x4 __attribute__((address_space(3)))*)(lo));
  s16x4 b = __builtin_amdgcn_ds_read_tr16_b64_v4i16((s16x4 __attribute__((address_space(3)))*)(hi));
  return __builtin_shufflevector(a, b, 0, 1, 2, 3, 4, 5, 6, 7);
}


#define XB_TMO      128
#define XB_XCNT(j)  (256  + 64 * (j))
#define XB_XSUB(j)  (1280 + 64 * (j))
#define XB_XGEN(j)  (2304 + 64 * (j))
#define XB_TOP      3328
#define XB_TOPGEN   3392
#define XCD_BAR_WORDS 3456
#define XB_SPIN_CAP (1u << 22)
#define LAS __attribute__((address_space(3)))
DI unsigned xb_ld(unsigned* p) { return __hip_atomic_load(p, __ATOMIC_RELAXED, __HIP_MEMORY_SCOPE_AGENT); }
DI unsigned xb_add(unsigned* p, unsigned v) { return __hip_atomic_fetch_add(p, v, __ATOMIC_RELAXED, __HIP_MEMORY_SCOPE_AGENT); }
DI unsigned xb_xcc_id() { return (unsigned)__builtin_amdgcn_s_getreg((3 << 11) | 20) & 0xFu; }
#define XB_SPIN(cond, bar) do { unsigned _sp = 0; while (cond) { __builtin_amdgcn_s_sleep(1); \
    if ((++_sp & 255u) == 0u) { if (xb_ld(&(bar)[XB_TMO])) break; if (_sp > XB_SPIN_CAP) { atomicAdd(&(bar)[XB_TMO], 1u); break; } } } } while (0)
struct XcdBarrier { unsigned* bar; unsigned x; volatile LAS unsigned* st; };
DI XcdBarrier xcd_barrier_post(unsigned* bar, volatile LAS unsigned* st) {
  XcdBarrier b; b.bar = bar; b.x = xb_xcc_id(); b.st = st;
  if (threadIdx.x == 0) (void)xb_add(&bar[XB_XCNT(b.x)], 1u);
  return b;
}
DI void xcd_barrier_complete(unsigned* bar, unsigned x, unsigned& nloc, unsigned& nx) {
  const unsigned G = gridDim.x * gridDim.y * gridDim.z;
  unsigned sum, cnt, mine, sp = 0u;
  for (;;) {
    sum = 0u; cnt = 0u; mine = 0u;
#pragma unroll
    for (unsigned j = 0; j < 16; ++j) { const unsigned c = xb_ld(&bar[XB_XCNT(j)]); sum += c; cnt += (c > 0u) ? 1u : 0u; mine = (j == x) ? c : mine; }
    if (sum == G) break;
    __builtin_amdgcn_s_sleep(1);
    if ((++sp & 255u) == 0u) { if (xb_ld(&bar[XB_TMO])) break; if (sp > XB_SPIN_CAP) { atomicAdd(&bar[XB_TMO], 1u); break; } }
  }
  nloc = mine > 0u ? mine : 1u; nx = cnt > 0u ? cnt : 1u;
}
DI void xcd_barrier(const XcdBarrier& b) {
  asm volatile("s_waitcnt vmcnt(0)" ::: "memory");
  __syncthreads();
  if (threadIdx.x == 0) {
    unsigned* bar = b.bar;
    __builtin_amdgcn_s_waitcnt(0);
    unsigned nloc = b.st[0], nx = b.st[1];
    if (nloc == 0u) { xcd_barrier_complete(bar, b.x, nloc, nx); b.st[0] = nloc; b.st[1] = nx; }
    const unsigned old = xb_add(&bar[XB_XSUB(b.x)], 1u);
    const unsigned gen = old / nloc;
    if (old + 1u == (gen + 1u) * nloc) {
      __builtin_amdgcn_fence(__ATOMIC_RELEASE, "agent");
      asm volatile("s_waitcnt vmcnt(0)" ::: "memory");
      const unsigned og = xb_add(&bar[XB_TOP], 1u);
      const unsigned tg = og / nx;
      if (og + 1u == (tg + 1u) * nx) xb_add(&bar[XB_TOPGEN], 1u);
      else XB_SPIN(xb_ld(&bar[XB_TOPGEN]) == tg, bar);
      __builtin_amdgcn_fence(__ATOMIC_ACQUIRE, "agent");
      xb_add(&bar[XB_XGEN(b.x)], 1u);
      asm volatile("s_waitcnt vmcnt(0)" ::: "memory");
    } else {
      XB_SPIN(xb_ld(&bar[XB_XGEN(b.x)]) == gen, bar);
      __builtin_amdgcn_fence(__ATOMIC_ACQUIRE, "agent");
      asm volatile("s_waitcnt vmcnt(0)" ::: "memory");
    }
  }
  __syncthreads();
}

DI int src_col(int perm, int r) {
  if (perm == 0) return r;
  if (perm == 1) { int grp = r >> 6, j = r & 63; return j < 32 ? grp * 32 + j : DFF + grp * 32 + (j - 32); }
  if (r < 4096) return r;
  if (r < 4800) return r + 16;
  if (r < 4816) return r - 704;
  if (r < 4864) return -1;
  return r - 48;
}

DI void convert_tile(const float* __restrict__ W, int Nsrc, int K, int perm, u16* __restrict__ Wt, int tile, char* smem) {
  const int nkt = K >> 6;
  const int rt = tile / nkt, kt = tile - rt * nkt;
  const int r0 = rt * 32, k0 = kt * 64;
  u16* t = (u16*)smem;
  const int tid = tidx();
  {
    const int j = tid & 31, i = tid >> 5;
    const int sc = src_col(perm, r0 + j);
#pragma unroll
    for (int s = 0; s < 8; ++s) {
      const int k = i + 8 * s;
      float v = sc >= 0 ? W[(size_t)(k0 + k) * Nsrc + sc] : 0.f;
      t[j * 72 + k] = f2bf(v);
    }
  }
  __syncthreads();
  {
    const int row = tid >> 3, c8 = tid & 7;
    uint4 v = *(const uint4*)(t + row * 72 + c8 * 8);
    *(uint4*)(Wt + bko(r0 + row, k0 + c8 * 8, K >> 6)) = v;
  }
  __syncthreads();
}

DI void convert_range(const Params& p, int l, char* smem, int t0, int t1, int tstep) {
  u16* wb = (u16*)(p.ws + OFF_WB) + (size_t)(l & 1) * WB_END;
  constexpr int T_UP = (2 * DFF / 32) * (D / 64);
  constexpr int T_DN = (D / 32) * (DFF / 64);
  constexpr int T_IN = (ZW / 32) * (D / 64);
  constexpr int T_UQ = (1536 / 32) * (384 / 64);
  constexpr int T_UKV = (2048 / 32) * (256 / 64);
  constexpr int T_SQ = (D / 32) * (D / 64);
  constexpr int C1 = T_UP, C2 = C1 + T_DN, C3 = C2 + T_UP, C4 = C3 + T_DN, C5 = C4 + T_IN, C6 = C5 + T_UQ, C7 = C6 + T_UKV,
                C8 = C7 + T_SQ, C9 = C8 + T_SQ, C10 = C9 + T_SQ;
  if (t1 > C10) t1 = C10;
  for (int t = t0; t < t1; t += tstep) {
    if (t < C1) convert_tile(p.w_ff1_up + (size_t)l * D * 2 * DFF, 2 * DFF, D, 1, wb + WB_UP1, t, smem);
    else if (t < C2) convert_tile(p.w_ff1_dn + (size_t)l * DFF * D, D, DFF, 0, wb + WB_DN1, t - C1, smem);
    else if (t < C3) convert_tile(p.w_ff2_up + (size_t)l * D * 2 * DFF, 2 * DFF, D, 1, wb + WB_UP2, t - C2, smem);
    else if (t < C4) convert_tile(p.w_ff2_dn + (size_t)l * DFF * D, D, DFF, 0, wb + WB_DN2, t - C3, smem);
    else if (t < C5) convert_tile(p.w_in + (size_t)l * D * INW, INW, D, 2, wb + WB_IN, t - C4, smem);
    else if (t < C6) convert_tile(p.w_uq + (size_t)l * 384 * 1536, 1536, 384, 0, wb + WB_UQ, t - C5, smem);
    else if (t < C7) convert_tile(p.w_ukv + (size_t)l * 256 * 2048, 2048, 256, 0, wb + WB_UKV, t - C6, smem);
    else if (t < C8) convert_tile(p.w_bm + (size_t)l * D * D, D, D, 0, wb + WB_BM, t - C7, smem);
    else if (t < C9) convert_tile(p.w_ba + (size_t)l * D * D, D, D, 0, wb + WB_BA, t - C8, smem);
    else convert_tile(p.w_out + (size_t)l * D * D, D, D, 0, wb + WB_OUT, t - C9, smem);
  }
}
constexpr int CONV_TILES = 13984;
constexpr int CONV_PER_TASK = 16;
constexpr int NCONV = (CONV_TILES + CONV_PER_TASK - 1) / CONV_PER_TASK;
DI void phase_convert(const Params& p, int l, char* smem, int bid, int nb) { convert_range(p, l, smem, bid, CONV_TILES, nb); }

DI void phase_init(const Params& p, char* smem, int bid, int nb) {
  const int tid = tidx(), lane = tid & 63, wid = tid >> 6;
  {
    float2* tab = (float2*)(p.ws + OFF_ROPE);
    for (int idx = bid * 256 + tid; idx < SEQ * 32; idx += nb * 256) {
      const int t = idx >> 5, i = idx & 31, f = i & 15;
      const float pos = (float)(i < 16 ? (t >> 6) : (t & 63));
      const float inv = powf(10000.f, -(float)(2 * f) / 32.f);
      const float ang = pos * inv;
      tab[idx] = make_float2(cosf(ang), sinf(ang));
    }
  }
  float* sc = (float*)smem;
  float* red = sc + 5 * D;
  for (int i = tid; i < 5 * D; i += 256) {
    const int row = i >> 10, k = i & 1023;
    const float v = row < 4 ? p.c[row * D + k] : p.c_ctx[k];
    sc[i] = siluf(v);
  }
  __syncthreads();
  float* mods = (float*)(p.ws + OFF_MODS);
  constexpr int NG = NMOD * D / 64;
  for (int t = bid; t < NL * NG; t += nb) {
    const int l = t / NG, n = (t - l * NG) * 64 + lane;
    const float* w = p.w_ada + (size_t)l * D * NMOD * D + n;
    float a0 = 0, a1 = 0, a2 = 0, a3 = 0, a4 = 0;
    const int kb = wid * 256;
#pragma unroll 8
    for (int k = 0; k < 256; ++k) {
      const float wv = w[(size_t)(kb + k) * (NMOD * D)];
      a0 += sc[kb + k] * wv; a1 += sc[D + kb + k] * wv; a2 += sc[2 * D + kb + k] * wv; a3 += sc[3 * D + kb + k] * wv; a4 += sc[4 * D + kb + k] * wv;
    }
    red[(wid * 5 + 0) * 64 + lane] = a0; red[(wid * 5 + 1) * 64 + lane] = a1; red[(wid * 5 + 2) * 64 + lane] = a2;
    red[(wid * 5 + 3) * 64 + lane] = a3; red[(wid * 5 + 4) * 64 + lane] = a4;
    __syncthreads();
    for (int i = tid; i < 320; i += 256) {
      const int row = i >> 6, ln = i & 63;
      const int nn = (t - l * NG) * 64 + ln;
      float s = red[(0 * 5 + row) * 64 + ln] + red[(1 * 5 + row) * 64 + ln] + red[(2 * 5 + row) * 64 + ln] + red[(3 * 5 + row) * 64 + ln];
      mods[((size_t)l * 5 + row) * (NMOD * D) + nn] = s + p.b_ada[(size_t)l * NMOD * D + nn];
    }
    __syncthreads();
  }
}

DI void phase_norm(const Params& p, int nrows, const float* __restrict__ g, const float* __restrict__ mods_l, int shift_idx, int scale_idx, u16* __restrict__ an, bool from_input, int bid, int nb) {
  const int tid_ = tidx(), lane = tid_ & 63, wid = tid_ >> 6;
  for (int r = bid * 4 + wid; r < nrows; r += nb * 4) {
    const float* x = from_input ? xin_ptr(p, r) : xptr(p, r);
    float4 v[4]; float ss = 0.f;
#pragma unroll
    for (int i = 0; i < 4; ++i) { v[i] = *(const float4*)(x + i * 256 + lane * 4); ss += v[i].x * v[i].x + v[i].y * v[i].y + v[i].z * v[i].z + v[i].w * v[i].w; }
    ss = wave_sum(ss);
    const float rstd = rsqrtf(ss * (1.f / D) + EPS);
    const float* md = mods_l + (size_t)modrow(r) * (NMOD * D);
#pragma unroll
    for (int i = 0; i < 4; ++i) {
      const int col = i * 256 + lane * 4;
      const float4 g4 = *(const float4*)(g + col);
      const float4 sh = *(const float4*)(md + shift_idx * D + col);
      const float4 sc = *(const float4*)(md + scale_idx * D + col);
      const float y0 = v[i].x * rstd * g4.x * (1.f + sc.x) + sh.x;
      const float y1 = v[i].y * rstd * g4.y * (1.f + sc.y) + sh.y;
      const float y2 = v[i].z * rstd * g4.z * (1.f + sc.z) + sh.z;
      const float y3 = v[i].w * rstd * g4.w * (1.f + sc.w) + sh.w;
      uint2 o; o.x = pk2(y0, y1); o.y = pk2(y2, y3);
      *(uint2*)(an + bko(r, col, D / 64)) = o;
    }
  }
}

DI void phase_final(const Params& p, int bid, int nb) {
  const int tid_ = tidx(), lane = tid_ & 63, wid = tid_ >> 6;
  for (int r = bid * 4 + wid; r < RL; r += nb * 4) {
    float* x = p.out + (size_t)r * D;
    float4 v[4]; float ss = 0.f;
#pragma unroll
    for (int i = 0; i < 4; ++i) { v[i] = *(const float4*)(x + i * 256 + lane * 4); ss += v[i].x * v[i].x + v[i].y * v[i].y + v[i].z * v[i].z + v[i].w * v[i].w; }
    ss = wave_sum(ss);
    const float rstd = rsqrtf(ss * (1.f / D) + EPS);
#pragma unroll
    for (int i = 0; i < 4; ++i) {
      const int col = i * 256 + lane * 4;
      const float4 g4 = *(const float4*)(p.g_final + col);
      float4 o; o.x = v[i].x * rstd * g4.x; o.y = v[i].y * rstd * g4.y; o.z = v[i].z * rstd * g4.z; o.w = v[i].w * rstd * g4.w;
      *(float4*)(x + col) = o;
    }
  }
}

constexpr int GSTR = 128;
constexpr int GBUF = 128 * GSTR;

#define G_PARAMS uint4 &ra00, uint4 &ra01, uint4 &ra02, uint4 &ra03, uint4 &rb00, uint4 &rb01, uint4 &rb02, uint4 &rb03, \
                 uint4 &ra10, uint4 &ra11, uint4 &ra12, uint4 &ra13, uint4 &rb10, uint4 &rb11, uint4 &rb12, uint4 &rb13
#define G_DECL uint4 g_a00, g_a01, g_a02, g_a03, g_b00, g_b01, g_b02, g_b03, g_a10, g_a11, g_a12, g_a13, g_b10, g_b11, g_b12, g_b13
#define G_ARGS g_a00, g_a01, g_a02, g_a03, g_b00, g_b01, g_b02, g_b03, g_a10, g_a11, g_a12, g_a13, g_b10, g_b11, g_b12, g_b13
#define G_L1(S, i, kt) ra##S##i = *(const uint4*)(ap + (size_t)(kt) * 8192 + i * 2048); rb##S##i = *(const uint4*)(bp + (size_t)(kt) * 8192 + i * 2048);
#define G_LOAD(S, kt) { G_L1(S, 0, kt) G_L1(S, 1, kt) G_L1(S, 2, kt) G_L1(S, 3, kt) }
#define G_S1(S, i, buf) *(uint4*)(sA + (buf) * GBUF + soff + i * 32 * GSTR) = ra##S##i; *(uint4*)(sB + (buf) * GBUF + soff + i * 32 * GSTR) = rb##S##i;
#define G_STORE(S, buf) { G_S1(S, 0, buf) G_S1(S, 1, buf) G_S1(S, 2, buf) G_S1(S, 3, buf) }
DI void gemm_prefetch(G_PARAMS, const u16* __restrict__ A, int lda, const u16* __restrict__ Bt, int ldb, int m0, int n0) {
  const int tid = tidx();
  const int lr = tid >> 3, lc = tid & 7;
  const u16* ap = A + (size_t)((m0 >> 7) * (lda >> 6)) * 8192 + lr * 64 + lc * 8;
  const u16* bp = Bt + (size_t)((n0 >> 7) * (ldb >> 6)) * 8192 + lr * 64 + lc * 8;
  G_LOAD(0, 0)
  G_LOAD(1, 1)
}
DI void gemm_mainloop(G_PARAMS, const u16* __restrict__ A, int lda, const u16* __restrict__ Bt, int ldb, int nk, int m0, int n0, f32x4 (&acc)[4][4], char* smem) {
  const int tid = tidx(), lane = tid & 63, wid = tid >> 6, wr = wid >> 1, wc = wid & 1;
  const int lr = tid >> 3, lc = tid & 7;
  const u16* ap = A + (size_t)((m0 >> 7) * (lda >> 6)) * 8192 + lr * 64 + lc * 8;
  const u16* bp = Bt + (size_t)((n0 >> 7) * (ldb >> 6)) * 8192 + lr * 64 + lc * 8;
#define G_COMPUTE(buf) { const char* cA = sA + (buf) * GBUF; const char* cB = sB + (buf) * GBUF; \
    _Pragma("unroll") for (int ks = 0; ks < 2; ++ks) { \
      bf16x8 a[4], b[4]; \
      _Pragma("unroll") for (int m = 0; m < 4; ++m) a[m] = *(const bf16x8*)(cA + (aoff ^ (ks * 64)) + m * 16 * GSTR); \
      _Pragma("unroll") for (int n = 0; n < 4; ++n) b[n] = *(const bf16x8*)(cB + (boff ^ (ks * 64)) + n * 16 * GSTR); \
      _Pragma("unroll") for (int m = 0; m < 4; ++m) _Pragma("unroll") for (int n = 0; n < 4; ++n) acc[m][n] = MFMA16(b[n], a[m], acc[m][n]); \
    } }
  char* sA = smem; char* sB = smem + 2 * GBUF;
  const int soff = lr * GSTR + ((lc ^ ((lr >> 1) & 7)) << 4);
  const int fr = lane & 15, fq = lane >> 4;
  const int swz = (fq ^ ((fr >> 1) & 7)) << 4;
  const int aoff = (wr * 64 + fr) * GSTR + swz;
  const int boff = (wc * 64 + fr) * GSTR + swz;
  uint4 ra20, ra21, ra22, ra23, rb20, rb21, rb22, rb23;
  if (2 < nk) G_LOAD(2, 2)
  G_STORE(0, 0)
  __syncthreads();
  if (3 < nk) G_LOAD(0, 3)
#define G_STEP(i, SN, BN) if (kt + (i) < nk) { \
    G_COMPUTE((i) & 1) \
    if (kt + (i) + 1 < nk) G_STORE(SN, BN) \
    __syncthreads(); \
    if (kt + (i) + 4 < nk) G_LOAD(SN, kt + (i) + 4) }
  for (int kt = 0; kt < nk; kt += 6) {
    G_STEP(0, 1, 1)
    G_STEP(1, 2, 0)
    G_STEP(2, 0, 1)
    G_STEP(3, 1, 0)
    G_STEP(4, 2, 1)
    G_STEP(5, 0, 0)
  }
#undef G_STEP
#undef G_COMPUTE
}
#undef G_L1
#undef G_S1
#undef G_LOAD
#undef G_STORE

DI int vbid(int bid, int nb) { return bid; }
DI void tile_of(int tile, int ntn, int& mt, int& nt) {
  const int gm = tile / (4 * ntn), rem = tile - gm * 4 * ntn;
  nt = rem >> 2; mt = gm * 4 + (rem & 3);
}
#define ZERO_ACC(acc) _Pragma("unroll") for (int m_ = 0; m_ < 4; ++m_) _Pragma("unroll") for (int n_ = 0; n_ < 4; ++n_) acc[m_][n_] = f32x4{0.f, 0.f, 0.f, 0.f}

constexpr int ST16 = 272;
constexpr int ST32 = 528;
DI void stage_bf16(const f32x4 (&acc)[4][4], char* st, int wr, int wc, int fr, int fq) {
#pragma unroll
  for (int m = 0; m < 4; ++m)
#pragma unroll
    for (int n = 0; n < 4; ++n) {
      uint2 v; v.x = pk2(acc[m][n][0], acc[m][n][1]); v.y = pk2(acc[m][n][2], acc[m][n][3]);
      *(uint2*)(st + (wr * 64 + 16 * m + fr) * ST16 + (wc * 64 + 16 * n + 4 * fq) * 2) = v;
    }
}
DI void stage_f32(const f32x4 (&acc)[4][4], char* st, int wr, int wc, int fr, int fq) {
#pragma unroll
  for (int m = 0; m < 4; ++m)
#pragma unroll
    for (int n = 0; n < 4; ++n) *(f32x4*)(st + (wr * 64 + 16 * m + fr) * ST32 + (wc * 64 + 16 * n + 4 * fq) * 4) = acc[m][n];
}

DI void phase_ffn_up(const Params& p, int mtn, const u16* an, const u16* wt, u16* h, char* smem, int bid, int nb) {
  constexpr int NTN = 2 * DFF / 128;
  G_DECL;
  { int tile = vbid(bid, nb); if (tile < mtn * NTN) { int mt, nt; tile_of(tile, NTN, mt, nt); gemm_prefetch(G_ARGS, an, D, wt, D, mt * 128, nt * 128); } }
  for (int tile = vbid(bid, nb); tile < mtn * NTN; tile += nb) {
    int mt, nt; tile_of(tile, NTN, mt, nt);
    f32x4 acc[4][4]; ZERO_ACC(acc);
    gemm_mainloop(G_ARGS, an, D, wt, D, D / 64, mt * 128, nt * 128, acc, smem);
    if (tile + nb < mtn * NTN) { int mt2, nt2; tile_of(tile + nb, NTN, mt2, nt2); gemm_prefetch(G_ARGS, an, D, wt, D, mt2 * 128, nt2 * 128); }
    const int tid = tidx(), lane = tid & 63, wid = tid >> 6, wr = wid >> 1, wc = wid & 1, fr = lane & 15, fq = lane >> 4;
#pragma unroll
    for (int m = 0; m < 4; ++m)
#pragma unroll
      for (int n = 0; n < 2; ++n) {
        float o[4];
#pragma unroll
        for (int r = 0; r < 4; ++r) o[r] = siluf(acc[m][n][r]) * acc[m][n + 2][r];
        uint2 v; v.x = pk2(o[0], o[1]); v.y = pk2(o[2], o[3]);
        *(uint2*)(smem + (wr * 64 + 16 * m + fr) * ST16 + (wc * 32 + 16 * n + 4 * fq) * 2) = v;
      }
    __syncthreads();
    const unsigned rbase = mt * 128, cbase = nt * 64;
#pragma unroll
    for (int i = 0; i < 4; ++i) {
      const unsigned id = tid + 256 * i, row = id >> 3, ch = id & 7;
      const uint4 v = *(const uint4*)(smem + row * ST16 + ch * 16);
      *(uint4*)(h + bko(rbase + row, cbase + ch * 8, DFF / 64)) = v;
    }
    __syncthreads();
  }
}

DI void phase_gemm_resid(const Params& p, int mtn, const u16* a, int K, const u16* wt, const float* mods_l, int gate_idx, float coef, bool from_input, char* smem, int bid, int nb) {
  constexpr int NTN = D / 128;
  G_DECL;
  { int tile = vbid(bid, nb); if (tile < mtn * NTN) { int mt, nt; tile_of(tile, NTN, mt, nt); gemm_prefetch(G_ARGS, a, K, wt, K, mt * 128, nt * 128); } }
  for (int tile = vbid(bid, nb); tile < mtn * NTN; tile += nb) {
    int mt, nt; tile_of(tile, NTN, mt, nt);
    f32x4 acc[4][4]; ZERO_ACC(acc);
    gemm_mainloop(G_ARGS, a, K, wt, K, K / 64, mt * 128, nt * 128, acc, smem);
    if (tile + nb < mtn * NTN) { int mt2, nt2; tile_of(tile + nb, NTN, mt2, nt2); gemm_prefetch(G_ARGS, a, K, wt, K, mt2 * 128, nt2 * 128); }
    const int tid = tidx(), lane = tid & 63, wid = tid >> 6, wr = wid >> 1, wc = wid & 1, fr = lane & 15, fq = lane >> 4;
    stage_f32(acc, smem, wr, wc, fr, fq);
    __syncthreads();
    const int r0 = mt * 128;
    const float* md = mods_l + (size_t)modrow(r0) * (NMOD * D) + gate_idx * D + nt * 128;
    float* xb = xptr(p, r0) + nt * 128;
    const float* xr = from_input ? xin_ptr(p, r0) + nt * 128 : xb;
    const unsigned ch = tid & 31;
    const float4 g4 = *(const float4*)(md + ch * 4);
#pragma unroll 4
    for (int i = 0; i < 16; ++i) {
      const unsigned row = (tid >> 5) + 8 * i;
      const float4 v = *(const float4*)(smem + row * ST32 + ch * 16);
      float4* xp = (float4*)(xb + row * (unsigned)D + ch * 4);
      float4 x = *(const float4*)(xr + row * (unsigned)D + ch * 4);
      x.x += coef * g4.x * v.x; x.y += coef * g4.y * v.y; x.z += coef * g4.z * v.z; x.w += coef * g4.w * v.w;
      *xp = x;
    }
    __syncthreads();
  }
}

DI void phase_inproj(const Params& p, int l, const u16* an, const u16* wt, char* smem, int bid, int nb) {
  constexpr int NTN = ZW / 128;
  char* ws = p.ws;
  G_DECL;
  { int tile = vbid(bid, nb); if (tile < MT * NTN) { int mt, nt; tile_of(tile, NTN, mt, nt); gemm_prefetch(G_ARGS, an, D, wt, D, mt * 128, nt * 128); } }
  for (int tile = vbid(bid, nb); tile < MT * NTN; tile += nb) {
    int mt, nt; tile_of(tile, NTN, mt, nt);
    f32x4 acc[4][4]; ZERO_ACC(acc);
    gemm_mainloop(G_ARGS, an, D, wt, D, D / 64, mt * 128, nt * 128, acc, smem);
    if (tile + nb < MT * NTN) { int mt2, nt2; tile_of(tile + nb, NTN, mt2, nt2); gemm_prefetch(G_ARGS, an, D, wt, D, mt2 * 128, nt2 * 128); }
    const int tid = tidx(), lane = tid & 63, wid = tid >> 6, wr = wid >> 1, wc = wid & 1, fr = lane & 15, fq = lane >> 4;
    if (nt == 37) {
      if (wc == 0) {
        u16* zkr = (u16*)(ws + OFF_ZKR);
#pragma unroll
        for (int m = 0; m < 4; ++m)
#pragma unroll
          for (int n = 0; n < 4; ++n) {
            const unsigned row = mt * 128 + wr * 64 + 16 * m + fr;
            uint2 v; v.x = pk2(acc[m][n][0], acc[m][n][1]); v.y = pk2(acc[m][n][2], acc[m][n][3]);
            *(uint2*)(zkr + row * 64u + 16 * n + 4 * fq) = v;
          }
      } else {
        float* zg = (float*)(ws + OFF_ZG);
        const float4 b4 = *(const float4*)(p.b_gate + l * 16 + 4 * fq);
#pragma unroll
        for (int m = 0; m < 4; ++m) {
          const unsigned row = mt * 128 + wr * 64 + 16 * m + fr;
          float4 v; v.x = acc[m][0][0] + b4.x; v.y = acc[m][0][1] + b4.y; v.z = acc[m][0][2] + b4.z; v.w = acc[m][0][3] + b4.w;
          *(float4*)(zg + row * 16u + 4 * fq) = v;
        }
      }
      continue;
    }
    if (nt >= 32 && nt < 37) {
      const bool isq = nt < 35;
      const float* gv = isq ? p.g_qa + l * 384 + (nt - 32) * 128 : p.g_kva + l * 256 + (nt - 35) * 128;
      float* ss2 = (float*)(ws + OFF_SS2);
      const int slot = isq ? (nt - 32) * 2 + wc : 8 + (nt - 35) * 2 + wc;
#pragma unroll
      for (int m = 0; m < 4; ++m) {
        float ssum = 0.f;
#pragma unroll
        for (int n = 0; n < 4; ++n) ssum += (acc[m][n][0] * acc[m][n][0] + acc[m][n][1] * acc[m][n][1]) + (acc[m][n][2] * acc[m][n][2] + acc[m][n][3] * acc[m][n][3]);
        ssum += __shfl_xor(ssum, 16); ssum += __shfl_xor(ssum, 32);
        if (fq == 0) ss2[(unsigned)(mt * 128 + wr * 64 + 16 * m + fr) * 16u + slot] = ssum;
      }
#pragma unroll
      for (int n = 0; n < 4; ++n) {
        const float4 g4 = *(const float4*)(gv + wc * 64 + 16 * n + 4 * fq);
#pragma unroll
        for (int m = 0; m < 4; ++m) { acc[m][n][0] *= g4.x; acc[m][n][1] *= g4.y; acc[m][n][2] *= g4.z; acc[m][n][3] *= g4.w; }
      }
    }
    stage_bf16(acc, smem, wr, wc, fr, fq);
    __syncthreads();
    const int c = nt * 128;
    u16* dst; unsigned ld, c0; unsigned nkb = 0;
    if (c < 4096) { dst = (u16*)(ws + OFF_ZQ) + (size_t)(c >> 10) * R * D; ld = D; c0 = c & 1023; }
    else if (c < 4480) { dst = (u16*)(ws + OFF_CQN); ld = 384; c0 = c - 4096; nkb = 6; }
    else if (c < 4736) { dst = (u16*)(ws + OFF_CKVN); ld = 256; c0 = c - 4480; nkb = 4; }
    else { dst = (u16*)(ws + OFF_ZBR); ld = 2048; c0 = c - 4864; }
    const unsigned rbase = mt * 128;
#pragma unroll
    for (int i = 0; i < 8; ++i) {
      const unsigned id = tid + 256 * i, row = id >> 4, ch = id & 15;
      const uint4 v = *(const uint4*)(smem + row * ST16 + ch * 16);
      *(uint4*)(dst + (nkb ? bko(rbase + row, c0 + ch * 8, nkb) : (rbase + row) * ld + c0 + ch * 8)) = v;
    }
    __syncthreads();
  }
}

DI void phase_prep(const Params& p, int l, int bid, int nb) {
  const int tid_ = tidx(), lane = tid_ & 63, wid = tid_ >> 6;
  char* ws = p.ws;
  const u16* zq = (const u16*)(ws + OFF_ZQ); const u16* zk = (const u16*)(ws + OFF_ZK);
  u16* qc = (u16*)(ws + OFF_AN); u16* kc = (u16*)(ws + OFF_KC);
  const float* wcv = p.w_conv + (size_t)l * 3 * 2048;
  const float2* tab = (const float2*)(ws + OFF_ROPE);
  for (int r = bid * 4 + wid; r < R; r += nb * 4) {
    int t, T;
    if (r < RL) { t = r & 4095; T = SEQ; } else { t = (r - RL) & 255; T = CTX; }
    const bool hp = t > 0, hn = t < T - 1;
#pragma unroll
    for (int c4 = 0; c4 < 4; ++c4) {
      const int ch = c4 * 512 + lane * 8;
      const bool isq = ch < 1024;
      const u16* src = isq ? zq : zk;
      const int cc = isq ? ch : ch - 1024;
      const uint4 zero = make_uint4(0, 0, 0, 0);
      const uint4 vc = *(const uint4*)(src + (size_t)r * D + cc);
      const uint4 vp = hp ? *(const uint4*)(src + (size_t)(r - 1) * D + cc) : zero;
      const uint4 vn = hn ? *(const uint4*)(src + (size_t)(r + 1) * D + cc) : zero;
      const unsigned pc[4] = {vc.x, vc.y, vc.z, vc.w}, pp[4] = {vp.x, vp.y, vp.z, vp.w}, pn[4] = {vn.x, vn.y, vn.z, vn.w};
      float o[8];
#pragma unroll
      for (int e = 0; e < 8; ++e) {
        const int sh = (e & 1) * 16;
        const float xc = bf2f((u16)(pc[e >> 1] >> sh)), xp = bf2f((u16)(pp[e >> 1] >> sh)), xn = bf2f((u16)(pn[e >> 1] >> sh));
        const float w0 = wcv[ch + e], w1 = wcv[2048 + ch + e], w2 = wcv[4096 + ch + e];
        float y = siluf(xp * w0 + xc * w1 + xn * w2);
        o[e] = isq ? y * 0.0625f : y;
      }
      uint4 ov; ov.x = pk2(o[0], o[1]); ov.y = pk2(o[2], o[3]); ov.z = pk2(o[4], o[5]); ov.w = pk2(o[6], o[7]);
      *(uint4*)((isq ? qc : kc) + (size_t)r * D + cc) = ov;
    }
    {
      const float v = bf2f(((const u16*)(ws + OFF_ZKR))[(size_t)r * 64 + lane]);
      const float pv = __shfl_xor(v, 1);
      float o = v;
      if (r < RL) {
        const float2 cs = tab[t * 32 + (lane >> 1)];
        o = (lane & 1) ? (pv * cs.y + v * cs.x) : (v * cs.x - pv * cs.y);
      }
      ((u16*)(ws + OFF_KROPE))[(size_t)r * 64 + lane] = f2bf(o);
    }
  }
  {
    const float* zg = (const float*)(ws + OFF_ZG);
    for (int item = bid * 4 + wid; item < 32 * NCH; item += nb * 4) {
      const int stream = item / NCH, n = item - stream * NCH;
      const int b = stream >> 3, hd = (stream >> 1) & 3, dir = stream & 1;
      int base, T, cc;
      if (n < 4) { base = RL + b * CTX; T = CTX; cc = n; } else { base = b * SEQ; T = SEQ; cc = n - 4; }
      const int pos = cc * 64 + lane;
      const int row = base + (dir ? T - 1 - pos : pos);
      const float ig = zg[(size_t)row * 16 + dir * 8 + hd];
      const float fg = zg[(size_t)row * 16 + dir * 8 + 4 + hd];
      const float lf = fminf(fg, 0.f) - log1pf(__expf(-fabsf(fg)));
      float bc = lf;
#pragma unroll
      for (int d = 1; d < 64; d <<= 1) { const float tt = __shfl_up(bc, d); if (lane >= d) bc += tt; }
      const float bL = __shfl(bc, 63);
      const float wv = ig - bc;
      float pm = wv;
#pragma unroll
      for (int d = 1; d < 64; d <<= 1) { const float tt = __shfl_up(pm, d); if (lane >= d) pm = fmaxf(pm, tt); }
      const float endl = bL + wv;
      const float me = wave_max(endl);
      float* g = (float*)(ws + OFF_G) + ((size_t)stream * NCH + n) * 512;
      g[lane] = bc; g[64 + lane] = wv; g[128 + lane] = pm; g[192 + lane] = endl;
      if (lane == 0) { g[256] = bL; g[257] = me; }
    }
  }
}

DI void phase_upproj(const Params& p, const u16* wb, char* smem, int bid, int nb) {
  char* ws = p.ws;
  const float2* tab = (const float2*)(ws + OFF_ROPE);
  u16* qa = (u16*)(ws + OFF_H);
  u16* kv = (u16*)(ws + OFF_KV);
  constexpr int NQ = 12, NKV = 16;
  const int total = MT * (NQ + NKV);
  G_DECL;
#define UP_PREFETCH(T) { const int t_ = (T); if (t_ < MT * NQ) { int m_, n_; tile_of(t_, NQ, m_, n_); gemm_prefetch(G_ARGS, (const u16*)(ws + OFF_CQN), 384, wb + WB_UQ, 384, m_ * 128, n_ * 128); } \
    else if (t_ < total) { int m_, n_; tile_of(t_ - MT * NQ, NKV, m_, n_); gemm_prefetch(G_ARGS, (const u16*)(ws + OFF_CKVN), 256, wb + WB_UKV, 256, m_ * 128, n_ * 128); } }
  for (int tile = vbid(bid, nb); tile < total; tile += nb) {
    const bool isq = tile < MT * NQ;
    int mt, nt;
    f32x4 acc[4][4]; ZERO_ACC(acc);
    UP_PREFETCH(tile)
    if (isq) { tile_of(tile, NQ, mt, nt); gemm_mainloop(G_ARGS, (const u16*)(ws + OFF_CQN), 384, wb + WB_UQ, 384, 6, mt * 128, nt * 128, acc, smem); }
    else { tile_of(tile - MT * NQ, NKV, mt, nt); gemm_mainloop(G_ARGS, (const u16*)(ws + OFF_CKVN), 256, wb + WB_UKV, 256, 4, mt * 128, nt * 128, acc, smem); }
    const int tid = tidx(), lane = tid & 63, wid = tid >> 6, wr = wid >> 1, wc = wid & 1, fr = lane & 15, fq = lane >> 4;
    {
      const float* ss2 = (const float*)(ws + OFF_SS2);
#pragma unroll
      for (int m = 0; m < 4; ++m) {
        const float* sp = ss2 + (unsigned)(mt * 128 + wr * 64 + 16 * m + fr) * 16u;
        float rstd;
        if (isq) { const float4 a = *(const float4*)sp; const float2 b = *(const float2*)(sp + 4); rstd = rsqrtf((((a.x + a.y) + (a.z + a.w)) + (b.x + b.y)) * (1.f / 384.f) + EPS); }
        else { const float4 a = *(const float4*)(sp + 8); rstd = rsqrtf(((a.x + a.y) + (a.z + a.w)) * (1.f / 256.f) + EPS); }
#pragma unroll
        for (int n = 0; n < 4; ++n) { acc[m][n][0] *= rstd; acc[m][n][1] *= rstd; acc[m][n][2] *= rstd; acc[m][n][3] *= rstd; }
      }
    }
    stage_bf16(acc, smem, wr, wc, fr, fq);
    __syncthreads();
    const unsigned rbase = mt * 128;
    if (isq) {
#pragma unroll
      for (int i = 0; i < 8; ++i) {
        const unsigned id = tid + 256 * i, row = id >> 4, ch = id & 15;
        uint4 v = *(const uint4*)(smem + row * ST16 + ch * 16);
        const unsigned col = nt * 128 + ch * 8, d0 = col % 192u, grow = rbase + row;
        if (d0 >= 128u && grow < (unsigned)RL) {
          const float4* tp = (const float4*)(tab + (grow & 4095u) * 32u + ((d0 - 128u) >> 1));
          const float4 t0 = tp[0], t1 = tp[1];
          float x0, x1;
          x0 = bf2f((u16)(v.x & 0xffff)); x1 = bf2f((u16)(v.x >> 16)); v.x = pk2(x0 * t0.x - x1 * t0.y, x0 * t0.y + x1 * t0.x);
          x0 = bf2f((u16)(v.y & 0xffff)); x1 = bf2f((u16)(v.y >> 16)); v.y = pk2(x0 * t0.z - x1 * t0.w, x0 * t0.w + x1 * t0.z);
          x0 = bf2f((u16)(v.z & 0xffff)); x1 = bf2f((u16)(v.z >> 16)); v.z = pk2(x0 * t1.x - x1 * t1.y, x0 * t1.y + x1 * t1.x);
          x0 = bf2f((u16)(v.w & 0xffff)); x1 = bf2f((u16)(v.w >> 16)); v.w = pk2(x0 * t1.z - x1 * t1.w, x0 * t1.w + x1 * t1.z);
        }
        *(uint4*)(qa + grow * 1536u + col) = v;
      }
    } else {
#pragma unroll
      for (int i = 0; i < 8; ++i) {
        const unsigned id = tid + 256 * i, row = id >> 4, ch = id & 15;
        const uint4 v = *(const uint4*)(smem + row * ST16 + ch * 16);
        *(uint4*)(kv + (rbase + row) * 2048u + nt * 128 + ch * 8) = v;
      }
    }
    __syncthreads();
  }
#undef UP_PREFETCH
}

constexpr int AKS = 400;
constexpr int AVS = 320;
DI void attn_task(const Params& p, int b, int h, int qrow0, int nkt, bool with_latent, char* smem) {
  const int tid = tidx(), lane = tid & 63, wid = tid >> 6, l31 = lane & 31, h2 = lane >> 5;
  char* ws = p.ws;
  const u16* qa = (const u16*)(ws + OFF_H);
  const u16* kvb = (const u16*)(ws + OFF_KV);
  const u16* krp = (const u16*)(ws + OFF_KROPE);
  u16* ao = (u16*)(ws + OFF_H) + (size_t)R * 1536;
  char* Ks = smem; char* Vs = smem + 64 * AKS;
  bf16x8 qf[12];
  {
    const u16* qp = qa + (size_t)(qrow0 + wid * 32 + l31) * 1536 + h * 192 + h2 * 8;
#pragma unroll
    for (int st = 0; st < 12; ++st) qf[st] = *(const bf16x8*)(qp + st * 16);
  }
  uint4 kreg0, kreg1, kreg2, kreg3, kreg4, kreg5, vreg0, vreg1, vreg2, vreg3;
#define KEY_ROW(kt, i) ((kt) < 4 ? (RL + b * CTX + (kt) * 64 + (i)) : (b * SEQ + ((kt) - 4) * 64 + (i)))
#define ATT_KL(kt, i) { const int id = tid + 256 * i, row = id / 24, ch = id - row * 24; const int kr = KEY_ROW(kt, row); \
    const u16* src = ch < 16 ? (kvb + (size_t)kr * 2048 + h * 256 + ch * 8) : (krp + (size_t)kr * 64 + (ch - 16) * 8); kreg##i = *(const uint4*)src; }
#define ATT_VL(kt, i) { const int id = tid + 256 * i, row = id >> 4, ch = id & 15; const int kr = KEY_ROW(kt, row); \
    vreg##i = *(const uint4*)(kvb + (size_t)kr * 2048 + h * 256 + 128 + ch * 8); }
#define ATT_GLOADK(kt) ATT_KL(kt, 0) ATT_KL(kt, 1) ATT_KL(kt, 2) ATT_KL(kt, 3) ATT_KL(kt, 4) ATT_KL(kt, 5)
#define ATT_GLOADV(kt) ATT_VL(kt, 0) ATT_VL(kt, 1) ATT_VL(kt, 2) ATT_VL(kt, 3)
#define ATT_GLOAD(kt) ATT_GLOADK(kt) ATT_GLOADV(kt)
#define ATT_KS(i) { const int id = tid + 256 * i, row = id / 24, ch = id - row * 24; *(uint4*)(Ks + row * AKS + ch * 16) = kreg##i; }
#define ATT_VS(i) { const int id = tid + 256 * i, row = id >> 4, ch = id & 15; *(uint4*)(Vs + row * AVS + ch * 16) = vreg##i; }
#define ATT_SSTORE() ATT_KS(0) ATT_KS(1) ATT_KS(2) ATT_KS(3) ATT_KS(4) ATT_KS(5) ATT_VS(0) ATT_VS(1) ATT_VS(2) ATT_VS(3)
  f32x16 o[4];
#pragma unroll
  for (int n = 0; n < 4; ++n)
#pragma unroll
    for (int i = 0; i < 16; ++i) o[n][i] = 0.f;
  float mrun = -1e30f, lrun = 0.f;
  const float sc = 0.07216878364870322f * 1.4426950408889634f;
  const int i16 = lane & 15, tq = i16 >> 2, tp = i16 & 3, blk = (lane >> 4) & 1;
  ATT_GLOAD(0)
  __syncthreads();
  ATT_SSTORE()
  __syncthreads();
  for (int kt = 0; kt < nkt; ++kt) {
    if (kt + 1 < nkt) { ATT_GLOADK(kt + 1) }
    f32x16 s0, s1;
#pragma unroll
    for (int i = 0; i < 16; ++i) { s0[i] = 0.f; s1[i] = 0.f; }
#pragma unroll
    for (int st = 0; st < 12; ++st) {
      const bf16x8 a0 = *(const bf16x8*)(Ks + l31 * AKS + st * 32 + h2 * 16);
      const bf16x8 a1 = *(const bf16x8*)(Ks + (32 + l31) * AKS + st * 32 + h2 * 16);
      s0 = MFMA32(a0, qf[st], s0);
      s1 = MFMA32(a1, qf[st], s1);
    }
    __builtin_amdgcn_sched_group_barrier(0x100, 4, 0);
#pragma unroll
    for (int i = 0; i < 10; ++i) { __builtin_amdgcn_sched_group_barrier(0x008, 2, 0); __builtin_amdgcn_sched_group_barrier(0x100, 2, 0); }
    __builtin_amdgcn_sched_group_barrier(0x008, 4, 0);
    __builtin_amdgcn_sched_barrier(0);
    float mx = s0[0];
#pragma unroll
    for (int i = 0; i < 16; ++i) { mx = fmaxf(mx, s0[i]); mx = fmaxf(mx, s1[i]); }
    mx = fmaxf(mx, __shfl_xor(mx, 32));
    const float mnew = fmaxf(mrun, mx * sc);
    const float alpha = __builtin_amdgcn_exp2f(mrun - mnew);
    mrun = mnew;
    float ls = 0.f;
#pragma unroll
    for (int i = 0; i < 16; ++i) { s0[i] = __builtin_amdgcn_exp2f(s0[i] * sc - mnew); s1[i] = __builtin_amdgcn_exp2f(s1[i] * sc - mnew); ls += s0[i] + s1[i]; }
    lrun = lrun * alpha + ls;
    if (__any(alpha != 1.f)) {
#pragma unroll
      for (int n = 0; n < 4; ++n)
#pragma unroll
        for (int i = 0; i < 16; ++i) o[n][i] *= alpha;
    }
    bf16x8 pbv[4];
#define ATT_PACK(SV, HH) \
    _Pragma("unroll") for (int s = 0; s < 2; ++s) { \
      u32x4 pu; \
      pu[0] = pk2(SV[8 * s + 0], SV[8 * s + 1]); pu[1] = pk2(SV[8 * s + 2], SV[8 * s + 3]); \
      pu[2] = pk2(SV[8 * s + 4], SV[8 * s + 5]); pu[3] = pk2(SV[8 * s + 6], SV[8 * s + 7]); \
      pbv[2 * HH + s] = __builtin_bit_cast(bf16x8, pu); \
    }
    ATT_PACK(s0, 0)
    ATT_PACK(s1, 1)
#undef ATT_PACK
    if (kt + 1 < nkt) { ATT_GLOADV(kt + 1) }
#pragma unroll
    for (int hs = 0; hs < 4; ++hs) {
      const char* vlo = Vs + (16 * hs + 4 * h2 + tq) * AVS + (16 * blk) * 2 + 8 * tp;
#pragma unroll
      for (int n = 0; n < 4; ++n) {
        const bf16x8 va = tr8(vlo + n * 64, vlo + n * 64 + 8 * AVS);
        o[n] = MFMA32(va, pbv[hs], o[n]);
      }
    }
    __syncthreads();
    if (kt + 1 < nkt) { ATT_SSTORE() }
    __syncthreads();
  }
  const float ltot = lrun + __shfl_xor(lrun, 32);
  const float inv = 1.f / ltot;
  const unsigned orow = qrow0 + wid * 32 + l31;
#pragma unroll
  for (int n = 0; n < 4; ++n)
#pragma unroll
    for (int g = 0; g < 4; ++g) {
      uint2 w; w.x = pk2(o[n][4 * g] * inv, o[n][4 * g + 1] * inv); w.y = pk2(o[n][4 * g + 2] * inv, o[n][4 * g + 3] * inv);
      *(uint2*)(ao + bko(orow, h * 128 + 32 * n + 8 * g + 4 * h2, D / 64)) = w;
    }
}

constexpr int MKS = 528;
constexpr int MVS = 112;
constexpr int M_CT = 64 * MKS;
constexpr int M_VS = M_CT + 48 * MKS;
constexpr int M_VW = M_VS + 64 * MVS;
constexpr int M_GS = 73728;
constexpr int M_MS = M_GS + 1536;
DI void mlstm_task(const Params& p, int task, char* smem) {
  const int tid = tidx(), lane = tid & 63, w = tid >> 6, fr = lane & 15, fq = lane >> 4, tq = fr >> 2, tp = fr & 3;
  const int stream = task >> 3, c = task & 7, b = stream >> 3, hd = (stream >> 1) & 3, dir = stream & 1;
  char* ws = p.ws;
  const u16* qc = (const u16*)(ws + OFF_AN); const u16* kc = (const u16*)(ws + OFF_KC); const u16* zv = (const u16*)(ws + OFF_ZV);
  const float* G = (const float*)(ws + OFF_G) + (size_t)stream * NCH * 512;
  _Float16* hout = (_Float16*)(ws + (dir ? OFF_ZK : OFF_ZQ));
  char* Ks = smem; char* Ct = smem + M_CT; char* Vs = smem + M_VS; char* Vw = smem + M_VW;
#define ROW_OF(n, pos) ((n) < 4 ? (RL + b * CTX + (dir ? CTX - 1 - ((n) * 64 + (pos)) : ((n) * 64 + (pos)))) : (b * SEQ + (dir ? SEQ - 1 - (((n) - 4) * 64 + (pos)) : (((n) - 4) * 64 + (pos)))))
  __syncthreads();
  for (int i = tid; i < 48 * MKS / 16; i += 256) ((uint4*)Ct)[i] = make_uint4(0, 0, 0, 0);
  f32x4 cacc[4][3];
#pragma unroll
  for (int kt = 0; kt < 4; ++kt)
#pragma unroll
    for (int vt = 0; vt < 3; ++vt) cacc[kt][vt] = f32x4{0.f, 0.f, 0.f, 0.f};
  uint4 kreg0, kreg1, kreg2, kreg3, kreg4, kreg5, kreg6, kreg7; uint4 vreg; float wreg; float4 greg = make_float4(0.f, 0.f, 0.f, 0.f);
#define M_KL(n, i) { const int id = tid + 256 * i, row = id >> 5, ch = id & 31; kreg##i = *(const uint4*)(kc + (size_t)ROW_OF(n, row) * D + hd * 256 + ch * 8); }
#define M_GLOAD(n) { M_KL(n, 0) M_KL(n, 1) M_KL(n, 2) M_KL(n, 3) M_KL(n, 4) M_KL(n, 5) M_KL(n, 6) M_KL(n, 7) \
    const int row_ = tid >> 2, part_ = tid & 3; \
    vreg = *(const uint4*)(zv + (size_t)ROW_OF(n, row_) * D + hd * 256 + c * 32 + part_ * 8); \
    wreg = G[(size_t)(n) * 512 + 192 + row_]; \
    if (tid < 64) { greg.x = G[(size_t)(n) * 512 + tid]; greg.y = G[(size_t)(n) * 512 + 64 + tid]; greg.z = G[(size_t)(n) * 512 + 128 + tid]; greg.w = G[(size_t)(n) * 512 + 192 + tid]; } }
#define M_KS(i) { const int id = tid + 256 * i, row = id >> 5, ch = id & 31; *(uint4*)(Ks + row * MKS + ch * 16) = kreg##i; }
#define M_SSTORE(n) { M_KS(0) M_KS(1) M_KS(2) M_KS(3) M_KS(4) M_KS(5) M_KS(6) M_KS(7) \
    const int row = tid >> 2, part = tid & 3; \
    const float mp_ = ((const float*)(smem + M_MS))[136 + (n)], mn_ = ((const float*)(smem + M_MS))[204 + (n)]; \
    if (tid < 64) { float* gs_ = (float*)(smem + M_GS); const float mj_ = fmaxf(greg.x + mp_, greg.x + greg.z); \
      gs_[tid] = greg.x - mj_; gs_[64 + tid] = greg.y; gs_[128 + tid] = __expf(greg.x + mp_ - mj_); gs_[192 + tid] = __expf(-mj_); gs_[256 + tid] = __expf(greg.w - mn_); \
      if (tid == 0) gs_[320] = __expf(((const float*)(smem + M_MS))[(n)] + mp_ - mn_); } \
    wreg = __expf(wreg - mn_); \
    *(uint4*)(Vs + row * MVS + part * 16) = vreg; \
    uint4 wv; \
    wv.x = pk2(bf2f((u16)(vreg.x & 0xffff)) * wreg, bf2f((u16)(vreg.x >> 16)) * wreg); \
    wv.y = pk2(bf2f((u16)(vreg.y & 0xffff)) * wreg, bf2f((u16)(vreg.y >> 16)) * wreg); \
    wv.z = pk2(bf2f((u16)(vreg.z & 0xffff)) * wreg, bf2f((u16)(vreg.z >> 16)) * wreg); \
    wv.w = pk2(bf2f((u16)(vreg.w & 0xffff)) * wreg, bf2f((u16)(vreg.w >> 16)) * wreg); \
    *(uint4*)(Vw + row * MVS + part * 16) = wv; \
    if (part == 0) { \
      *(uint4*)(Vs + row * MVS + 64) = make_uint4(0x3f80u, 0, 0, 0); \
      *(uint4*)(Vs + row * MVS + 80) = make_uint4(0, 0, 0, 0); \
      *(uint4*)(Vw + row * MVS + 64) = make_uint4((unsigned)f2bf(wreg), 0, 0, 0); \
      *(uint4*)(Vw + row * MVS + 80) = make_uint4(0, 0, 0, 0); \
    } }
#define M_QLOAD(n) { \
    const u16* qp = qc + (size_t)ROW_OF(n, 16 * w + fr) * D + hd * 256 + fq * 8; \
    _Pragma("unroll") for (int ks = 0; ks < 8; ++ks) qf[ks] = *(const bf16x8*)(qp + ks * 32); }
  bf16x8 qf[8];
  M_GLOAD(0) M_QLOAD(0)
  {
    float* ms = (float*)(smem + M_MS);
    if (tid < NCH) { ms[tid] = G[(size_t)tid * 512 + 256]; ms[68 + tid] = G[(size_t)tid * 512 + 257]; }
    __syncthreads();
    if (tid == 0) { float m = 0.f; for (int i = 0; i < NCH; ++i) { const float mn = fmaxf(ms[i] + m, ms[68 + i]); ms[136 + i] = m; ms[204 + i] = mn; m = mn; } }
    __syncthreads();
  }
  M_SSTORE(0)
  __syncthreads();
  for (int n = 0; n < NCH; ++n) {
    const bool more = n + 1 < NCH;
    if (more) M_GLOAD(n + 1)
    const float* g = (const float*)(smem + M_GS);
    const int jpos = 16 * w + fr;
    const float u_j = g[jpos], e_j = g[128 + jpos], rd_j = g[192 + jpos];
    const float a_state = g[320];
    f32x4 xs[4];
#pragma unroll
    for (int st = 0; st < 4; ++st) {
      xs[st] = f32x4{0.f, 0.f, 0.f, 0.f};
      if (st <= w) {
#pragma unroll
        for (int ks = 0; ks < 8; ++ks) {
          const bf16x8 a = *(const bf16x8*)(Ks + (16 * st + fr) * MKS + ks * 64 + fq * 16);
          xs[st] = MFMA16(a, qf[ks], xs[st]);
        }
        const float4 wv4 = *(const float4*)(g + 64 + 16 * st + 4 * fq);
        const int sb = 16 * st + 4 * fq;
        xs[st][0] *= (sb + 0 <= jpos) ? __expf(u_j + wv4.x) : 0.f;
        xs[st][1] *= (sb + 1 <= jpos) ? __expf(u_j + wv4.y) : 0.f;
        xs[st][2] *= (sb + 2 <= jpos) ? __expf(u_j + wv4.z) : 0.f;
        xs[st][3] *= (sb + 3 <= jpos) ? __expf(u_j + wv4.w) : 0.f;
      }
    }
    bf16x8 pb[2];
#pragma unroll
    for (int u = 0; u < 2; ++u) {
      u32x4 pu;
      pu[0] = pk2(xs[2 * u][0], xs[2 * u][1]); pu[1] = pk2(xs[2 * u][2], xs[2 * u][3]);
      pu[2] = pk2(xs[2 * u + 1][0], xs[2 * u + 1][1]); pu[3] = pk2(xs[2 * u + 1][2], xs[2 * u + 1][3]);
      pb[u] = __builtin_bit_cast(bf16x8, pu);
    }
    f32x4 num[3];
#pragma unroll
    for (int vt = 0; vt < 3; ++vt) {
      f32x4 n1 = {0.f, 0.f, 0.f, 0.f}, n2 = {0.f, 0.f, 0.f, 0.f};
#pragma unroll
      for (int u = 0; u < 2; ++u) {
        const char* lo = Vs + (32 * u + 4 * fq + tq) * MVS + (16 * vt) * 2 + 8 * tp;
        const bf16x8 a = tr8(lo, lo + 16 * MVS);
        n1 = MFMA16(a, pb[u], n1);
      }
#pragma unroll
      for (int ks = 0; ks < 8; ++ks) {
        const bf16x8 a = *(const bf16x8*)(Ct + (16 * vt + fr) * MKS + ks * 64 + fq * 16);
        n2 = MFMA16(a, qf[ks], n2);
      }
#pragma unroll
      for (int r = 0; r < 4; ++r) num[vt][r] = n1[r] + e_j * n2[r];
    }
    const float den = __shfl(num[2][0], fr);
    const float inv = 1.f / fmaxf(fabsf(den), rd_j);
    {
      _Float16* hp = hout + (size_t)ROW_OF(n, jpos) * D + hd * 256 + c * 32 + 4 * fq;
#pragma unroll
      for (int vt = 0; vt < 2; ++vt) {
        h16x4 hv;
#pragma unroll
        for (int r = 0; r < 4; ++r) hv[r] = (_Float16)(num[vt][r] * inv);
        *(h16x4*)(hp + 16 * vt) = hv;
      }
    }
    if (more) M_QLOAD(n + 1)
    __syncthreads();
#pragma unroll
    for (int kt = 0; kt < 4; ++kt)
#pragma unroll
      for (int vt = 0; vt < 3; ++vt) cacc[kt][vt] *= a_state;
#pragma unroll
    for (int u = 0; u < 2; ++u) {
      bf16x8 bfr[3];
#pragma unroll
      for (int vt = 0; vt < 3; ++vt) {
        const char* lo = Vw + (32 * u + 8 * fq + tq) * MVS + (16 * vt) * 2 + 8 * tp;
        bfr[vt] = tr8(lo, lo + 4 * MVS);
      }
#pragma unroll
      for (int kt = 0; kt < 4; ++kt) {
        const char* lo = Ks + (32 * u + 8 * fq + tq) * MKS + (64 * w + 16 * kt) * 2 + 8 * tp;
        const bf16x8 af = tr8(lo, lo + 4 * MKS);
#pragma unroll
        for (int vt = 0; vt < 3; ++vt) cacc[kt][vt] = MFMA16(af, bfr[vt], cacc[kt][vt]);
      }
    }
#pragma unroll
    for (int kt = 0; kt < 4; ++kt)
#pragma unroll
      for (int vt = 0; vt < 3; ++vt) {
        uint2 o2; o2.x = pk2(cacc[kt][vt][0], cacc[kt][vt][1]); o2.y = pk2(cacc[kt][vt][2], cacc[kt][vt][3]);
        *(uint2*)(Ct + (16 * vt + fr) * MKS + (64 * w + 16 * kt + 4 * fq) * 2) = o2;
      }
    __syncthreads();
    if (more) M_SSTORE(n + 1)
    __syncthreads();
  }
}

DI int q_pull(int* head, volatile LAS unsigned* s_task_p) {
  __syncthreads();
  if (threadIdx.x == 0) *s_task_p = (unsigned)atomicAdd(head, 1);
  __syncthreads();
  return (int)*s_task_p;
}
DI void phase_mix(const Params& p, int l, char* smem, volatile LAS unsigned* s_task_p, int bid, int nb) {
  int* C = (int*)(p.ws + OFF_CTR) + l * 16;
  const bool last = (l & 3) == NL - 1;
  const int per_g = last ? 32 : 34;
  const int n_cv = last ? 0 : NCONV;
  const int xcd = (int)(xb_xcc_id() & 7u);
  for (;;) { const int t = q_pull(C, s_task_p); if (t >= 256) break; mlstm_task(p, t, smem); }
  for (int j = 0; j < 8; ++j) {
    const int x = (xcd + j) & 7;
    for (;;) {
      const int e = q_pull(C + 1 + x, s_task_p);
      if (e >= 4 * per_g) break;
      const int gi = e / per_g, r = e - gi * per_g, g = x + 8 * gi, b = g >> 3, h = g & 7;
      if (r < 32) attn_task(p, b, h, b * SEQ + r * 128, 68, true, smem);
      else attn_task(p, b, h, RL + b * CTX + (r - 32) * 128, 4, false, smem);
    }
  }
  for (;;) { const int t = q_pull(C + 9, s_task_p); if (t >= n_cv) break; const int c0 = t * CONV_PER_TASK; convert_range(p, (l & 3) + 1, smem, c0, c0 + CONV_PER_TASK, 1); }
}

DI void phase_mout(const Params& p, int l, int bid, int nb) {
  const int tid_ = tidx(), lane = tid_ & 63, wid = tid_ >> 6;
  char* ws = p.ws;
  const _Float16* hf = (const _Float16*)(ws + OFF_ZQ); const _Float16* hb = (const _Float16*)(ws + OFF_ZK);
  const u16* zo = (const u16*)(ws + OFF_ZO);
  u16* hm = (u16*)(ws + OFF_KC);
  for (int r = bid * 4 + wid; r < R; r += nb * 4) {
#pragma unroll
    for (int hd = 0; hd < 4; ++hd) {
      const size_t off = (size_t)r * D + hd * 256 + lane * 4;
      const h16x4 a = *(const h16x4*)(hf + off), bb = *(const h16x4*)(hb + off);
      float v[4]; float ss = 0.f;
#pragma unroll
      for (int e = 0; e < 4; ++e) { v[e] = (float)a[e] + (float)bb[e]; ss += v[e] * v[e]; }
      ss = wave_sum(ss);
      const float rstd = rsqrtf(ss * (1.f / 256.f) + EPS);
      const uint2 z = *(const uint2*)(zo + off);
      const float4 g4 = *(const float4*)(p.g_mh + (size_t)l * D + hd * 256 + lane * 4);
      const float o0 = sigmf(bf2f((u16)(z.x & 0xffff))) * v[0] * rstd * g4.x;
      const float o1 = sigmf(bf2f((u16)(z.x >> 16))) * v[1] * rstd * g4.y;
      const float o2 = sigmf(bf2f((u16)(z.y & 0xffff))) * v[2] * rstd * g4.z;
      const float o3 = sigmf(bf2f((u16)(z.y >> 16))) * v[3] * rstd * g4.w;
      uint2 o; o.x = pk2(o0, o1); o.y = pk2(o2, o3);
      *(uint2*)(hm + bko(r, hd * 256 + lane * 4, D / 64)) = o;
    }
  }
}

DI void phase_merge(const Params& p, const u16* wb, int mtn, char* smem, int bid, int nb) {
  constexpr int NTN = D / 128;
  char* ws = p.ws;
  const u16* hm = (const u16*)(ws + OFF_KC);
  const u16* ao = (const u16*)(ws + OFF_H) + (size_t)R * 1536;
  const u16* zbr = (const u16*)(ws + OFF_ZBR);
  u16* tt = (u16*)(ws + OFF_AN);
  G_DECL;
  for (int tile = vbid(bid, nb); tile < mtn * NTN; tile += nb) {
    int mt, nt; tile_of(tile, NTN, mt, nt);
    f32x4 acc[4][4]; ZERO_ACC(acc);
    gemm_prefetch(G_ARGS, hm, D, wb + WB_BM, D, mt * 128, nt * 128);
    gemm_mainloop(G_ARGS, hm, D, wb + WB_BM, D, D / 64, mt * 128, nt * 128, acc, smem);
    const unsigned rbase = mt * 128;
    {
      const int tid = tidx(), lane = tid & 63, wid = tid >> 6, wr = wid >> 1, wc = wid & 1, fr = lane & 15, fq = lane >> 4;
      stage_bf16(acc, smem, wr, wc, fr, fq);
      __syncthreads();
#pragma unroll
      for (int i = 0; i < 8; ++i) {
        const unsigned id = tid + 256 * i, row = id >> 4, ch = id & 15;
        const uint4 a = *(const uint4*)(smem + row * ST16 + ch * 16);
        const unsigned grow = rbase + row, col = nt * 128 + ch * 8;
        const uint4 gm = *(const uint4*)(zbr + grow * 2048u + col);
        uint4 o;
#define MRG1(F) o.F = pk2(sigmf(bf2f((u16)(gm.F & 0xffff))) * bf2f((u16)(a.F & 0xffff)), sigmf(bf2f((u16)(gm.F >> 16))) * bf2f((u16)(a.F >> 16)));
        MRG1(x) MRG1(y) MRG1(z) MRG1(w)
#undef MRG1
        *(uint4*)(tt + bko(grow, col, D / 64)) = o;
      }
      __syncthreads();
    }
    ZERO_ACC(acc);
    gemm_prefetch(G_ARGS, ao, D, wb + WB_BA, D, mt * 128, nt * 128);
    gemm_mainloop(G_ARGS, ao, D, wb + WB_BA, D, D / 64, mt * 128, nt * 128, acc, smem);
    const int tid = tidx(), lane = tid & 63, wid = tid >> 6, wr = wid >> 1, wc = wid & 1, fr = lane & 15, fq = lane >> 4;
    stage_bf16(acc, smem, wr, wc, fr, fq);
    __syncthreads();
#pragma unroll
    for (int i = 0; i < 8; ++i) {
      const unsigned id = tid + 256 * i, row = id >> 4, ch = id & 15;
      const uint4 b = *(const uint4*)(smem + row * ST16 + ch * 16);
      const unsigned grow = rbase + row, col = nt * 128 + ch * 8;
      const uint4 a = *(const uint4*)(tt + bko(grow, col, D / 64));
      const uint4 ga = *(const uint4*)(zbr + grow * 2048u + 1024u + col);
      uint4 o;
#define MRG(F) { \
      const float o0 = bf2f((u16)(a.F & 0xffff)) + sigmf(bf2f((u16)(ga.F & 0xffff))) * bf2f((u16)(b.F & 0xffff)); \
      const float o1 = bf2f((u16)(a.F >> 16)) + sigmf(bf2f((u16)(ga.F >> 16))) * bf2f((u16)(b.F >> 16)); \
      o.F = pk2(o0, o1); }
      MRG(x) MRG(y) MRG(z) MRG(w)
#undef MRG
      *(uint4*)(tt + bko(grow, col, D / 64)) = o;
    }
    __syncthreads();
  }
}

__global__ void __launch_bounds__(256, 2) fwd_kernel(Params p) {
  extern __shared__ __attribute__((aligned(16))) char smem[];
  __shared__ __attribute__((aligned(16))) unsigned xbw[4];
  const int bid = blockIdx.x, nb = gridDim.x;
  char* ws = p.ws;
  u16* an = (u16*)(ws + OFF_AN);
  u16* hbuf = (u16*)(ws + OFF_H);
  if (threadIdx.x < 4) xbw[threadIdx.x] = 0u;
  __syncthreads();
  XcdBarrier xb = xcd_barrier_post((unsigned*)(ws + OFF_BAR), (volatile LAS unsigned*)xbw);
  for (int ph = p.ph_lo; ph < p.ph_hi; ++ph) {
    if (ph == NPH - 1) {
      phase_final(p, bid, nb);
    } else {
      const int l = ph / NPH_LAYER, k = ph - l * NPH_LAYER;
      if (k == 0 && l > 0) continue;
      if (k == 7) continue;
      const u16* wb = (const u16*)(ws + OFF_WB) + (size_t)(l & 1) * WB_END;
      const float* mods_l = (const float*)(ws + OFF_MODS) + (size_t)l * 5 * NMOD * D;
      const int mtl = (l == NL - 1) ? RL / 128 : MT;
      const int nrep = ((DUP_MASK >> k) & 1) ? 2 : 1;
      for (int rep = 0; rep < nrep; ++rep) {
      if (rep) xcd_barrier(xb);
      switch (k) {
        case 0:
          if (l == 0) phase_init(p, smem, bid, nb);
          phase_convert(p, l, smem, bid, nb);
          break;
        case 1: phase_norm(p, R, p.g_n1 + l * D, mods_l, 0, 1, an, l == 0, bid, nb); break;
        case 2: phase_ffn_up(p, MT, an, wb + WB_UP1, hbuf, smem, bid, nb); break;
        case 3: phase_gemm_resid(p, MT, hbuf, DFF, wb + WB_DN1, mods_l, 2, 0.5f, l == 0, smem, bid, nb); break;
        case 4: phase_norm(p, R, p.g_n2 + l * D, mods_l, 3, 4, an, false, bid, nb); break;
        case 5: phase_inproj(p, l, an, wb + WB_IN, smem, bid, nb); break;
        case 6: phase_prep(p, l, bid, nb); phase_upproj(p, wb, smem, bid, nb); break;
        case 7: phase_upproj(p, wb, smem, bid, nb); break;
        case 8: phase_mix(p, l + 4 * rep, smem, (volatile LAS unsigned*)&xbw[2], bid, nb); break;
        case 9: phase_mout(p, l, bid, nb); break;
        case 10: phase_merge(p, wb, mtl, smem, bid, nb); break;
        case 11: phase_gemm_resid(p, mtl, an, D, wb + WB_OUT, mods_l, 5, 1.0f, false, smem, bid, nb); break;
        case 12: phase_norm(p, mtl * 128, p.g_n3 + l * D, mods_l, 6, 7, an, false, bid, nb); break;
        case 13: phase_ffn_up(p, mtl, an, wb + WB_UP2, hbuf, smem, bid, nb); break;
        case 14: phase_gemm_resid(p, mtl, hbuf, DFF, wb + WB_DN2, mods_l, 8, 0.5f, false, smem, bid, nb); break;
      }
      }
    }
    if (ph + 1 < p.ph_hi) { if (ph == 0) cg::this_grid().sync(); else xcd_barrier(xb); }
  }
}

extern "C" void kernel_launch(void* const* d_in, const int* in_sizes, int n_in, void* d_out, int out_size, void* d_ws, size_t ws_size, hipStream_t stream) {
  static int grid = 0;
  if (grid == 0) {
    if (n_in != 25 || ws_size < WS_END) { fprintf(stderr, "kernel_launch: unexpected n_in %d or ws_size %zu (< %zu)\n", n_in, ws_size, (size_t)WS_END); grid = -1; return; }
    int dev = 0, cus = 0, per_cu = 0;
    hipGetDevice(&dev);
    hipDeviceGetAttribute(&cus, hipDeviceAttributeMultiprocessorCount, dev);
    hipFuncSetAttribute((const void*)fwd_kernel, hipFuncAttributeMaxDynamicSharedMemorySize, SMEM_BYTES);
    hipOccupancyMaxActiveBlocksPerMultiprocessor(&per_cu, (const void*)fwd_kernel, 256, SMEM_BYTES);
    if (per_cu < 1) per_cu = 1;
    if (per_cu > 2) per_cu = 2;
    grid = cus * per_cu;
    fprintf(stderr, "kernel_launch: grid %d (%d CUs x %d), ws need %zu have %zu\n", grid, cus, per_cu, (size_t)WS_END, ws_size);
  }
  if (grid < 0) return;
  Params p{};
  const float** f = (const float**)&p;
  for (int i = 0; i < 25; ++i) f[i] = (const float*)d_in[i];
  p.out = (float*)d_out; p.ws = (char*)d_ws;
  hipMemsetAsync((char*)d_ws + OFF_CTR, 0, (OFF_WB - OFF_CTR), stream);
#if ONE_LAUNCH
  p.ph_lo = 0; p.ph_hi = NPH;
  void* args[] = {&p};
  hipError_t e = hipLaunchCooperativeKernel((const void*)fwd_kernel, dim3(grid), dim3(256), args, SMEM_BYTES, stream);
  if (e != hipSuccess) fprintf(stderr, "cooperative launch failed: %s (grid %d)\n", hipGetErrorString(e), grid);
#else
  for (int ph = 0; ph < NPH; ++ph) {
    p.ph_lo = ph; p.ph_hi = ph + 1;
    hipLaunchKernelGGL(fwd_kernel, dim3(grid), dim3(256), SMEM_BYTES, stream, p);
  }
#endif
}
```

```cpp
#include <hip/hip_runtime.h>
#include <hip/hip_cooperative_groups.h>
#include <cstdio>
namespace cg = cooperative_groups;

#ifndef DUP_MASK
#define DUP_MASK 0
#endif
#ifndef ONE_LAUNCH
#define ONE_LAUNCH 1
#endif

typedef unsigned short u16;
typedef __attribute__((ext_vector_type(8))) short bf16x8;
typedef __attribute__((ext_vector_type(4))) short s16x4;
typedef __attribute__((ext_vector_type(4))) float f32x4;
typedef __attribute__((ext_vector_type(16))) float f32x16;
typedef __attribute__((ext_vector_type(4))) _Float16 h16x4;
typedef __attribute__((ext_vector_type(4))) unsigned u32x4;
#define DI __device__ __forceinline__
#define MFMA16(a, b, c) __builtin_amdgcn_mfma_f32_16x16x32_bf16((a), (b), (c), 0, 0, 0)
#define MFMA32(a, b, c) __builtin_amdgcn_mfma_f32_32x32x16_bf16((a), (b), (c), 0, 0, 0)

constexpr int D = 1024, NB = 4, SEQ = 4096, NL = 4, CTX = 256;
constexpr int RL = NB * SEQ;
constexpr int RC = NB * CTX;
constexpr int R = RL + RC;
constexpr int DFF = 2816, INW = 6864, ZW = 6912, NMOD = 9;
constexpr float EPS = 1e-6f;
constexpr int NCH = 68;
constexpr int MT = R / 128;

constexpr size_t al(size_t x) { return (x + 255) & ~(size_t)255; }
constexpr size_t OFF_XC = 0;
constexpr size_t OFF_MODS = al(OFF_XC + (size_t)RC * D * 4);
constexpr size_t OFF_ROPE = al(OFF_MODS + (size_t)NL * 5 * NMOD * D * 4);
constexpr size_t OFF_G = al(OFF_ROPE + (size_t)SEQ * 32 * 8);
constexpr size_t OFF_CTR = al(OFF_G + (size_t)32 * NCH * 512 * 4);
constexpr size_t OFF_BAR = al(OFF_CTR + 8 * 16 * 4);
constexpr size_t OFF_WB = al(OFF_BAR + 3456 * 4);
constexpr size_t WB_UP1 = 0;
constexpr size_t WB_DN1 = WB_UP1 + (size_t)2 * DFF * D;
constexpr size_t WB_UP2 = WB_DN1 + (size_t)D * DFF;
constexpr size_t WB_DN2 = WB_UP2 + (size_t)2 * DFF * D;
constexpr size_t WB_IN = WB_DN2 + (size_t)D * DFF;
constexpr size_t WB_UQ = WB_IN + (size_t)ZW * D;
constexpr size_t WB_UKV = WB_UQ + (size_t)1536 * 384;
constexpr size_t WB_BM = WB_UKV + (size_t)2048 * 256;
constexpr size_t WB_BA = WB_BM + (size_t)D * D;
constexpr size_t WB_OUT = WB_BA + (size_t)D * D;
constexpr size_t WB_END = WB_OUT + (size_t)D * D;
constexpr size_t OFF_AN = al(OFF_WB + 2 * WB_END * 2);
constexpr size_t OFF_H = al(OFF_AN + (size_t)R * D * 2);
constexpr size_t OFF_ZQ = al(OFF_H + (size_t)R * DFF * 2);
constexpr size_t OFF_ZK = al(OFF_ZQ + (size_t)R * D * 2);
constexpr size_t OFF_ZV = al(OFF_ZK + (size_t)R * D * 2);
constexpr size_t OFF_ZO = al(OFF_ZV + (size_t)R * D * 2);
constexpr size_t OFF_ZCQ = al(OFF_ZO + (size_t)R * D * 2);
constexpr size_t OFF_ZCKV = al(OFF_ZCQ + (size_t)R * 384 * 2);
constexpr size_t OFF_ZKR = al(OFF_ZCKV + (size_t)R * 256 * 2);
constexpr size_t OFF_ZG = al(OFF_ZKR + (size_t)R * 64 * 2);
constexpr size_t OFF_ZBR = al(OFF_ZG + (size_t)R * 16 * 4);
constexpr size_t OFF_KC = al(OFF_ZBR + (size_t)R * 2048 * 2);
constexpr size_t OFF_KV = al(OFF_KC + (size_t)R * D * 2);
constexpr size_t OFF_CQN = al(OFF_KV + (size_t)R * 2048 * 2);
constexpr size_t OFF_CKVN = al(OFF_CQN + (size_t)R * 384 * 2);
constexpr size_t OFF_KROPE = al(OFF_CKVN + (size_t)R * 256 * 2);
constexpr size_t OFF_SS2 = al(OFF_KROPE + (size_t)R * 64 * 2);
constexpr size_t WS_END = al(OFF_SS2 + (size_t)R * 16 * 4);

constexpr int SMEM_BYTES = 76800;
constexpr int NPH_LAYER = 15;
constexpr int NPH = NL * NPH_LAYER + 1;

struct Params {
  const float *x, *c, *ctx, *c_ctx, *w_ada, *b_ada, *g_n1, *g_n2, *g_n3, *w_ff1_up, *w_ff1_dn, *w_ff2_up, *w_ff2_dn,
      *w_in, *b_gate, *w_conv, *g_mh, *g_qa, *g_kva, *w_uq, *w_ukv, *w_bm, *w_ba, *w_out, *g_final;
  float* out;
  char* ws;
  int ph_lo, ph_hi;
};

DI float bf2f(u16 u) { return __uint_as_float(((unsigned)u) << 16); }
DI u16 f2bf(float x) { return __builtin_bit_cast(u16, (__bf16)x); }
DI unsigned pk2(float a, float b) { return (unsigned)f2bf(a) | ((unsigned)f2bf(b) << 16); }
DI float siluf(float x) { return x / (1.f + __expf(-x)); }
DI float sigmf(float x) { return 1.f / (1.f + __expf(-x)); }
DI float wave_sum(float v) {
#pragma unroll
  for (int o = 32; o > 0; o >>= 1) v += __shfl_xor(v, o);
  return v;
}
DI float wave_max(float v) {
#pragma unroll
  for (int o = 32; o > 0; o >>= 1) v = fmaxf(v, __shfl_xor(v, o));
  return v;
}
DI int tidx() { int t = threadIdx.x; asm volatile("" : "+v"(t)); return t; }
DI unsigned bko(unsigned r, unsigned k, unsigned nkt) { return ((r >> 7) * nkt + (k >> 6)) * 8192u + ((r & 127u) << 6) + (k & 63u); }
DI float* xptr(const Params& p, int r) { return r < RL ? p.out + (size_t)r * D : (float*)(p.ws + OFF_XC) + (size_t)(r - RL) * D; }
DI const float* xin_ptr(const Params& p, int r) { return r < RL ? p.x + (size_t)r * D : p.ctx + (size_t)(r - RL) * D; }
DI int modrow(int r) { return r < RL ? (r >> 12) : 4; }
DI bf16x8 tr8(const char* lo, const char* hi) {
  s16x4 a = __builtin_amdgcn_ds_read_tr16_b64_v4i16((s16x4 __attribute__((address_space(3)))*)(lo));
  s16x4 b = __builtin_amdgcn_ds_read_tr16_b64_v4i16((s16x4 __attribute__((address_space(3)))*)(hi));
  return __builtin_shufflevector(a, b, 0, 1, 2, 3, 4, 5, 6, 7);
}


#define XB_TMO      128
#define XB_XCNT(j)  (256  + 64 * (j))
#define XB_XSUB(j)  (1280 + 64 * (j))
#define XB_XGEN(j)  (2304 + 64 * (j))
#define XB_TOP      3328
#define XB_TOPGEN   3392
#define XCD_BAR_WORDS 3456
#define XB_SPIN_CAP (1u << 22)
#define LAS __attribute__((address_space(3)))
DI unsigned xb_ld(unsigned* p) { return __hip_atomic_load(p, __ATOMIC_RELAXED, __HIP_MEMORY_SCOPE_AGENT); }
DI unsigned xb_add(unsigned* p, unsigned v) { return __hip_atomic_fetch_add(p, v, __ATOMIC_RELAXED, __HIP_MEMORY_SCOPE_AGENT); }
DI unsigned xb_xcc_id() { return (unsigned)__builtin_amdgcn_s_getreg((3 << 11) | 20) & 0xFu; }
#define XB_SPIN(cond, bar) do { unsigned _sp = 0; while (cond) { __builtin_amdgcn_s_sleep(1); \
    if ((++_sp & 255u) == 0u) { if (xb_ld(&(bar)[XB_TMO])) break; if (_sp > XB_SPIN_CAP) { atomicAdd(&(bar)[XB_TMO], 1u); break; } } } } while (0)
struct XcdBarrier { unsigned* bar; unsigned x; volatile LAS unsigned* st; };
DI XcdBarrier xcd_barrier_post(unsigned* bar, volatile LAS unsigned* st) {
  XcdBarrier b; b.bar = bar; b.x = xb_xcc_id(); b.st = st;
  if (threadIdx.x == 0) (void)xb_add(&bar[XB_XCNT(b.x)], 1u);
  return b;
}
DI void xcd_barrier_complete(unsigned* bar, unsigned x, unsigned& nloc, unsigned& nx) {
  const unsigned G = gridDim.x * gridDim.y * gridDim.z;
  unsigned sum, cnt, mine, sp = 0u;
  for (;;) {
    sum = 0u; cnt = 0u; mine = 0u;
#pragma unroll
    for (unsigned j = 0; j < 16; ++j) { const unsigned c = xb_ld(&bar[XB_XCNT(j)]); sum += c; cnt += (c > 0u) ? 1u : 0u; mine = (j == x) ? c : mine; }
    if (sum == G) break;
    __builtin_amdgcn_s_sleep(1);
    if ((++sp & 255u) == 0u) { if (xb_ld(&bar[XB_TMO])) break; if (sp > XB_SPIN_CAP) { atomicAdd(&bar[XB_TMO], 1u); break; } }
  }
  nloc = mine > 0u ? mine : 1u; nx = cnt > 0u ? cnt : 1u;
}
DI void xcd_barrier(const XcdBarrier& b) {
  asm volatile("s_waitcnt vmcnt(0)" ::: "memory");
  __syncthreads();
  if (threadIdx.x == 0) {
    unsigned* bar = b.bar;
    __builtin_amdgcn_s_waitcnt(0);
    unsigned nloc = b.st[0], nx = b.st[1];
    if (nloc == 0u) { xcd_barrier_complete(bar, b.x, nloc, nx); b.st[0] = nloc; b.st[1] = nx; }
    const unsigned old = xb_add(&bar[XB_XSUB(b.x)], 1u);
    const unsigned gen = old / nloc;
    if (old + 1u == (gen + 1u) * nloc) {
      __builtin_amdgcn_fence(__ATOMIC_RELEASE, "agent");
      asm volatile("s_waitcnt vmcnt(0)" ::: "memory");
      const unsigned og = xb_add(&bar[XB_TOP], 1u);
      const unsigned tg = og / nx;
      if (og + 1u == (tg + 1u) * nx) xb_add(&bar[XB_TOPGEN], 1u);
      else XB_SPIN(xb_ld(&bar[XB_TOPGEN]) == tg, bar);
      __builtin_amdgcn_fence(__ATOMIC_ACQUIRE, "agent");
      xb_add(&bar[XB_XGEN(b.x)], 1u);
      asm volatile("s_waitcnt vmcnt(0)" ::: "memory");
    } else {
      XB_SPIN(xb_ld(&bar[XB_XGEN(b.x)]) == gen, bar);
      __builtin_amdgcn_fence(__ATOMIC_ACQUIRE, "agent");
      asm volatile("s_waitcnt vmcnt(0)" ::: "memory");
    }
  }
  __syncthreads();
}

DI int src_col(int perm, int r) {
  if (perm == 0) return r;
  if (perm == 1) { int grp = r >> 6, j = r & 63; return j < 32 ? grp * 32 + j : DFF + grp * 32 + (j - 32); }
  if (r < 4096) return r;
  if (r < 4800) return r + 16;
  if (r < 4816) return r - 704;
  if (r < 4864) return -1;
  return r - 48;
}

DI void convert_tile(const float* __restrict__ W, int Nsrc, int K, int perm, u16* __restrict__ Wt, int tile, char* smem) {
  const int nkt = K >> 6;
  const int rt = tile / nkt, kt = tile - rt * nkt;
  const int r0 = rt * 32, k0 = kt * 64;
  u16* t = (u16*)smem;
  const int tid = tidx();
  {
    const int j = tid & 31, i = tid >> 5;
    const int sc = src_col(perm, r0 + j);
#pragma unroll
    for (int s = 0; s < 8; ++s) {
      const int k = i + 8 * s;
      float v = sc >= 0 ? W[(size_t)(k0 + k) * Nsrc + sc] : 0.f;
      t[j * 72 + k] = f2bf(v);
    }
  }
  __syncthreads();
  {
    const int row = tid >> 3, c8 = tid & 7;
    uint4 v = *(const uint4*)(t + row * 72 + c8 * 8);
    *(uint4*)(Wt + bko(r0 + row, k0 + c8 * 8, K >> 6)) = v;
  }
  __syncthreads();
}

DI void convert_range(const Params& p, int l, char* smem, int t0, int t1, int tstep) {
  u16* wb = (u16*)(p.ws + OFF_WB) + (size_t)(l & 1) * WB_END;
  constexpr int T_UP = (2 * DFF / 32) * (D / 64);
  constexpr int T_DN = (D / 32) * (DFF / 64);
  constexpr int T_IN = (ZW / 32) * (D / 64);
  constexpr int T_UQ = (1536 / 32) * (384 / 64);
  constexpr int T_UKV = (2048 / 32) * (256 / 64);
  constexpr int T_SQ = (D / 32) * (D / 64);
  constexpr int C1 = T_UP, C2 = C1 + T_DN, C3 = C2 + T_UP, C4 = C3 + T_DN, C5 = C4 + T_IN, C6 = C5 + T_UQ, C7 = C6 + T_UKV,
                C8 = C7 + T_SQ, C9 = C8 + T_SQ, C10 = C9 + T_SQ;
  if (t1 > C10) t1 = C10;
  for (int t = t0; t < t1; t += tstep) {
    if (t < C1) convert_tile(p.w_ff1_up + (size_t)l * D * 2 * DFF, 2 * DFF, D, 1, wb + WB_UP1, t, smem);
    else if (t < C2) convert_tile(p.w_ff1_dn + (size_t)l * DFF * D, D, DFF, 0, wb + WB_DN1, t - C1, smem);
    else if (t < C3) convert_tile(p.w_ff2_up + (size_t)l * D * 2 * DFF, 2 * DFF, D, 1, wb + WB_UP2, t - C2, smem);
    else if (t < C4) convert_tile(p.w_ff2_dn + (size_t)l * DFF * D, D, DFF, 0, wb + WB_DN2, t - C3, smem);
    else if (t < C5) convert_tile(p.w_in + (size_t)l * D * INW, INW, D, 2, wb + WB_IN, t - C4, smem);
    else if (t < C6) convert_tile(p.w_uq + (size_t)l * 384 * 1536, 1536, 384, 0, wb + WB_UQ, t - C5, smem);
    else if (t < C7) convert_tile(p.w_ukv + (size_t)l * 256 * 2048, 2048, 256, 0, wb + WB_UKV, t - C6, smem);
    else if (t < C8) convert_tile(p.w_bm + (size_t)l * D * D, D, D, 0, wb + WB_BM, t - C7, smem);
    else if (t < C9) convert_tile(p.w_ba + (size_t)l * D * D, D, D, 0, wb + WB_BA, t - C8, smem);
    else convert_tile(p.w_out + (size_t)l * D * D, D, D, 0, wb + WB_OUT, t - C9, smem);
  }
}
constexpr int CONV_TILES = 13984;
constexpr int CONV_PER_TASK = 16;
constexpr int NCONV = (CONV_TILES + CONV_PER_TASK - 1) / CONV_PER_TASK;
DI void phase_convert(const Params& p, int l, char* smem, int bid, int nb) { convert_range(p, l, smem, bid, CONV_TILES, nb); }

DI void phase_init(const Params& p, char* smem, int bid, int nb) {
  const int tid = tidx(), lane = tid & 63, wid = tid >> 6;
  {
    float2* tab = (float2*)(p.ws + OFF_ROPE);
    for (int idx = bid * 256 + tid; idx < SEQ * 32; idx += nb * 256) {
      const int t = idx >> 5, i = idx & 31, f = i & 15;
      const float pos = (float)(i < 16 ? (t >> 6) : (t & 63));
      const float inv = powf(10000.f, -(float)(2 * f) / 32.f);
      const float ang = pos * inv;
      tab[idx] = make_float2(cosf(ang), sinf(ang));
    }
  }
  float* sc = (float*)smem;
  float* red = sc + 5 * D;
  for (int i = tid; i < 5 * D; i += 256) {
    const int row = i >> 10, k = i & 1023;
    const float v = row < 4 ? p.c[row * D + k] : p.c_ctx[k];
    sc[i] = siluf(v);
  }
  __syncthreads();
  float* mods = (float*)(p.ws + OFF_MODS);
  constexpr int NG = NMOD * D / 128;
  for (int t = bid; t < NL * NG; t += nb) {
    const int l = t / NG, n = (t - l * NG) * 128 + lane * 2;
    const float* w = p.w_ada + (size_t)l * D * NMOD * D + n;
    float a0 = 0, a1 = 0, a2 = 0, a3 = 0, a4 = 0, b0 = 0, b1 = 0, b2 = 0, b3 = 0, b4 = 0;
    const int kb = wid * 256;
#pragma unroll 8
    for (int k = 0; k < 256; ++k) {
      const float2 wv = *(const float2*)(w + (size_t)(kb + k) * (NMOD * D));
      const float s0 = sc[kb + k], s1 = sc[D + kb + k], s2 = sc[2 * D + kb + k], s3 = sc[3 * D + kb + k], s4 = sc[4 * D + kb + k];
      a0 += s0 * wv.x; a1 += s1 * wv.x; a2 += s2 * wv.x; a3 += s3 * wv.x; a4 += s4 * wv.x;
      b0 += s0 * wv.y; b1 += s1 * wv.y; b2 += s2 * wv.y; b3 += s3 * wv.y; b4 += s4 * wv.y;
    }
    float* rp = red + (wid * 5) * 128 + lane * 2;
    rp[0] = a0; rp[1] = b0; rp[128] = a1; rp[129] = b1; rp[256] = a2; rp[257] = b2; rp[384] = a3; rp[385] = b3; rp[512] = a4; rp[513] = b4;
    __syncthreads();
    for (int i = tid; i < 640; i += 256) {
      const int row = i >> 7, ln = i & 127;
      const int nn = (t - l * NG) * 128 + ln;
      const float s = (red[(0 * 5 + row) * 128 + ln] + red[(1 * 5 + row) * 128 + ln]) + (red[(2 * 5 + row) * 128 + ln] + red[(3 * 5 + row) * 128 + ln]);
      mods[((size_t)l * 5 + row) * (NMOD * D) + nn] = s + p.b_ada[(size_t)l * NMOD * D + nn];
    }
    __syncthreads();
  }
}

DI void phase_norm(const Params& p, int nrows, const float* __restrict__ g, const float* __restrict__ mods_l, int shift_idx, int scale_idx, u16* __restrict__ an, bool from_input, int bid, int nb) {
  const int tid_ = tidx(), lane = tid_ & 63, wid = tid_ >> 6;
  for (int r = bid * 4 + wid; r < nrows; r += nb * 4) {
    const float* x = from_input ? xin_ptr(p, r) : xptr(p, r);
    float4 v[4]; float ss = 0.f;
#pragma unroll
    for (int i = 0; i < 4; ++i) { v[i] = *(const float4*)(x + i * 256 + lane * 4); ss += v[i].x * v[i].x + v[i].y * v[i].y + v[i].z * v[i].z + v[i].w * v[i].w; }
    ss = wave_sum(ss);
    const float rstd = rsqrtf(ss * (1.f / D) + EPS);
    const float* md = mods_l + (size_t)modrow(r) * (NMOD * D);
#pragma unroll
    for (int i = 0; i < 4; ++i) {
      const int col = i * 256 + lane * 4;
      const float4 g4 = *(const float4*)(g + col);
      const float4 sh = *(const float4*)(md + shift_idx * D + col);
      const float4 sc = *(const float4*)(md + scale_idx * D + col);
      const float y0 = v[i].x * rstd * g4.x * (1.f + sc.x) + sh.x;
      const float y1 = v[i].y * rstd * g4.y * (1.f + sc.y) + sh.y;
      const float y2 = v[i].z * rstd * g4.z * (1.f + sc.z) + sh.z;
      const float y3 = v[i].w * rstd * g4.w * (1.f + sc.w) + sh.w;
      uint2 o; o.x = pk2(y0, y1); o.y = pk2(y2, y3);
      *(uint2*)(an + bko(r, col, D / 64)) = o;
    }
  }
}

DI void phase_final(const Params& p, int bid, int nb) {
  const int tid_ = tidx(), lane = tid_ & 63, wid = tid_ >> 6;
  for (int r = bid * 4 + wid; r < RL; r += nb * 4) {
    float* x = p.out + (size_t)r * D;
    float4 v[4]; float ss = 0.f;
#pragma unroll
    for (int i = 0; i < 4; ++i) { v[i] = *(const float4*)(x + i * 256 + lane * 4); ss += v[i].x * v[i].x + v[i].y * v[i].y + v[i].z * v[i].z + v[i].w * v[i].w; }
    ss = wave_sum(ss);
    const float rstd = rsqrtf(ss * (1.f / D) + EPS);
#pragma unroll
    for (int i = 0; i < 4; ++i) {
      const int col = i * 256 + lane * 4;
      const float4 g4 = *(const float4*)(p.g_final + col);
      float4 o; o.x = v[i].x * rstd * g4.x; o.y = v[i].y * rstd * g4.y; o.z = v[i].z * rstd * g4.z; o.w = v[i].w * rstd * g4.w;
      *(float4*)(x + col) = o;
    }
  }
}

constexpr int GSTR = 128;
constexpr int GBUF = 128 * GSTR;

#define G_PARAMS uint4 &ra00, uint4 &ra01, uint4 &ra02, uint4 &ra03, uint4 &rb00, uint4 &rb01, uint4 &rb02, uint4 &rb03, \
                 uint4 &ra10, uint4 &ra11, uint4 &ra12, uint4 &ra13, uint4 &rb10, uint4 &rb11, uint4 &rb12, uint4 &rb13
#define G_DECL uint4 g_a00, g_a01, g_a02, g_a03, g_b00, g_b01, g_b02, g_b03, g_a10, g_a11, g_a12, g_a13, g_b10, g_b11, g_b12, g_b13
#define G_ARGS g_a00, g_a01, g_a02, g_a03, g_b00, g_b01, g_b02, g_b03, g_a10, g_a11, g_a12, g_a13, g_b10, g_b11, g_b12, g_b13
#define G_L1(S, i, kt) ra##S##i = *(const uint4*)(ap + (size_t)(kt) * 8192 + i * 2048); rb##S##i = *(const uint4*)(bp + (size_t)(kt) * 8192 + i * 2048);
#define G_LOAD(S, kt) { G_L1(S, 0, kt) G_L1(S, 1, kt) G_L1(S, 2, kt) G_L1(S, 3, kt) }
#define G_S1(S, i, buf) *(uint4*)(sA + (buf) * GBUF + soff + i * 32 * GSTR) = ra##S##i; *(uint4*)(sB + (buf) * GBUF + soff + i * 32 * GSTR) = rb##S##i;
#define G_STORE(S, buf) { G_S1(S, 0, buf) G_S1(S, 1, buf) G_S1(S, 2, buf) G_S1(S, 3, buf) }
DI void gemm_prefetch(G_PARAMS, const u16* __restrict__ A, int lda, const u16* __restrict__ Bt, int ldb, int m0, int n0) {
  const int tid = tidx();
  const int lr = tid >> 3, lc = tid & 7;
  const u16* ap = A + (size_t)((m0 >> 7) * (lda >> 6)) * 8192 + lr * 64 + lc * 8;
  const u16* bp = Bt + (size_t)((n0 >> 7) * (ldb >> 6)) * 8192 + lr * 64 + lc * 8;
  G_LOAD(0, 0)
  G_LOAD(1, 1)
}
DI void gemm_mainloop(G_PARAMS, const u16* __restrict__ A, int lda, const u16* __restrict__ Bt, int ldb, int nk, int m0, int n0, f32x4 (&acc)[4][4], char* smem) {
  const int tid = tidx(), lane = tid & 63, wid = tid >> 6, wr = wid >> 1, wc = wid & 1;
  const int lr = tid >> 3, lc = tid & 7;
  const u16* ap = A + (size_t)((m0 >> 7) * (lda >> 6)) * 8192 + lr * 64 + lc * 8;
  const u16* bp = Bt + (size_t)((n0 >> 7) * (ldb >> 6)) * 8192 + lr * 64 + lc * 8;
#define G_COMPUTE(buf) { const char* cA = sA + (buf) * GBUF; const char* cB = sB + (buf) * GBUF; \
    _Pragma("unroll") for (int ks = 0; ks < 2; ++ks) { \
      bf16x8 a[4], b[4]; \
      _Pragma("unroll") for (int m = 0; m < 4; ++m) a[m] = *(const bf16x8*)(cA + (aoff ^ (ks * 64)) + m * 16 * GSTR); \
      _Pragma("unroll") for (int n = 0; n < 4; ++n) b[n] = *(const bf16x8*)(cB + (boff ^ (ks * 64)) + n * 16 * GSTR); \
      _Pragma("unroll") for (int m = 0; m < 4; ++m) _Pragma("unroll") for (int n = 0; n < 4; ++n) acc[m][n] = MFMA16(b[n], a[m], acc[m][n]); \
    } }
  char* sA = smem; char* sB = smem + 2 * GBUF;
  const int soff = lr * GSTR + ((lc ^ ((lr >> 1) & 7)) << 4);
  const int fr = lane & 15, fq = lane >> 4;
  const int swz = (fq ^ ((fr >> 1) & 7)) << 4;
  const int aoff = (wr * 64 + fr) * GSTR + swz;
  const int boff = (wc * 64 + fr) * GSTR + swz;
  uint4 ra20, ra21, ra22, ra23, rb20, rb21, rb22, rb23;
  if (2 < nk) G_LOAD(2, 2)
  G_STORE(0, 0)
  __syncthreads();
  if (3 < nk) G_LOAD(0, 3)
#define G_STEP(i, SN, BN) if (kt + (i) < nk) { \
    G_COMPUTE((i) & 1) \
    if (kt + (i) + 1 < nk) G_STORE(SN, BN) \
    __syncthreads(); \
    if (kt + (i) + 4 < nk) G_LOAD(SN, kt + (i) + 4) }
  for (int kt = 0; kt < nk; kt += 6) {
    G_STEP(0, 1, 1)
    G_STEP(1, 2, 0)
    G_STEP(2, 0, 1)
    G_STEP(3, 1, 0)
    G_STEP(4, 2, 1)
    G_STEP(5, 0, 0)
  }
#undef G_STEP
#undef G_COMPUTE
}
#undef G_L1
#undef G_S1
#undef G_LOAD
#undef G_STORE

DI int vbid(int bid, int nb) { return bid; }
DI void tile_of(int tile, int ntn, int& mt, int& nt) {
  const int gm = tile / (4 * ntn), rem = tile - gm * 4 * ntn;
  nt = rem >> 2; mt = gm * 4 + (rem & 3);
}
#define ZERO_ACC(acc) _Pragma("unroll") for (int m_ = 0; m_ < 4; ++m_) _Pragma("unroll") for (int n_ = 0; n_ < 4; ++n_) acc[m_][n_] = f32x4{0.f, 0.f, 0.f, 0.f}

constexpr int ST16 = 272;
constexpr int ST32 = 528;
DI void stage_bf16(const f32x4 (&acc)[4][4], char* st, int wr, int wc, int fr, int fq) {
#pragma unroll
  for (int m = 0; m < 4; ++m)
#pragma unroll
    for (int n = 0; n < 4; ++n) {
      uint2 v; v.x = pk2(acc[m][n][0], acc[m][n][1]); v.y = pk2(acc[m][n][2], acc[m][n][3]);
      *(uint2*)(st + (wr * 64 + 16 * m + fr) * ST16 + (wc * 64 + 16 * n + 4 * fq) * 2) = v;
    }
}
DI void stage_f32(const f32x4 (&acc)[4][4], char* st, int wr, int wc, int fr, int fq) {
#pragma unroll
  for (int m = 0; m < 4; ++m)
#pragma unroll
    for (int n = 0; n < 4; ++n) *(f32x4*)(st + (wr * 64 + 16 * m + fr) * ST32 + (wc * 64 + 16 * n + 4 * fq) * 4) = acc[m][n];
}

DI void phase_ffn_up(const Params& p, int mtn, const u16* an, const u16* wt, u16* h, char* smem, int bid, int nb) {
  constexpr int NTN = 2 * DFF / 128;
  G_DECL;
  { int tile = vbid(bid, nb); if (tile < mtn * NTN) { int mt, nt; tile_of(tile, NTN, mt, nt); gemm_prefetch(G_ARGS, an, D, wt, D, mt * 128, nt * 128); } }
  for (int tile = vbid(bid, nb); tile < mtn * NTN; tile += nb) {
    int mt, nt; tile_of(tile, NTN, mt, nt);
    f32x4 acc[4][4]; ZERO_ACC(acc);
    gemm_mainloop(G_ARGS, an, D, wt, D, D / 64, mt * 128, nt * 128, acc, smem);
    if (tile + nb < mtn * NTN) { int mt2, nt2; tile_of(tile + nb, NTN, mt2, nt2); gemm_prefetch(G_ARGS, an, D, wt, D, mt2 * 128, nt2 * 128); }
    const int tid = tidx(), lane = tid & 63, wid = tid >> 6, wr = wid >> 1, wc = wid & 1, fr = lane & 15, fq = lane >> 4;
#pragma unroll
    for (int m = 0; m < 4; ++m)
#pragma unroll
      for (int n = 0; n < 2; ++n) {
        float o[4];
#pragma unroll
        for (int r = 0; r < 4; ++r) o[r] = siluf(acc[m][n][r]) * acc[m][n + 2][r];
        uint2 v; v.x = pk2(o[0], o[1]); v.y = pk2(o[2], o[3]);
        *(uint2*)(smem + (wr * 64 + 16 * m + fr) * ST16 + (wc * 32 + 16 * n + 4 * fq) * 2) = v;
      }
    __syncthreads();
    const unsigned rbase = mt * 128, cbase = nt * 64;
#pragma unroll
    for (int i = 0; i < 4; ++i) {
      const unsigned id = tid + 256 * i, row = id >> 3, ch = id & 7;
      const uint4 v = *(const uint4*)(smem + row * ST16 + ch * 16);
      *(uint4*)(h + bko(rbase + row, cbase + ch * 8, DFF / 64)) = v;
    }
    __syncthreads();
  }
}

DI void phase_gemm_resid(const Params& p, int mtn, const u16* a, int K, const u16* wt, const float* mods_l, int gate_idx, float coef, bool from_input, char* smem, int bid, int nb) {
  constexpr int NTN = D / 128;
  G_DECL;
  { int tile = vbid(bid, nb); if (tile < mtn * NTN) { int mt, nt; tile_of(tile, NTN, mt, nt); gemm_prefetch(G_ARGS, a, K, wt, K, mt * 128, nt * 128); } }
  for (int tile = vbid(bid, nb); tile < mtn * NTN; tile += nb) {
    int mt, nt; tile_of(tile, NTN, mt, nt);
    f32x4 acc[4][4]; ZERO_ACC(acc);
    gemm_mainloop(G_ARGS, a, K, wt, K, K / 64, mt * 128, nt * 128, acc, smem);
    if (tile + nb < mtn * NTN) { int mt2, nt2; tile_of(tile + nb, NTN, mt2, nt2); gemm_prefetch(G_ARGS, a, K, wt, K, mt2 * 128, nt2 * 128); }
    const int tid = tidx(), lane = tid & 63, wid = tid >> 6, wr = wid >> 1, wc = wid & 1, fr = lane & 15, fq = lane >> 4;
    stage_f32(acc, smem, wr, wc, fr, fq);
    __syncthreads();
    const int r0 = mt * 128;
    const float* md = mods_l + (size_t)modrow(r0) * (NMOD * D) + gate_idx * D + nt * 128;
    float* xb = xptr(p, r0) + nt * 128;
    const float* xr = from_input ? xin_ptr(p, r0) + nt * 128 : xb;
    const unsigned ch = tid & 31;
    const float4 g4 = *(const float4*)(md + ch * 4);
#pragma unroll 4
    for (int i = 0; i < 16; ++i) {
      const unsigned row = (tid >> 5) + 8 * i;
      const float4 v = *(const float4*)(smem + row * ST32 + ch * 16);
      float4* xp = (float4*)(xb + row * (unsigned)D + ch * 4);
      float4 x = *(const float4*)(xr + row * (unsigned)D + ch * 4);
      x.x += coef * g4.x * v.x; x.y += coef * g4.y * v.y; x.z += coef * g4.z * v.z; x.w += coef * g4.w * v.w;
      *xp = x;
    }
    __syncthreads();
  }
}

DI void phase_inproj(const Params& p, int l, const u16* an, const u16* wt, char* smem, int bid, int nb) {
  constexpr int NTN = ZW / 128;
  char* ws = p.ws;
  G_DECL;
  { int tile = vbid(bid, nb); if (tile < MT * NTN) { int mt, nt; tile_of(tile, NTN, mt, nt); gemm_prefetch(G_ARGS, an, D, wt, D, mt * 128, nt * 128); } }
  for (int tile = vbid(bid, nb); tile < MT * NTN; tile += nb) {
    int mt, nt; tile_of(tile, NTN, mt, nt);
    f32x4 acc[4][4]; ZERO_ACC(acc);
    gemm_mainloop(G_ARGS, an, D, wt, D, D / 64, mt * 128, nt * 128, acc, smem);
    if (tile + nb < MT * NTN) { int mt2, nt2; tile_of(tile + nb, NTN, mt2, nt2); gemm_prefetch(G_ARGS, an, D, wt, D, mt2 * 128, nt2 * 128); }
    const int tid = tidx(), lane = tid & 63, wid = tid >> 6, wr = wid >> 1, wc = wid & 1, fr = lane & 15, fq = lane >> 4;
    if (nt == 37) {
      if (wc == 0) {
        u16* zkr = (u16*)(ws + OFF_ZKR);
#pragma unroll
        for (int m = 0; m < 4; ++m)
#pragma unroll
          for (int n = 0; n < 4; ++n) {
            const unsigned row = mt * 128 + wr * 64 + 16 * m + fr;
            uint2 v; v.x = pk2(acc[m][n][0], acc[m][n][1]); v.y = pk2(acc[m][n][2], acc[m][n][3]);
            *(uint2*)(zkr + row * 64u + 16 * n + 4 * fq) = v;
          }
      } else {
        float* zg = (float*)(ws + OFF_ZG);
        const float4 b4 = *(const float4*)(p.b_gate + l * 16 + 4 * fq);
#pragma unroll
        for (int m = 0; m < 4; ++m) {
          const unsigned row = mt * 128 + wr * 64 + 16 * m + fr;
          float4 v; v.x = acc[m][0][0] + b4.x; v.y = acc[m][0][1] + b4.y; v.z = acc[m][0][2] + b4.z; v.w = acc[m][0][3] + b4.w;
          *(float4*)(zg + row * 16u + 4 * fq) = v;
        }
      }
      continue;
    }
    if (nt >= 32 && nt < 37) {
      const bool isq = nt < 35;
      const float* gv = isq ? p.g_qa + l * 384 + (nt - 32) * 128 : p.g_kva + l * 256 + (nt - 35) * 128;
      float* ss2 = (float*)(ws + OFF_SS2);
      const int slot = isq ? (nt - 32) * 2 + wc : 8 + (nt - 35) * 2 + wc;
#pragma unroll
      for (int m = 0; m < 4; ++m) {
        float ssum = 0.f;
#pragma unroll
        for (int n = 0; n < 4; ++n) ssum += (acc[m][n][0] * acc[m][n][0] + acc[m][n][1] * acc[m][n][1]) + (acc[m][n][2] * acc[m][n][2] + acc[m][n][3] * acc[m][n][3]);
        ssum += __shfl_xor(ssum, 16); ssum += __shfl_xor(ssum, 32);
        if (fq == 0) ss2[(unsigned)(mt * 128 + wr * 64 + 16 * m + fr) * 16u + slot] = ssum;
      }
#pragma unroll
      for (int n = 0; n < 4; ++n) {
        const float4 g4 = *(const float4*)(gv + wc * 64 + 16 * n + 4 * fq);
#pragma unroll
        for (int m = 0; m < 4; ++m) { acc[m][n][0] *= g4.x; acc[m][n][1] *= g4.y; acc[m][n][2] *= g4.z; acc[m][n][3] *= g4.w; }
      }
    }
    stage_bf16(acc, smem, wr, wc, fr, fq);
    __syncthreads();
    const int c = nt * 128;
    u16* dst; unsigned ld, c0; unsigned nkb = 0;
    if (c < 4096) { dst = (u16*)(ws + OFF_ZQ) + (size_t)(c >> 10) * R * D; ld = D; c0 = c & 1023; }
    else if (c < 4480) { dst = (u16*)(ws + OFF_CQN); ld = 384; c0 = c - 4096; nkb = 6; }
    else if (c < 4736) { dst = (u16*)(ws + OFF_CKVN); ld = 256; c0 = c - 4480; nkb = 4; }
    else { dst = (u16*)(ws + OFF_ZBR); ld = 2048; c0 = c - 4864; }
    const unsigned rbase = mt * 128;
#pragma unroll
    for (int i = 0; i < 8; ++i) {
      const unsigned id = tid + 256 * i, row = id >> 4, ch = id & 15;
      const uint4 v = *(const uint4*)(smem + row * ST16 + ch * 16);
      *(uint4*)(dst + (nkb ? bko(rbase + row, c0 + ch * 8, nkb) : (rbase + row) * ld + c0 + ch * 8)) = v;
    }
    __syncthreads();
  }
}

DI void phase_prep(const Params& p, int l, int bid, int nb) {
  const int tid_ = tidx(), lane = tid_ & 63, wid = tid_ >> 6;
  char* ws = p.ws;
  const u16* zq = (const u16*)(ws + OFF_ZQ); const u16* zk = (const u16*)(ws + OFF_ZK);
  u16* qc = (u16*)(ws + OFF_AN); u16* kc = (u16*)(ws + OFF_KC);
  const float* wcv = p.w_conv + (size_t)l * 3 * 2048;
  const float2* tab = (const float2*)(ws + OFF_ROPE);
  for (int r = bid * 4 + wid; r < R; r += nb * 4) {
    int t, T;
    if (r < RL) { t = r & 4095; T = SEQ; } else { t = (r - RL) & 255; T = CTX; }
    const bool hp = t > 0, hn = t < T - 1;
#pragma unroll
    for (int c4 = 0; c4 < 4; ++c4) {
      const int ch = c4 * 512 + lane * 8;
      const bool isq = ch < 1024;
      const u16* src = isq ? zq : zk;
      const int cc = isq ? ch : ch - 1024;
      const uint4 zero = make_uint4(0, 0, 0, 0);
      const uint4 vc = *(const uint4*)(src + (size_t)r * D + cc);
      const uint4 vp = hp ? *(const uint4*)(src + (size_t)(r - 1) * D + cc) : zero;
      const uint4 vn = hn ? *(const uint4*)(src + (size_t)(r + 1) * D + cc) : zero;
      const unsigned pc[4] = {vc.x, vc.y, vc.z, vc.w}, pp[4] = {vp.x, vp.y, vp.z, vp.w}, pn[4] = {vn.x, vn.y, vn.z, vn.w};
      float o[8];
#pragma unroll
      for (int e = 0; e < 8; ++e) {
        const int sh = (e & 1) * 16;
        const float xc = bf2f((u16)(pc[e >> 1] >> sh)), xp = bf2f((u16)(pp[e >> 1] >> sh)), xn = bf2f((u16)(pn[e >> 1] >> sh));
        const float w0 = wcv[ch + e], w1 = wcv[2048 + ch + e], w2 = wcv[4096 + ch + e];
        float y = siluf(xp * w0 + xc * w1 + xn * w2);
        o[e] = isq ? y * 0.0625f : y;
      }
      uint4 ov; ov.x = pk2(o[0], o[1]); ov.y = pk2(o[2], o[3]); ov.z = pk2(o[4], o[5]); ov.w = pk2(o[6], o[7]);
      *(uint4*)((isq ? qc : kc) + (size_t)r * D + cc) = ov;
    }
    {
      const float v = bf2f(((const u16*)(ws + OFF_ZKR))[(size_t)r * 64 + lane]);
      const float pv = __shfl_xor(v, 1);
      float o = v;
      if (r < RL) {
        const float2 cs = tab[t * 32 + (lane >> 1)];
        o = (lane & 1) ? (pv * cs.y + v * cs.x) : (v * cs.x - pv * cs.y);
      }
      ((u16*)(ws + OFF_KROPE))[(size_t)r * 64 + lane] = f2bf(o);
    }
  }
  {
    const float* zg = (const float*)(ws + OFF_ZG);
    for (int item = bid * 4 + wid; item < 32 * NCH; item += nb * 4) {
      const int stream = item / NCH, n = item - stream * NCH;
      const int b = stream >> 3, hd = (stream >> 1) & 3, dir = stream & 1;
      int base, T, cc;
      if (n < 4) { base = RL + b * CTX; T = CTX; cc = n; } else { base = b * SEQ; T = SEQ; cc = n - 4; }
      const int pos = cc * 64 + lane;
      const int row = base + (dir ? T - 1 - pos : pos);
      const float ig = zg[(size_t)row * 16 + dir * 8 + hd];
      const float fg = zg[(size_t)row * 16 + dir * 8 + 4 + hd];
      const float lf = fminf(fg, 0.f) - log1pf(__expf(-fabsf(fg)));
      float bc = lf;
#pragma unroll
      for (int d = 1; d < 64; d <<= 1) { const float tt = __shfl_up(bc, d); if (lane >= d) bc += tt; }
      const float bL = __shfl(bc, 63);
      const float wv = ig - bc;
      float pm = wv;
#pragma unroll
      for (int d = 1; d < 64; d <<= 1) { const float tt = __shfl_up(pm, d); if (lane >= d) pm = fmaxf(pm, tt); }
      const float endl = bL + wv;
      const float me = wave_max(endl);
      float* g = (float*)(ws + OFF_G) + ((size_t)stream * NCH + n) * 512;
      g[lane] = bc; g[64 + lane] = wv; g[128 + lane] = pm; g[192 + lane] = endl;
      if (lane == 0) { g[256] = bL; g[257] = me; }
    }
  }
}

DI void phase_upproj(const Params& p, const u16* wb, char* smem, int bid, int nb) {
  char* ws = p.ws;
  const float2* tab = (const float2*)(ws + OFF_ROPE);
  u16* qa = (u16*)(ws + OFF_H);
  u16* kv = (u16*)(ws + OFF_KV);
  constexpr int NQ = 12, NKV = 16;
  const int total = MT * (NQ + NKV);
  G_DECL;
#define UP_PREFETCH(T) { const int t_ = (T); if (t_ < MT * NQ) { int m_, n_; tile_of(t_, NQ, m_, n_); gemm_prefetch(G_ARGS, (const u16*)(ws + OFF_CQN), 384, wb + WB_UQ, 384, m_ * 128, n_ * 128); } \
    else if (t_ < total) { int m_, n_; tile_of(t_ - MT * NQ, NKV, m_, n_); gemm_prefetch(G_ARGS, (const u16*)(ws + OFF_CKVN), 256, wb + WB_UKV, 256, m_ * 128, n_ * 128); } }
  for (int tile = vbid(bid, nb); tile < total; tile += nb) {
    const bool isq = tile < MT * NQ;
    int mt, nt;
    f32x4 acc[4][4]; ZERO_ACC(acc);
    UP_PREFETCH(tile)
    if (isq) { tile_of(tile, NQ, mt, nt); gemm_mainloop(G_ARGS, (const u16*)(ws + OFF_CQN), 384, wb + WB_UQ, 384, 6, mt * 128, nt * 128, acc, smem); }
    else { tile_of(tile - MT * NQ, NKV, mt, nt); gemm_mainloop(G_ARGS, (const u16*)(ws + OFF_CKVN), 256, wb + WB_UKV, 256, 4, mt * 128, nt * 128, acc, smem); }
    const int tid = tidx(), lane = tid & 63, wid = tid >> 6, wr = wid >> 1, wc = wid & 1, fr = lane & 15, fq = lane >> 4;
    {
      const float* ss2 = (const float*)(ws + OFF_SS2);
#pragma unroll
      for (int m = 0; m < 4; ++m) {
        const float* sp = ss2 + (unsigned)(mt * 128 + wr * 64 + 16 * m + fr) * 16u;
        float rstd;
        if (isq) { const float4 a = *(const float4*)sp; const float2 b = *(const float2*)(sp + 4); rstd = rsqrtf((((a.x + a.y) + (a.z + a.w)) + (b.x + b.y)) * (1.f / 384.f) + EPS); }
        else { const float4 a = *(const float4*)(sp + 8); rstd = rsqrtf(((a.x + a.y) + (a.z + a.w)) * (1.f / 256.f) + EPS); }
#pragma unroll
        for (int n = 0; n < 4; ++n) { acc[m][n][0] *= rstd; acc[m][n][1] *= rstd; acc[m][n][2] *= rstd; acc[m][n][3] *= rstd; }
      }
    }
    stage_bf16(acc, smem, wr, wc, fr, fq);
    __syncthreads();
    const unsigned rbase = mt * 128;
    if (isq) {
#pragma unroll
      for (int i = 0; i < 8; ++i) {
        const unsigned id = tid + 256 * i, row = id >> 4, ch = id & 15;
        uint4 v = *(const uint4*)(smem + row * ST16 + ch * 16);
        const unsigned col = nt * 128 + ch * 8, d0 = col % 192u, grow = rbase + row;
        if (d0 >= 128u && grow < (unsigned)RL) {
          const float4* tp = (const float4*)(tab + (grow & 4095u) * 32u + ((d0 - 128u) >> 1));
          const float4 t0 = tp[0], t1 = tp[1];
          float x0, x1;
          x0 = bf2f((u16)(v.x & 0xffff)); x1 = bf2f((u16)(v.x >> 16)); v.x = pk2(x0 * t0.x - x1 * t0.y, x0 * t0.y + x1 * t0.x);
          x0 = bf2f((u16)(v.y & 0xffff)); x1 = bf2f((u16)(v.y >> 16)); v.y = pk2(x0 * t0.z - x1 * t0.w, x0 * t0.w + x1 * t0.z);
          x0 = bf2f((u16)(v.z & 0xffff)); x1 = bf2f((u16)(v.z >> 16)); v.z = pk2(x0 * t1.x - x1 * t1.y, x0 * t1.y + x1 * t1.x);
          x0 = bf2f((u16)(v.w & 0xffff)); x1 = bf2f((u16)(v.w >> 16)); v.w = pk2(x0 * t1.z - x1 * t1.w, x0 * t1.w + x1 * t1.z);
        }
        *(uint4*)(qa + grow * 1536u + col) = v;
      }
    } else {
#pragma unroll
      for (int i = 0; i < 8; ++i) {
        const unsigned id = tid + 256 * i, row = id >> 4, ch = id & 15;
        const uint4 v = *(const uint4*)(smem + row * ST16 + ch * 16);
        *(uint4*)(kv + (rbase + row) * 2048u + nt * 128 + ch * 8) = v;
      }
    }
    __syncthreads();
  }
#undef UP_PREFETCH
}

constexpr int AKS = 400;
constexpr int AVS = 320;
DI void attn_task(const Params& p, int b, int h, int qrow0, int nkt, bool with_latent, char* smem) {
  const int tid = tidx(), lane = tid & 63, wid = tid >> 6, l31 = lane & 31, h2 = lane >> 5;
  char* ws = p.ws;
  const u16* qa = (const u16*)(ws + OFF_H);
  const u16* kvb = (const u16*)(ws + OFF_KV);
  const u16* krp = (const u16*)(ws + OFF_KROPE);
  u16* ao = (u16*)(ws + OFF_H) + (size_t)R * 1536;
  char* Ks = smem; char* Vs = smem + 64 * AKS;
  bf16x8 qf[12];
  {
    const u16* qp = qa + (size_t)(qrow0 + wid * 32 + l31) * 1536 + h * 192 + h2 * 8;
#pragma unroll
    for (int st = 0; st < 12; ++st) qf[st] = *(const bf16x8*)(qp + st * 16);
  }
  uint4 kreg0, kreg1, kreg2, kreg3, kreg4, kreg5, vreg0, vreg1, vreg2, vreg3;
#define KEY_ROW(kt, i) ((kt) < 4 ? (RL + b * CTX + (kt) * 64 + (i)) : (b * SEQ + ((kt) - 4) * 64 + (i)))
#define ATT_KL(kt, i) { const int id = tid + 256 * i, row = id / 24, ch = id - row * 24; const int kr = KEY_ROW(kt, row); \
    const u16* src = ch < 16 ? (kvb + (size_t)kr * 2048 + h * 256 + ch * 8) : (krp + (size_t)kr * 64 + (ch - 16) * 8); kreg##i = *(const uint4*)src; }
#define ATT_VL(kt, i) { const int id = tid + 256 * i, row = id >> 4, ch = id & 15; const int kr = KEY_ROW(kt, row); \
    vreg##i = *(const uint4*)(kvb + (size_t)kr * 2048 + h * 256 + 128 + ch * 8); }
#define ATT_GLOADK(kt) ATT_KL(kt, 0) ATT_KL(kt, 1) ATT_KL(kt, 2) ATT_KL(kt, 3) ATT_KL(kt, 4) ATT_KL(kt, 5)
#define ATT_GLOADV(kt) ATT_VL(kt, 0) ATT_VL(kt, 1) ATT_VL(kt, 2) ATT_VL(kt, 3)
#define ATT_GLOAD(kt) ATT_GLOADK(kt) ATT_GLOADV(kt)
#define ATT_KS(i) { const int id = tid + 256 * i, row = id / 24, ch = id - row * 24; *(uint4*)(Ks + row * AKS + ch * 16) = kreg##i; }
#define ATT_VS(i) { const int id = tid + 256 * i, row = id >> 4, ch = id & 15; *(uint4*)(Vs + row * AVS + ch * 16) = vreg##i; }
#define ATT_SSTORE() ATT_KS(0) ATT_KS(1) ATT_KS(2) ATT_KS(3) ATT_KS(4) ATT_KS(5) ATT_VS(0) ATT_VS(1) ATT_VS(2) ATT_VS(3)
  f32x16 o[4];
#pragma unroll
  for (int n = 0; n < 4; ++n)
#pragma unroll
    for (int i = 0; i < 16; ++i) o[n][i] = 0.f;
  float mrun = -1e30f, lrun = 0.f;
  const float sc = 0.07216878364870322f * 1.4426950408889634f;
  const int i16 = lane & 15, tq = i16 >> 2, tp = i16 & 3, blk = (lane >> 4) & 1;
  ATT_GLOAD(0)
  __syncthreads();
  ATT_SSTORE()
  __syncthreads();
  for (int kt = 0; kt < nkt; ++kt) {
    if (kt + 1 < nkt) { ATT_GLOADK(kt + 1) }
    f32x16 s0, s1;
#pragma unroll
    for (int i = 0; i < 16; ++i) { s0[i] = 0.f; s1[i] = 0.f; }
#pragma unroll
    for (int st = 0; st < 12; ++st) {
      const bf16x8 a0 = *(const bf16x8*)(Ks + l31 * AKS + st * 32 + h2 * 16);
      const bf16x8 a1 = *(const bf16x8*)(Ks + (32 + l31) * AKS + st * 32 + h2 * 16);
      s0 = MFMA32(a0, qf[st], s0);
      s1 = MFMA32(a1, qf[st], s1);
    }
    __builtin_amdgcn_sched_group_barrier(0x100, 4, 0);
#pragma unroll
    for (int i = 0; i < 10; ++i) { __builtin_amdgcn_sched_group_barrier(0x008, 2, 0); __builtin_amdgcn_sched_group_barrier(0x100, 2, 0); }
    __builtin_amdgcn_sched_group_barrier(0x008, 4, 0);
    __builtin_amdgcn_sched_barrier(0);
    float mx = s0[0];
#pragma unroll
    for (int i = 0; i < 16; ++i) { mx = fmaxf(mx, s0[i]); mx = fmaxf(mx, s1[i]); }
    mx = fmaxf(mx, __shfl_xor(mx, 32));
    const float mnew = fmaxf(mrun, mx * sc);
    const float alpha = __builtin_amdgcn_exp2f(mrun - mnew);
    mrun = mnew;
    float ls = 0.f;
#pragma unroll
    for (int i = 0; i < 16; ++i) { s0[i] = __builtin_amdgcn_exp2f(s0[i] * sc - mnew); s1[i] = __builtin_amdgcn_exp2f(s1[i] * sc - mnew); ls += s0[i] + s1[i]; }
    lrun = lrun * alpha + ls;
    if (__any(alpha != 1.f)) {
#pragma unroll
      for (int n = 0; n < 4; ++n)
#pragma unroll
        for (int i = 0; i < 16; ++i) o[n][i] *= alpha;
    }
    bf16x8 pbv[4];
#define ATT_PACK(SV, HH) \
    _Pragma("unroll") for (int s = 0; s < 2; ++s) { \
      u32x4 pu; \
      pu[0] = pk2(SV[8 * s + 0], SV[8 * s + 1]); pu[1] = pk2(SV[8 * s + 2], SV[8 * s + 3]); \
      pu[2] = pk2(SV[8 * s + 4], SV[8 * s + 5]); pu[3] = pk2(SV[8 * s + 6], SV[8 * s + 7]); \
      pbv[2 * HH + s] = __builtin_bit_cast(bf16x8, pu); \
    }
    ATT_PACK(s0, 0)
    ATT_PACK(s1, 1)
#undef ATT_PACK
    if (kt + 1 < nkt) { ATT_GLOADV(kt + 1) }
#pragma unroll
    for (int hs = 0; hs < 4; ++hs) {
      const char* vlo = Vs + (16 * hs + 4 * h2 + tq) * AVS + (16 * blk) * 2 + 8 * tp;
#pragma unroll
      for (int n = 0; n < 4; ++n) {
        const bf16x8 va = tr8(vlo + n * 64, vlo + n * 64 + 8 * AVS);
        o[n] = MFMA32(va, pbv[hs], o[n]);
      }
    }
    __syncthreads();
    if (kt + 1 < nkt) { ATT_SSTORE() }
    __syncthreads();
  }
  const float ltot = lrun + __shfl_xor(lrun, 32);
  const float inv = 1.f / ltot;
  const unsigned orow = qrow0 + wid * 32 + l31;
#pragma unroll
  for (int n = 0; n < 4; ++n)
#pragma unroll
    for (int g = 0; g < 4; ++g) {
      uint2 w; w.x = pk2(o[n][4 * g] * inv, o[n][4 * g + 1] * inv); w.y = pk2(o[n][4 * g + 2] * inv, o[n][4 * g + 3] * inv);
      *(uint2*)(ao + bko(orow, h * 128 + 32 * n + 8 * g + 4 * h2, D / 64)) = w;
    }
}

constexpr int MKS = 528;
constexpr int MVS = 112;
constexpr int M_CT = 64 * MKS;
constexpr int M_VS = M_CT + 48 * MKS;
constexpr int M_VW = M_VS + 64 * MVS;
constexpr int M_GS = 73728;
constexpr int M_MS = M_GS + 1536;
DI void mlstm_task(const Params& p, int task, char* smem) {
  const int tid = tidx(), lane = tid & 63, w = tid >> 6, fr = lane & 15, fq = lane >> 4, tq = fr >> 2, tp = fr & 3;
  const int stream = task >> 3, c = task & 7, b = stream >> 3, hd = (stream >> 1) & 3, dir = stream & 1;
  char* ws = p.ws;
  const u16* qc = (const u16*)(ws + OFF_AN); const u16* kc = (const u16*)(ws + OFF_KC); const u16* zv = (const u16*)(ws + OFF_ZV);
  const float* G = (const float*)(ws + OFF_G) + (size_t)stream * NCH * 512;
  _Float16* hout = (_Float16*)(ws + (dir ? OFF_ZK : OFF_ZQ));
  char* Ks = smem; char* Ct = smem + M_CT; char* Vs = smem + M_VS; char* Vw = smem + M_VW;
#define ROW_OF(n, pos) ((n) < 4 ? (RL + b * CTX + (dir ? CTX - 1 - ((n) * 64 + (pos)) : ((n) * 64 + (pos)))) : (b * SEQ + (dir ? SEQ - 1 - (((n) - 4) * 64 + (pos)) : (((n) - 4) * 64 + (pos)))))
  __syncthreads();
  for (int i = tid; i < 48 * MKS / 16; i += 256) ((uint4*)Ct)[i] = make_uint4(0, 0, 0, 0);
  f32x4 cacc[4][3];
#pragma unroll
  for (int kt = 0; kt < 4; ++kt)
#pragma unroll
    for (int vt = 0; vt < 3; ++vt) cacc[kt][vt] = f32x4{0.f, 0.f, 0.f, 0.f};
  uint4 kreg0, kreg1, kreg2, kreg3, kreg4, kreg5, kreg6, kreg7; uint4 vreg; float wreg; float4 greg = make_float4(0.f, 0.f, 0.f, 0.f);
#define M_KL(n, i) { const int id = tid + 256 * i, row = id >> 5, ch = id & 31; kreg##i = *(const uint4*)(kc + (size_t)ROW_OF(n, row) * D + hd * 256 + ch * 8); }
#define M_GLOAD(n) { M_KL(n, 0) M_KL(n, 1) M_KL(n, 2) M_KL(n, 3) M_KL(n, 4) M_KL(n, 5) M_KL(n, 6) M_KL(n, 7) \
    const int row_ = tid >> 2, part_ = tid & 3; \
    vreg = *(const uint4*)(zv + (size_t)ROW_OF(n, row_) * D + hd * 256 + c * 32 + part_ * 8); \
    wreg = G[(size_t)(n) * 512 + 192 + row_]; \
    if (tid < 64) { greg.x = G[(size_t)(n) * 512 + tid]; greg.y = G[(size_t)(n) * 512 + 64 + tid]; greg.z = G[(size_t)(n) * 512 + 128 + tid]; greg.w = G[(size_t)(n) * 512 + 192 + tid]; } }
#define M_KS(i) { const int id = tid + 256 * i, row = id >> 5, ch = id & 31; *(uint4*)(Ks + row * MKS + ch * 16) = kreg##i; }
#define M_SSTORE(n) { M_KS(0) M_KS(1) M_KS(2) M_KS(3) M_KS(4) M_KS(5) M_KS(6) M_KS(7) \
    const int row = tid >> 2, part = tid & 3; \
    const float mp_ = ((const float*)(smem + M_MS))[136 + (n)], mn_ = ((const float*)(smem + M_MS))[204 + (n)]; \
    if (tid < 64) { float* gs_ = (float*)(smem + M_GS); const float mj_ = fmaxf(greg.x + mp_, greg.x + greg.z); \
      gs_[tid] = greg.x - mj_; gs_[64 + tid] = greg.y; gs_[128 + tid] = __expf(greg.x + mp_ - mj_); gs_[192 + tid] = __expf(-mj_); gs_[256 + tid] = __expf(greg.w - mn_); \
      if (tid == 0) gs_[320] = __expf(((const float*)(smem + M_MS))[(n)] + mp_ - mn_); } \
    wreg = __expf(wreg - mn_); \
    *(uint4*)(Vs + row * MVS + part * 16) = vreg; \
    uint4 wv; \
    wv.x = pk2(bf2f((u16)(vreg.x & 0xffff)) * wreg, bf2f((u16)(vreg.x >> 16)) * wreg); \
    wv.y = pk2(bf2f((u16)(vreg.y & 0xffff)) * wreg, bf2f((u16)(vreg.y >> 16)) * wreg); \
    wv.z = pk2(bf2f((u16)(vreg.z & 0xffff)) * wreg, bf2f((u16)(vreg.z >> 16)) * wreg); \
    wv.w = pk2(bf2f((u16)(vreg.w & 0xffff)) * wreg, bf2f((u16)(vreg.w >> 16)) * wreg); \
    *(uint4*)(Vw + row * MVS + part * 16) = wv; \
    if (part == 0) { \
      *(uint4*)(Vs + row * MVS + 64) = make_uint4(0x3f80u, 0, 0, 0); \
      *(uint4*)(Vs + row * MVS + 80) = make_uint4(0, 0, 0, 0); \
      *(uint4*)(Vw + row * MVS + 64) = make_uint4((unsigned)f2bf(wreg), 0, 0, 0); \
      *(uint4*)(Vw + row * MVS + 80) = make_uint4(0, 0, 0, 0); \
    } }
#define M_QLOAD(n) { \
    const u16* qp = qc + (size_t)ROW_OF(n, 16 * w + fr) * D + hd * 256 + fq * 8; \
    _Pragma("unroll") for (int ks = 0; ks < 8; ++ks) qf[ks] = *(const bf16x8*)(qp + ks * 32); }
  bf16x8 qf[8];
  M_GLOAD(0) M_QLOAD(0)
  {
    float* ms = (float*)(smem + M_MS);
    if (tid < NCH) { ms[tid] = G[(size_t)tid * 512 + 256]; ms[68 + tid] = G[(size_t)tid * 512 + 257]; }
    __syncthreads();
    if (tid == 0) { float m = 0.f; for (int i = 0; i < NCH; ++i) { const float mn = fmaxf(ms[i] + m, ms[68 + i]); ms[136 + i] = m; ms[204 + i] = mn; m = mn; } }
    __syncthreads();
  }
  M_SSTORE(0)
  __syncthreads();
  for (int n = 0; n < NCH; ++n) {
    const bool more = n + 1 < NCH;
    if (more) M_GLOAD(n + 1)
    const float* g = (const float*)(smem + M_GS);
    const int jpos = 16 * w + fr;
    const float u_j = g[jpos], e_j = g[128 + jpos], rd_j = g[192 + jpos];
    const float a_state = g[320];
    f32x4 xs[4];
#pragma unroll
    for (int st = 0; st < 4; ++st) {
      xs[st] = f32x4{0.f, 0.f, 0.f, 0.f};
      if (st <= w) {
#pragma unroll
        for (int ks = 0; ks < 8; ++ks) {
          const bf16x8 a = *(const bf16x8*)(Ks + (16 * st + fr) * MKS + ks * 64 + fq * 16);
          xs[st] = MFMA16(a, qf[ks], xs[st]);
        }
        const float4 wv4 = *(const float4*)(g + 64 + 16 * st + 4 * fq);
        const int sb = 16 * st + 4 * fq;
        xs[st][0] *= (sb + 0 <= jpos) ? __expf(u_j + wv4.x) : 0.f;
        xs[st][1] *= (sb + 1 <= jpos) ? __expf(u_j + wv4.y) : 0.f;
        xs[st][2] *= (sb + 2 <= jpos) ? __expf(u_j + wv4.z) : 0.f;
        xs[st][3] *= (sb + 3 <= jpos) ? __expf(u_j + wv4.w) : 0.f;
      }
    }
    bf16x8 pb[2];
#pragma unroll
    for (int u = 0; u < 2; ++u) {
      u32x4 pu;
      pu[0] = pk2(xs[2 * u][0], xs[2 * u][1]); pu[1] = pk2(xs[2 * u][2], xs[2 * u][3]);
      pu[2] = pk2(xs[2 * u + 1][0], xs[2 * u + 1][1]); pu[3] = pk2(xs[2 * u + 1][2], xs[2 * u + 1][3]);
      pb[u] = __builtin_bit_cast(bf16x8, pu);
    }
    f32x4 num[3];
#pragma unroll
    for (int vt = 0; vt < 3; ++vt) {
      f32x4 n1 = {0.f, 0.f, 0.f, 0.f}, n2 = {0.f, 0.f, 0.f, 0.f};
#pragma unroll
      for (int u = 0; u < 2; ++u) {
        const char* lo = Vs + (32 * u + 4 * fq + tq) * MVS + (16 * vt) * 2 + 8 * tp;
        const bf16x8 a = tr8(lo, lo + 16 * MVS);
        n1 = MFMA16(a, pb[u], n1);
      }
#pragma unroll
      for (int ks = 0; ks < 8; ++ks) {
        const bf16x8 a = *(const bf16x8*)(Ct + (16 * vt + fr) * MKS + ks * 64 + fq * 16);
        n2 = MFMA16(a, qf[ks], n2);
      }
#pragma unroll
      for (int r = 0; r < 4; ++r) num[vt][r] = n1[r] + e_j * n2[r];
    }
    const float den = __shfl(num[2][0], fr);
    const float inv = 1.f / fmaxf(fabsf(den), rd_j);
    {
      _Float16* hp = hout + (size_t)ROW_OF(n, jpos) * D + hd * 256 + c * 32 + 4 * fq;
#pragma unroll
      for (int vt = 0; vt < 2; ++vt) {
        h16x4 hv;
#pragma unroll
        for (int r = 0; r < 4; ++r) hv[r] = (_Float16)(num[vt][r] * inv);
        *(h16x4*)(hp + 16 * vt) = hv;
      }
    }
    if (more) M_QLOAD(n + 1)
    __syncthreads();
#pragma unroll
    for (int kt = 0; kt < 4; ++kt)
#pragma unroll
      for (int vt = 0; vt < 3; ++vt) cacc[kt][vt] *= a_state;
#pragma unroll
    for (int u = 0; u < 2; ++u) {
      bf16x8 bfr[3];
#pragma unroll
      for (int vt = 0; vt < 3; ++vt) {
        const char* lo = Vw + (32 * u + 8 * fq + tq) * MVS + (16 * vt) * 2 + 8 * tp;
        bfr[vt] = tr8(lo, lo + 4 * MVS);
      }
#pragma unroll
      for (int kt = 0; kt < 4; ++kt) {
        const char* lo = Ks + (32 * u + 8 * fq + tq) * MKS + (64 * w + 16 * kt) * 2 + 8 * tp;
        const bf16x8 af = tr8(lo, lo + 4 * MKS);
#pragma unroll
        for (int vt = 0; vt < 3; ++vt) cacc[kt][vt] = MFMA16(af, bfr[vt], cacc[kt][vt]);
      }
    }
#pragma unroll
    for (int kt = 0; kt < 4; ++kt)
#pragma unroll
      for (int vt = 0; vt < 3; ++vt) {
        uint2 o2; o2.x = pk2(cacc[kt][vt][0], cacc[kt][vt][1]); o2.y = pk2(cacc[kt][vt][2], cacc[kt][vt][3]);
        *(uint2*)(Ct + (16 * vt + fr) * MKS + (64 * w + 16 * kt + 4 * fq) * 2) = o2;
      }
    __syncthreads();
    if (more) M_SSTORE(n + 1)
    __syncthreads();
  }
}

DI int q_pull(int* head, volatile LAS unsigned* s_task_p) {
  __syncthreads();
  if (threadIdx.x == 0) *s_task_p = (unsigned)atomicAdd(head, 1);
  __syncthreads();
  return (int)*s_task_p;
}
DI void phase_mix(const Params& p, int l, char* smem, volatile LAS unsigned* s_task_p, int bid, int nb) {
  int* C = (int*)(p.ws + OFF_CTR) + l * 16;
  const bool last = (l & 3) == NL - 1;
  const int per_g = last ? 32 : 34;
  const int n_cv = last ? 0 : NCONV;
  const int xcd = (int)(xb_xcc_id() & 7u);
  for (;;) { const int t = q_pull(C, s_task_p); if (t >= 256) break; mlstm_task(p, t, smem); }
  for (int j = 0; j < 8; ++j) {
    const int x = (xcd + j) & 7;
    for (;;) {
      const int e = q_pull(C + 1 + x, s_task_p);
      if (e >= 4 * per_g) break;
      const int gi = e / per_g, r = e - gi * per_g, g = x + 8 * gi, b = g >> 3, h = g & 7;
      if (r < 32) attn_task(p, b, h, b * SEQ + r * 128, 68, true, smem);
      else attn_task(p, b, h, RL + b * CTX + (r - 32) * 128, 4, false, smem);
    }
  }
  for (;;) { const int t = q_pull(C + 9, s_task_p); if (t >= n_cv) break; const int c0 = t * CONV_PER_TASK; convert_range(p, (l & 3) + 1, smem, c0, c0 + CONV_PER_TASK, 1); }
}

DI void phase_mout(const Params& p, int l, int bid, int nb) {
  const int tid_ = tidx(), lane = tid_ & 63, wid = tid_ >> 6;
  char* ws = p.ws;
  const _Float16* hf = (const _Float16*)(ws + OFF_ZQ); const _Float16* hb = (const _Float16*)(ws + OFF_ZK);
  const u16* zo = (const u16*)(ws + OFF_ZO);
  u16* hm = (u16*)(ws + OFF_KC);
  for (int r = bid * 4 + wid; r < R; r += nb * 4) {
#pragma unroll
    for (int hd = 0; hd < 4; ++hd) {
      const size_t off = (size_t)r * D + hd * 256 + lane * 4;
      const h16x4 a = *(const h16x4*)(hf + off), bb = *(const h16x4*)(hb + off);
      float v[4]; float ss = 0.f;
#pragma unroll
      for (int e = 0; e < 4; ++e) { v[e] = (float)a[e] + (float)bb[e]; ss += v[e] * v[e]; }
      ss = wave_sum(ss);
      const float rstd = rsqrtf(ss * (1.f / 256.f) + EPS);
      const uint2 z = *(const uint2*)(zo + off);
      const float4 g4 = *(const float4*)(p.g_mh + (size_t)l * D + hd * 256 + lane * 4);
      const float o0 = sigmf(bf2f((u16)(z.x & 0xffff))) * v[0] * rstd * g4.x;
      const float o1 = sigmf(bf2f((u16)(z.x >> 16))) * v[1] * rstd * g4.y;
      const float o2 = sigmf(bf2f((u16)(z.y & 0xffff))) * v[2] * rstd * g4.z;
      const float o3 = sigmf(bf2f((u16)(z.y >> 16))) * v[3] * rstd * g4.w;
      uint2 o; o.x = pk2(o0, o1); o.y = pk2(o2, o3);
      *(uint2*)(hm + bko(r, hd * 256 + lane * 4, D / 64)) = o;
    }
  }
}

DI void phase_merge(const Params& p, const u16* wb, int mtn, char* smem, int bid, int nb) {
  constexpr int NTN = D / 128;
  char* ws = p.ws;
  const u16* hm = (const u16*)(ws + OFF_KC);
  const u16* ao = (const u16*)(ws + OFF_H) + (size_t)R * 1536;
  const u16* zbr = (const u16*)(ws + OFF_ZBR);
  u16* tt = (u16*)(ws + OFF_AN);
  G_DECL;
  for (int tile = vbid(bid, nb); tile < mtn * NTN; tile += nb) {
    int mt, nt; tile_of(tile, NTN, mt, nt);
    f32x4 acc[4][4]; ZERO_ACC(acc);
    gemm_prefetch(G_ARGS, hm, D, wb + WB_BM, D, mt * 128, nt * 128);
    gemm_mainloop(G_ARGS, hm, D, wb + WB_BM, D, D / 64, mt * 128, nt * 128, acc, smem);
    const unsigned rbase = mt * 128;
    {
      const int tid = tidx(), lane = tid & 63, wid = tid >> 6, wr = wid >> 1, wc = wid & 1, fr = lane & 15, fq = lane >> 4;
      stage_bf16(acc, smem, wr, wc, fr, fq);
      __syncthreads();
#pragma unroll
      for (int i = 0; i < 8; ++i) {
        const unsigned id = tid + 256 * i, row = id >> 4, ch = id & 15;
        const uint4 a = *(const uint4*)(smem + row * ST16 + ch * 16);
        const unsigned grow = rbase + row, col = nt * 128 + ch * 8;
        const uint4 gm = *(const uint4*)(zbr + grow * 2048u + col);
        uint4 o;
#define MRG1(F) o.F = pk2(sigmf(bf2f((u16)(gm.F & 0xffff))) * bf2f((u16)(a.F & 0xffff)), sigmf(bf2f((u16)(gm.F >> 16))) * bf2f((u16)(a.F >> 16)));
        MRG1(x) MRG1(y) MRG1(z) MRG1(w)
#undef MRG1
        *(uint4*)(tt + bko(grow, col, D / 64)) = o;
      }
      __syncthreads();
    }
    ZERO_ACC(acc);
    gemm_prefetch(G_ARGS, ao, D, wb + WB_BA, D, mt * 128, nt * 128);
    gemm_mainloop(G_ARGS, ao, D, wb + WB_BA, D, D / 64, mt * 128, nt * 128, acc, smem);
    const int tid = tidx(), lane = tid & 63, wid = tid >> 6, wr = wid >> 1, wc = wid & 1, fr = lane & 15, fq = lane >> 4;
    stage_bf16(acc, smem, wr, wc, fr, fq);
    __syncthreads();
#pragma unroll
    for (int i = 0; i < 8; ++i) {
      const unsigned id = tid + 256 * i, row = id >> 4, ch = id & 15;
      const uint4 b = *(const uint4*)(smem + row * ST16 + ch * 16);
      const unsigned grow = rbase + row, col = nt * 128 + ch * 8;
      const uint4 a = *(const uint4*)(tt + bko(grow, col, D / 64));
      const uint4 ga = *(const uint4*)(zbr + grow * 2048u + 1024u + col);
      uint4 o;
#define MRG(F) { \
      const float o0 = bf2f((u16)(a.F & 0xffff)) + sigmf(bf2f((u16)(ga.F & 0xffff))) * bf2f((u16)(b.F & 0xffff)); \
      const float o1 = bf2f((u16)(a.F >> 16)) + sigmf(bf2f((u16)(ga.F >> 16))) * bf2f((u16)(b.F >> 16)); \
      o.F = pk2(o0, o1); }
      MRG(x) MRG(y) MRG(z) MRG(w)
#undef MRG
      *(uint4*)(tt + bko(grow, col, D / 64)) = o;
    }
    __syncthreads();
  }
}

__global__ void __launch_bounds__(256, 2) fwd_kernel(Params p) {
  extern __shared__ __attribute__((aligned(16))) char smem[];
  __shared__ __attribute__((aligned(16))) unsigned xbw[4];
  const int bid = blockIdx.x, nb = gridDim.x;
  char* ws = p.ws;
  u16* an = (u16*)(ws + OFF_AN);
  u16* hbuf = (u16*)(ws + OFF_H);
  if (threadIdx.x < 4) xbw[threadIdx.x] = 0u;
  __syncthreads();
  XcdBarrier xb = xcd_barrier_post((unsigned*)(ws + OFF_BAR), (volatile LAS unsigned*)xbw);
  for (int ph = p.ph_lo; ph < p.ph_hi; ++ph) {
    if (ph == NPH - 1) {
      phase_final(p, bid, nb);
    } else {
      const int l = ph / NPH_LAYER, k = ph - l * NPH_LAYER;
      if (k == 0 && l > 0) continue;
      if (k == 7) continue;
      const u16* wb = (const u16*)(ws + OFF_WB) + (size_t)(l & 1) * WB_END;
      const float* mods_l = (const float*)(ws + OFF_MODS) + (size_t)l * 5 * NMOD * D;
      const int mtl = (l == NL - 1) ? RL / 128 : MT;
      const int nrep = ((DUP_MASK >> k) & 1) ? 2 : 1;
      for (int rep = 0; rep < nrep; ++rep) {
      if (rep) xcd_barrier(xb);
      switch (k) {
        case 0:
          if (l == 0) phase_init(p, smem, bid, nb);
          phase_convert(p, l, smem, bid, nb);
          break;
        case 1: phase_norm(p, R, p.g_n1 + l * D, mods_l, 0, 1, an, l == 0, bid, nb); break;
        case 2: phase_ffn_up(p, MT, an, wb + WB_UP1, hbuf, smem, bid, nb); break;
        case 3: phase_gemm_resid(p, MT, hbuf, DFF, wb + WB_DN1, mods_l, 2, 0.5f, l == 0, smem, bid, nb); break;
        case 4: phase_norm(p, R, p.g_n2 + l * D, mods_l, 3, 4, an, false, bid, nb); break;
        case 5: phase_inproj(p, l, an, wb + WB_IN, smem, bid, nb); break;
        case 6: phase_prep(p, l, bid, nb); phase_upproj(p, wb, smem, bid, nb); break;
        case 7: phase_upproj(p, wb, smem, bid, nb); break;
        case 8: phase_mix(p, l + 4 * rep, smem, (volatile LAS unsigned*)&xbw[2], bid, nb); break;
        case 9: phase_mout(p, l, bid, nb); break;
        case 10: phase_merge(p, wb, mtl, smem, bid, nb); break;
        case 11: phase_gemm_resid(p, mtl, an, D, wb + WB_OUT, mods_l, 5, 1.0f, false, smem, bid, nb); break;
        case 12: phase_norm(p, mtl * 128, p.g_n3 + l * D, mods_l, 6, 7, an, false, bid, nb); break;
        case 13: phase_ffn_up(p, mtl, an, wb + WB_UP2, hbuf, smem, bid, nb); break;
        case 14: phase_gemm_resid(p, mtl, hbuf, DFF, wb + WB_DN2, mods_l, 8, 0.5f, false, smem, bid, nb); break;
      }
      }
    }
    if (ph + 1 < p.ph_hi) { if (ph == 0) cg::this_grid().sync(); else xcd_barrier(xb); }
  }
}

extern "C" void kernel_launch(void* const* d_in, const int* in_sizes, int n_in, void* d_out, int out_size, void* d_ws, size_t ws_size, hipStream_t stream) {
  static int grid = 0;
  if (grid == 0) {
    if (n_in != 25 || ws_size < WS_END) { fprintf(stderr, "kernel_launch: unexpected n_in %d or ws_size %zu (< %zu)\n", n_in, ws_size, (size_t)WS_END); grid = -1; return; }
    int dev = 0, cus = 0, per_cu = 0;
    hipGetDevice(&dev);
    hipDeviceGetAttribute(&cus, hipDeviceAttributeMultiprocessorCount, dev);
    hipFuncSetAttribute((const void*)fwd_kernel, hipFuncAttributeMaxDynamicSharedMemorySize, SMEM_BYTES);
    hipOccupancyMaxActiveBlocksPerMultiprocessor(&per_cu, (const void*)fwd_kernel, 256, SMEM_BYTES);
    if (per_cu < 1) per_cu = 1;
    if (per_cu > 2) per_cu = 2;
    grid = cus * per_cu;
    fprintf(stderr, "kernel_launch: grid %d (%d CUs x %d), ws need %zu have %zu\n", grid, cus, per_cu, (size_t)WS_END, ws_size);
  }
  if (grid < 0) return;
  Params p{};
  const float** f = (const float**)&p;
  for (int i = 0; i < 25; ++i) f[i] = (const float*)d_in[i];
  p.out = (float*)d_out; p.ws = (char*)d_ws;
  hipMemsetAsync((char*)d_ws + OFF_CTR, 0, (OFF_WB - OFF_CTR), stream);
#if ONE_LAUNCH
  p.ph_lo = 0; p.ph_hi = NPH;
  void* args[] = {&p};
  hipError_t e = hipLaunchCooperativeKernel((const void*)fwd_kernel, dim3(grid), dim3(256), args, SMEM_BYTES, stream);
  if (e != hipSuccess) fprintf(stderr, "cooperative launch failed: %s (grid %d)\n", hipGetErrorString(e), grid);
#else
  for (int ph = 0; ph < NPH; ++ph) {
    p.ph_lo = ph; p.ph_hi = ph + 1;
    hipLaunchKernelGGL(fwd_kernel, dim3(grid), dim3(256), SMEM_BYTES, stream, p);
  }
#endif
}
```

```cpp
#include <hip/hip_runtime.h>
#include <hip/hip_cooperative_groups.h>
#include <cstdio>
namespace cg = cooperative_groups;

#ifndef DUP_MASK
#define DUP_MASK 0
#endif
#ifndef ONE_LAUNCH
#define ONE_LAUNCH 1
#endif

typedef unsigned short u16;
typedef __attribute__((ext_vector_type(8))) short bf16x8;
typedef __attribute__((ext_vector_type(4))) short s16x4;
typedef __attribute__((ext_vector_type(4))) float f32x4;
typedef __attribute__((ext_vector_type(16))) float f32x16;
typedef __attribute__((ext_vector_type(4))) _Float16 h16x4;
typedef __attribute__((ext_vector_type(4))) unsigned u32x4;
#define DI __device__ __forceinline__
#define MFMA16(a, b, c) __builtin_amdgcn_mfma_f32_16x16x32_bf16((a), (b), (c), 0, 0, 0)
#define MFMA32(a, b, c) __builtin_amdgcn_mfma_f32_32x32x16_bf16((a), (b), (c), 0, 0, 0)

constexpr int D = 1024, NB = 4, SEQ = 4096, NL = 4, CTX = 256;
constexpr int RL = NB * SEQ;
constexpr int RC = NB * CTX;
constexpr int R = RL + RC;
constexpr int DFF = 2816, INW = 6864, ZW = 6912, NMOD = 9;
constexpr float EPS = 1e-6f;
constexpr int NCH = 68;
constexpr int MT = R / 128;

constexpr size_t al(size_t x) { return (x + 255) & ~(size_t)255; }
constexpr size_t OFF_XC = 0;
constexpr size_t OFF_MODS = al(OFF_XC + (size_t)RC * D * 4);
constexpr size_t OFF_ROPE = al(OFF_MODS + (size_t)NL * 5 * NMOD * D * 4);
constexpr size_t OFF_G = al(OFF_ROPE + (size_t)SEQ * 32 * 8);
constexpr size_t OFF_CTR = al(OFF_G + (size_t)32 * NCH * 512 * 4);
constexpr size_t OFF_BAR = al(OFF_CTR + 8 * 16 * 4);
constexpr size_t OFF_WB = al(OFF_BAR + 3456 * 4);
constexpr size_t WB_UP1 = 0;
constexpr size_t WB_DN1 = WB_UP1 + (size_t)2 * DFF * D;
constexpr size_t WB_UP2 = WB_DN1 + (size_t)D * DFF;
constexpr size_t WB_DN2 = WB_UP2 + (size_t)2 * DFF * D;
constexpr size_t WB_IN = WB_DN2 + (size_t)D * DFF;
constexpr size_t WB_UQ = WB_IN + (size_t)ZW * D;
constexpr size_t WB_UKV = WB_UQ + (size_t)1536 * 384;
constexpr size_t WB_BM = WB_UKV + (size_t)2048 * 256;
constexpr size_t WB_BA = WB_BM + (size_t)D * D;
constexpr size_t WB_OUT = WB_BA + (size_t)D * D;
constexpr size_t WB_END = WB_OUT + (size_t)D * D;
constexpr size_t OFF_AN = al(OFF_WB + 2 * WB_END * 2);
constexpr size_t OFF_H = al(OFF_AN + (size_t)R * D * 2);
constexpr size_t OFF_ZQ = al(OFF_H + (size_t)R * DFF * 2);
constexpr size_t OFF_ZK = al(OFF_ZQ + (size_t)R * D * 2);
constexpr size_t OFF_ZV = al(OFF_ZK + (size_t)R * D * 2);
constexpr size_t OFF_ZO = al(OFF_ZV + (size_t)R * D * 2);
constexpr size_t OFF_ZCQ = al(OFF_ZO + (size_t)R * D * 2);
constexpr size_t OFF_ZCKV = al(OFF_ZCQ + (size_t)R * 384 * 2);
constexpr size_t OFF_ZKR = al(OFF_ZCKV + (size_t)R * 256 * 2);
constexpr size_t OFF_ZG = al(OFF_ZKR + (size_t)R * 64 * 2);
constexpr size_t OFF_ZBR = al(OFF_ZG + (size_t)R * 16 * 4);
constexpr size_t OFF_KC = al(OFF_ZBR + (size_t)R * 2048 * 2);
constexpr size_t OFF_KV = al(OFF_KC + (size_t)R * D * 2);
constexpr size_t OFF_CQN = al(OFF_KV + (size_t)R * 2048 * 2);
constexpr size_t OFF_CKVN = al(OFF_CQN + (size_t)R * 384 * 2);
constexpr size_t OFF_KROPE = al(OFF_CKVN + (size_t)R * 256 * 2);
constexpr size_t OFF_SS2 = al(OFF_KROPE + (size_t)R * 64 * 2);
constexpr size_t WS_END = al(OFF_SS2 + (size_t)R * 16 * 4);

constexpr int SMEM_BYTES = 76800;
constexpr int NPH_LAYER = 15;
constexpr int NPH = NL * NPH_LAYER + 1;

struct Params {
  const float *x, *c, *ctx, *c_ctx, *w_ada, *b_ada, *g_n1, *g_n2, *g_n3, *w_ff1_up, *w_ff1_dn, *w_ff2_up, *w_ff2_dn,
      *w_in, *b_gate, *w_conv, *g_mh, *g_qa, *g_kva, *w_uq, *w_ukv, *w_bm, *w_ba, *w_out, *g_final;
  float* out;
  char* ws;
  int ph_lo, ph_hi;
};

DI float bf2f(u16 u) { return __uint_as_float(((unsigned)u) << 16); }
DI u16 f2bf(float x) { return __builtin_bit_cast(u16, (__bf16)x); }
DI unsigned pk2(float a, float b) { return (unsigned)f2bf(a) | ((unsigned)f2bf(b) << 16); }
DI float siluf(float x) { return x / (1.f + __expf(-x)); }
DI float sigmf(float x) { return 1.f / (1.f + __expf(-x)); }
DI float wave_sum(float v) {
#pragma unroll
  for (int o = 32; o > 0; o >>= 1) v += __shfl_xor(v, o);
  return v;
}
DI float wave_max(float v) {
#pragma unroll
  for (int o = 32; o > 0; o >>= 1) v = fmaxf(v, __shfl_xor(v, o));
  return v;
}
DI int tidx() { int t = threadIdx.x; asm volatile("" : "+v"(t)); return t; }
DI unsigned bko(unsigned r, unsigned k, unsigned nkt) { return ((r >> 7) * nkt + (k >> 6)) * 8192u + ((r & 127u) << 6) + (k & 63u); }
DI float* xptr(const Params& p, int r) { return r < RL ? p.out + (size_t)r * D : (float*)(p.ws + OFF_XC) + (size_t)(r - RL) * D; }
DI const float* xin_ptr(const Params& p, int r) { return r < RL ? p.x + (size_t)r * D : p.ctx + (size_t)(r - RL) * D; }
DI int modrow(int r) { return r < RL ? (r >> 12) : 4; }
DI bf16x8 tr8(const char* lo, const char* hi) {
  s16x4 a = __builtin_amdgcn_ds_read_tr16_b64_v4i16((s16x4 __attribute__((address_space(3)))*)(lo));
  s16x4 b = __builtin_amdgcn_ds_read_tr16_b64_v4i16((s16x4 __attribute__((address_space(3)))*)(hi));
  return __builtin_shufflevector(a, b, 0, 1, 2, 3, 4, 5, 6, 7);
}


#define XB_TMO      128
#define XB_XCNT(j)  (256  + 64 * (j))
#define XB_XSUB(j)  (1280 + 64 * (j))
#define XB_XGEN(j)  (2304 + 64 * (j))
#define XB_TOP      3328
#define XB_TOPGEN   3392
#define XCD_BAR_WORDS 3456
#define XB_SPIN_CAP (1u << 22)
#define LAS __attribute__((address_space(3)))
DI unsigned xb_ld(unsigned* p) { return __hip_atomic_load(p, __ATOMIC_RELAXED, __HIP_MEMORY_SCOPE_AGENT); }
DI unsigned xb_add(unsigned* p, unsigned v) { return __hip_atomic_fetch_add(p, v, __ATOMIC_RELAXED, __HIP_MEMORY_SCOPE_AGENT); }
DI unsigned xb_xcc_id() { return (unsigned)__builtin_amdgcn_s_getreg((3 << 11) | 20) & 0xFu; }
#define XB_SPIN(cond, bar) do { unsigned _sp = 0; while (cond) { __builtin_amdgcn_s_sleep(1); \
    if ((++_sp & 255u) == 0u) { if (xb_ld(&(bar)[XB_TMO])) break; if (_sp > XB_SPIN_CAP) { atomicAdd(&(bar)[XB_TMO], 1u); break; } } } } while (0)
struct XcdBarrier { unsigned* bar; unsigned x; volatile LAS unsigned* st; };
DI XcdBarrier xcd_barrier_post(unsigned* bar, volatile LAS unsigned* st) {
  XcdBarrier b; b.bar = bar; b.x = xb_xcc_id(); b.st = st;
  if (threadIdx.x == 0) (void)xb_add(&bar[XB_XCNT(b.x)], 1u);
  return b;
}
DI void xcd_barrier_complete(unsigned* bar, unsigned x, unsigned& nloc, unsigned& nx) {
  const unsigned G = gridDim.x * gridDim.y * gridDim.z;
  unsigned sum, cnt, mine, sp = 0u;
  for (;;) {
    sum = 0u; cnt = 0u; mine = 0u;
#pragma unroll
    for (unsigned j = 0; j < 16; ++j) { const unsigned c = xb_ld(&bar[XB_XCNT(j)]); sum += c; cnt += (c > 0u) ? 1u : 0u; mine = (j == x) ? c : mine; }
    if (sum == G) break;
    __builtin_amdgcn_s_sleep(1);
    if ((++sp & 255u) == 0u) { if (xb_ld(&bar[XB_TMO])) break; if (sp > XB_SPIN_CAP) { atomicAdd(&bar[XB_TMO], 1u); break; } }
  }
  nloc = mine > 0u ? mine : 1u; nx = cnt > 0u ? cnt : 1u;
}
DI void xcd_barrier(const XcdBarrier& b) {
  asm volatile("s_waitcnt vmcnt(0)" ::: "memory");
  __syncthreads();
  if (threadIdx.x == 0) {
    unsigned* bar = b.bar;
    __builtin_amdgcn_s_waitcnt(0);
    unsigned nloc = b.st[0], nx = b.st[1];
    if (nloc == 0u) { xcd_barrier_complete(bar, b.x, nloc, nx); b.st[0] = nloc; b.st[1] = nx; }
    const unsigned old = xb_add(&bar[XB_XSUB(b.x)], 1u);
    const unsigned gen = old / nloc;
    if (old + 1u == (gen + 1u) * nloc) {
      __builtin_amdgcn_fence(__ATOMIC_RELEASE, "agent");
      asm volatile("s_waitcnt vmcnt(0)" ::: "memory");
      const unsigned og = xb_add(&bar[XB_TOP], 1u);
      const unsigned tg = og / nx;
      if (og + 1u == (tg + 1u) * nx) xb_add(&bar[XB_TOPGEN], 1u);
      else XB_SPIN(xb_ld(&bar[XB_TOPGEN]) == tg, bar);
      __builtin_amdgcn_fence(__ATOMIC_ACQUIRE, "agent");
      xb_add(&bar[XB_XGEN(b.x)], 1u);
      asm volatile("s_waitcnt vmcnt(0)" ::: "memory");
    } else {
      XB_SPIN(xb_ld(&bar[XB_XGEN(b.x)]) == gen, bar);
      __builtin_amdgcn_fence(__ATOMIC_ACQUIRE, "agent");
      asm volatile("s_waitcnt vmcnt(0)" ::: "memory");
    }
  }
  __syncthreads();
}

DI int src_col(int perm, int r) {
  if (perm == 0) return r;
  if (perm == 1) { int grp = r >> 6, j = r & 63; return j < 32 ? grp * 32 + j : DFF + grp * 32 + (j - 32); }
  if (r < 4096) return r;
  if (r < 4800) return r + 16;
  if (r < 4816) return r - 704;
  if (r < 4864) return -1;
  return r - 48;
}

DI void convert_tile(const float* __restrict__ W, int Nsrc, int K, int perm, u16* __restrict__ Wt, int tile, char* smem) {
  const int nkt = K >> 6;
  const int rt = tile / nkt, kt = tile - rt * nkt;
  const int r0 = rt * 32, k0 = kt * 64;
  u16* t = (u16*)smem;
  const int tid = tidx();
  {
    const int j = tid & 31, i = tid >> 5;
    const int sc = src_col(perm, r0 + j);
#pragma unroll
    for (int s = 0; s < 8; ++s) {
      const int k = i + 8 * s;
      float v = sc >= 0 ? W[(size_t)(k0 + k) * Nsrc + sc] : 0.f;
      t[j * 72 + k] = f2bf(v);
    }
  }
  __syncthreads();
  {
    const int row = tid >> 3, c8 = tid & 7;
    uint4 v = *(const uint4*)(t + row * 72 + c8 * 8);
    *(uint4*)(Wt + bko(r0 + row, k0 + c8 * 8, K >> 6)) = v;
  }
  __syncthreads();
}

DI void convert_range(const Params& p, int l, char* smem, int t0, int t1, int tstep) {
  u16* wb = (u16*)(p.ws + OFF_WB) + (size_t)(l & 1) * WB_END;
  constexpr int T_UP = (2 * DFF / 32) * (D / 64);
  constexpr int T_DN = (D / 32) * (DFF / 64);
  constexpr int T_IN = (ZW / 32) * (D / 64);
  constexpr int T_UQ = (1536 / 32) * (384 / 64);
  constexpr int T_UKV = (2048 / 32) * (256 / 64);
  constexpr int T_SQ = (D / 32) * (D / 64);
  constexpr int C1 = T_UP, C2 = C1 + T_DN, C3 = C2 + T_UP, C4 = C3 + T_DN, C5 = C4 + T_IN, C6 = C5 + T_UQ, C7 = C6 + T_UKV,
                C8 = C7 + T_SQ, C9 = C8 + T_SQ, C10 = C9 + T_SQ;
  if (t1 > C10) t1 = C10;
  for (int t = t0; t < t1; t += tstep) {
    if (t < C1) convert_tile(p.w_ff1_up + (size_t)l * D * 2 * DFF, 2 * DFF, D, 1, wb + WB_UP1, t, smem);
    else if (t < C2) convert_tile(p.w_ff1_dn + (size_t)l * DFF * D, D, DFF, 0, wb + WB_DN1, t - C1, smem);
    else if (t < C3) convert_tile(p.w_ff2_up + (size_t)l * D * 2 * DFF, 2 * DFF, D, 1, wb + WB_UP2, t - C2, smem);
    else if (t < C4) convert_tile(p.w_ff2_dn + (size_t)l * DFF * D, D, DFF, 0, wb + WB_DN2, t - C3, smem);
    else if (t < C5) convert_tile(p.w_in + (size_t)l * D * INW, INW, D, 2, wb + WB_IN, t - C4, smem);
    else if (t < C6) convert_tile(p.w_uq + (size_t)l * 384 * 1536, 1536, 384, 0, wb + WB_UQ, t - C5, smem);
    else if (t < C7) convert_tile(p.w_ukv + (size_t)l * 256 * 2048, 2048, 256, 0, wb + WB_UKV, t - C6, smem);
    else if (t < C8) convert_tile(p.w_bm + (size_t)l * D * D, D, D, 0, wb + WB_BM, t - C7, smem);
    else if (t < C9) convert_tile(p.w_ba + (size_t)l * D * D, D, D, 0, wb + WB_BA, t - C8, smem);
    else convert_tile(p.w_out + (size_t)l * D * D, D, D, 0, wb + WB_OUT, t - C9, smem);
  }
}
constexpr int CONV_TILES = 13984;
constexpr int CONV_PER_TASK = 16;
constexpr int NCONV = (CONV_TILES + CONV_PER_TASK - 1) / CONV_PER_TASK;
DI void phase_convert(const Params& p, int l, char* smem, int bid, int nb) { convert_range(p, l, smem, bid, CONV_TILES, nb); }

DI void phase_init(const Params& p, char* smem, int bid, int nb) {
  const int tid = tidx(), lane = tid & 63, wid = tid >> 6;
  {
    float2* tab = (float2*)(p.ws + OFF_ROPE);
    for (int idx = bid * 256 + tid; idx < SEQ * 32; idx += nb * 256) {
      const int t = idx >> 5, i = idx & 31, f = i & 15;
      const float pos = (float)(i < 16 ? (t >> 6) : (t & 63));
      const float inv = powf(10000.f, -(float)(2 * f) / 32.f);
      const float ang = pos * inv;
      tab[idx] = make_float2(cosf(ang), sinf(ang));
    }
  }
  float* sc = (float*)smem;
  float* red = sc + 5 * D;
  for (int i = tid; i < 5 * D; i += 256) {
    const int row = i >> 10, k = i & 1023;
    const float v = row < 4 ? p.c[row * D + k] : p.c_ctx[k];
    sc[i] = siluf(v);
  }
  __syncthreads();
  float* mods = (float*)(p.ws + OFF_MODS);
  constexpr int NG = NMOD * D / 128;
  for (int t = bid; t < NL * NG; t += nb) {
    const int l = t / NG, n = (t - l * NG) * 128 + lane * 2;
    const float* w = p.w_ada + (size_t)l * D * NMOD * D + n;
    float a0 = 0, a1 = 0, a2 = 0, a3 = 0, a4 = 0, b0 = 0, b1 = 0, b2 = 0, b3 = 0, b4 = 0;
    const int kb = wid * 256;
#pragma unroll 8
    for (int k = 0; k < 256; ++k) {
      const float2 wv = *(const float2*)(w + (size_t)(kb + k) * (NMOD * D));
      const float s0 = sc[kb + k], s1 = sc[D + kb + k], s2 = sc[2 * D + kb + k], s3 = sc[3 * D + kb + k], s4 = sc[4 * D + kb + k];
      a0 += s0 * wv.x; a1 += s1 * wv.x; a2 += s2 * wv.x; a3 += s3 * wv.x; a4 += s4 * wv.x;
      b0 += s0 * wv.y; b1 += s1 * wv.y; b2 += s2 * wv.y; b3 += s3 * wv.y; b4 += s4 * wv.y;
    }
    float* rp = red + (wid * 5) * 128 + lane * 2;
    rp[0] = a0; rp[1] = b0; rp[128] = a1; rp[129] = b1; rp[256] = a2; rp[257] = b2; rp[384] = a3; rp[385] = b3; rp[512] = a4; rp[513] = b4;
    __syncthreads();
    for (int i = tid; i < 640; i += 256) {
      const int row = i >> 7, ln = i & 127;
      const int nn = (t - l * NG) * 128 + ln;
      const float s = (red[(0 * 5 + row) * 128 + ln] + red[(1 * 5 + row) * 128 + ln]) + (red[(2 * 5 + row) * 128 + ln] + red[(3 * 5 + row) * 128 + ln]);
      mods[((size_t)l * 5 + row) * (NMOD * D) + nn] = s + p.b_ada[(size_t)l * NMOD * D + nn];
    }
    __syncthreads();
  }
}

DI void phase_norm(const Params& p, int nrows, const float* __restrict__ g, const float* __restrict__ mods_l, int shift_idx, int scale_idx, u16* __restrict__ an, bool from_input, int bid, int nb) {
  const int tid_ = tidx(), lane = tid_ & 63, wid = tid_ >> 6;
  for (int r = bid * 4 + wid; r < nrows; r += nb * 4) {
    const float* x = from_input ? xin_ptr(p, r) : xptr(p, r);
    float4 v[4]; float ss = 0.f;
#pragma unroll
    for (int i = 0; i < 4; ++i) { v[i] = *(const float4*)(x + i * 256 + lane * 4); ss += v[i].x * v[i].x + v[i].y * v[i].y + v[i].z * v[i].z + v[i].w * v[i].w; }
    ss = wave_sum(ss);
    const float rstd = rsqrtf(ss * (1.f / D) + EPS);
    const float* md = mods_l + (size_t)modrow(r) * (NMOD * D);
#pragma unroll
    for (int i = 0; i < 4; ++i) {
      const int col = i * 256 + lane * 4;
      const float4 g4 = *(const float4*)(g + col);
      const float4 sh = *(const float4*)(md + shift_idx * D + col);
      const float4 sc = *(const float4*)(md + scale_idx * D + col);
      const float y0 = v[i].x * rstd * g4.x * (1.f + sc.x) + sh.x;
      const float y1 = v[i].y * rstd * g4.y * (1.f + sc.y) + sh.y;
      const float y2 = v[i].z * rstd * g4.z * (1.f + sc.z) + sh.z;
      const float y3 = v[i].w * rstd * g4.w * (1.f + sc.w) + sh.w;
      uint2 o; o.x = pk2(y0, y1); o.y = pk2(y2, y3);
      *(uint2*)(an + bko(r, col, D / 64)) = o;
    }
  }
}

DI void phase_final(const Params& p, int bid, int nb) {
  const int tid_ = tidx(), lane = tid_ & 63, wid = tid_ >> 6;
  for (int r = bid * 4 + wid; r < RL; r += nb * 4) {
    float* x = p.out + (size_t)r * D;
    float4 v[4]; float ss = 0.f;
#pragma unroll
    for (int i = 0; i < 4; ++i) { v[i] = *(const float4*)(x + i * 256 + lane * 4); ss += v[i].x * v[i].x + v[i].y * v[i].y + v[i].z * v[i].z + v[i].w * v[i].w; }
    ss = wave_sum(ss);
    const float rstd = rsqrtf(ss * (1.f / D) + EPS);
#pragma unroll
    for (int i = 0; i < 4; ++i) {
      const int col = i * 256 + lane * 4;
      const float4 g4 = *(const float4*)(p.g_final + col);
      float4 o; o.x = v[i].x * rstd * g4.x; o.y = v[i].y * rstd * g4.y; o.z = v[i].z * rstd * g4.z; o.w = v[i].w * rstd * g4.w;
      *(float4*)(x + col) = o;
    }
  }
}

constexpr int GSTR = 128;
constexpr int GBUF = 128 * GSTR;

#define G_PARAMS uint4 &ra00, uint4 &ra01, uint4 &ra02, uint4 &ra03, uint4 &rb00, uint4 &rb01, uint4 &rb02, uint4 &rb03, \
                 uint4 &ra10, uint4 &ra11, uint4 &ra12, uint4 &ra13, uint4 &rb10, uint4 &rb11, uint4 &rb12, uint4 &rb13
#define G_DECL uint4 g_a00, g_a01, g_a02, g_a03, g_b00, g_b01, g_b02, g_b03, g_a10, g_a11, g_a12, g_a13, g_b10, g_b11, g_b12, g_b13
#define G_ARGS g_a00, g_a01, g_a02, g_a03, g_b00, g_b01, g_b02, g_b03, g_a10, g_a11, g_a12, g_a13, g_b10, g_b11, g_b12, g_b13
#define G_L1(S, i, kt) ra##S##i = *(const uint4*)(ap + (size_t)(kt) * 8192 + i * 2048); rb##S##i = *(const uint4*)(bp + (size_t)(kt) * 8192 + i * 2048);
#define G_LOAD(S, kt) { G_L1(S, 0, kt) G_L1(S, 1, kt) G_L1(S, 2, kt) G_L1(S, 3, kt) }
#define G_S1(S, i, buf) *(uint4*)(sA + (buf) * GBUF + soff + i * 32 * GSTR) = ra##S##i; *(uint4*)(sB + (buf) * GBUF + soff + i * 32 * GSTR) = rb##S##i;
#define G_STORE(S, buf) { G_S1(S, 0, buf) G_S1(S, 1, buf) G_S1(S, 2, buf) G_S1(S, 3, buf) }
DI void gemm_prefetch(G_PARAMS, const u16* __restrict__ A, int lda, const u16* __restrict__ Bt, int ldb, int m0, int n0) {
  const int tid = tidx();
  const int lr = tid >> 3, lc = tid & 7;
  const u16* ap = A + (size_t)((m0 >> 7) * (lda >> 6)) * 8192 + lr * 64 + lc * 8;
  const u16* bp = Bt + (size_t)((n0 >> 7) * (ldb >> 6)) * 8192 + lr * 64 + lc * 8;
  G_LOAD(0, 0)
  G_LOAD(1, 1)
}
DI void gemm_mainloop(G_PARAMS, const u16* __restrict__ A, int lda, const u16* __restrict__ Bt, int ldb, int nk, int m0, int n0, f32x4 (&acc)[4][4], char* smem) {
  const int tid = tidx(), lane = tid & 63, wid = tid >> 6, wr = wid >> 1, wc = wid & 1;
  const int lr = tid >> 3, lc = tid & 7;
  const u16* ap = A + (size_t)((m0 >> 7) * (lda >> 6)) * 8192 + lr * 64 + lc * 8;
  const u16* bp = Bt + (size_t)((n0 >> 7) * (ldb >> 6)) * 8192 + lr * 64 + lc * 8;
#define G_COMPUTE(buf) { const char* cA = sA + (buf) * GBUF; const char* cB = sB + (buf) * GBUF; \
    _Pragma("unroll") for (int ks = 0; ks < 2; ++ks) { \
      bf16x8 a[4], b[4]; \
      _Pragma("unroll") for (int m = 0; m < 4; ++m) a[m] = *(const bf16x8*)(cA + (aoff ^ (ks * 64)) + m * 16 * GSTR); \
      _Pragma("unroll") for (int n = 0; n < 4; ++n) b[n] = *(const bf16x8*)(cB + (boff ^ (ks * 64)) + n * 16 * GSTR); \
      _Pragma("unroll") for (int m = 0; m < 4; ++m) _Pragma("unroll") for (int n = 0; n < 4; ++n) acc[m][n] = MFMA16(b[n], a[m], acc[m][n]); \
    } }
  char* sA = smem; char* sB = smem + 2 * GBUF;
  const int soff = lr * GSTR + ((lc ^ ((lr >> 1) & 7)) << 4);
  const int fr = lane & 15, fq = lane >> 4;
  const int swz = (fq ^ ((fr >> 1) & 7)) << 4;
  const int aoff = (wr * 64 + fr) * GSTR + swz;
  const int boff = (wc * 64 + fr) * GSTR + swz;
  uint4 ra20, ra21, ra22, ra23, rb20, rb21, rb22, rb23;
  if (2 < nk) G_LOAD(2, 2)
  G_STORE(0, 0)
  __syncthreads();
  if (3 < nk) G_LOAD(0, 3)
#define G_STEP(i, SN, BN) if (kt + (i) < nk) { \
    G_COMPUTE((i) & 1) \
    if (kt + (i) + 1 < nk) G_STORE(SN, BN) \
    __syncthreads(); \
    if (kt + (i) + 4 < nk) G_LOAD(SN, kt + (i) + 4) }
  for (int kt = 0; kt < nk; kt += 6) {
    G_STEP(0, 1, 1)
    G_STEP(1, 2, 0)
    G_STEP(2, 0, 1)
    G_STEP(3, 1, 0)
    G_STEP(4, 2, 1)
    G_STEP(5, 0, 0)
  }
#undef G_STEP
#undef G_COMPUTE
}
#undef G_L1
#undef G_S1
#undef G_LOAD
#undef G_STORE

DI int vbid(int bid, int nb) { return bid; }
DI void tile_of(int tile, int ntn, int& mt, int& nt) {
  const int gm = tile / (4 * ntn), rem = tile - gm * 4 * ntn;
  nt = rem >> 2; mt = gm * 4 + (rem & 3);
}
#define ZERO_ACC(acc) _Pragma("unroll") for (int m_ = 0; m_ < 4; ++m_) _Pragma("unroll") for (int n_ = 0; n_ < 4; ++n_) acc[m_][n_] = f32x4{0.f, 0.f, 0.f, 0.f}

constexpr int ST16 = 272;
constexpr int ST32 = 528;
DI void stage_bf16(const f32x4 (&acc)[4][4], char* st, int wr, int wc, int fr, int fq) {
#pragma unroll
  for (int m = 0; m < 4; ++m)
#pragma unroll
    for (int n = 0; n < 4; ++n) {
      uint2 v; v.x = pk2(acc[m][n][0], acc[m][n][1]); v.y = pk2(acc[m][n][2], acc[m][n][3]);
      *(uint2*)(st + (wr * 64 + 16 * m + fr) * ST16 + (wc * 64 + 16 * n + 4 * fq) * 2) = v;
    }
}
DI void stage_f32(const f32x4 (&acc)[4][4], char* st, int wr, int wc, int fr, int fq) {
#pragma unroll
  for (int m = 0; m < 4; ++m)
#pragma unroll
    for (int n = 0; n < 4; ++n) *(f32x4*)(st + (wr * 64 + 16 * m + fr) * ST32 + (wc * 64 + 16 * n + 4 * fq) * 4) = acc[m][n];
}

DI void phase_ffn_up(const Params& p, int mtn, const u16* an, const u16* wt, u16* h, char* smem, int bid, int nb) {
  constexpr int NTN = 2 * DFF / 128;
  G_DECL;
  { int tile = vbid(bid, nb); if (tile < mtn * NTN) { int mt, nt; tile_of(tile, NTN, mt, nt); gemm_prefetch(G_ARGS, an, D, wt, D, mt * 128, nt * 128); } }
  for (int tile = vbid(bid, nb); tile < mtn * NTN; tile += nb) {
    int mt, nt; tile_of(tile, NTN, mt, nt);
    f32x4 acc[4][4]; ZERO_ACC(acc);
    gemm_mainloop(G_ARGS, an, D, wt, D, D / 64, mt * 128, nt * 128, acc, smem);
    if (tile + nb < mtn * NTN) { int mt2, nt2; tile_of(tile + nb, NTN, mt2, nt2); gemm_prefetch(G_ARGS, an, D, wt, D, mt2 * 128, nt2 * 128); }
    const int tid = tidx(), lane = tid & 63, wid = tid >> 6, wr = wid >> 1, wc = wid & 1, fr = lane & 15, fq = lane >> 4;
#pragma unroll
    for (int m = 0; m < 4; ++m)
#pragma unroll
      for (int n = 0; n < 2; ++n) {
        float o[4];
#pragma unroll
        for (int r = 0; r < 4; ++r) o[r] = siluf(acc[m][n][r]) * acc[m][n + 2][r];
        uint2 v; v.x = pk2(o[0], o[1]); v.y = pk2(o[2], o[3]);
        *(uint2*)(smem + (wr * 64 + 16 * m + fr) * ST16 + (wc * 32 + 16 * n + 4 * fq) * 2) = v;
      }
    __syncthreads();
    const unsigned rbase = mt * 128, cbase = nt * 64;
#pragma unroll
    for (int i = 0; i < 4; ++i) {
      const unsigned id = tid + 256 * i, row = id >> 3, ch = id & 7;
      const uint4 v = *(const uint4*)(smem + row * ST16 + ch * 16);
      *(uint4*)(h + bko(rbase + row, cbase + ch * 8, DFF / 64)) = v;
    }
    __syncthreads();
  }
}

DI void phase_gemm_resid(const Params& p, int mtn, const u16* a, int K, const u16* wt, const float* mods_l, int gate_idx, float coef, bool from_input, char* smem, int bid, int nb) {
  constexpr int NTN = D / 128;
  G_DECL;
  { int tile = vbid(bid, nb); if (tile < mtn * NTN) { int mt, nt; tile_of(tile, NTN, mt, nt); gemm_prefetch(G_ARGS, a, K, wt, K, mt * 128, nt * 128); } }
  for (int tile = vbid(bid, nb); tile < mtn * NTN; tile += nb) {
    int mt, nt; tile_of(tile, NTN, mt, nt);
    f32x4 acc[4][4]; ZERO_ACC(acc);
    gemm_mainloop(G_ARGS, a, K, wt, K, K / 64, mt * 128, nt * 128, acc, smem);
    if (tile + nb < mtn * NTN) { int mt2, nt2; tile_of(tile + nb, NTN, mt2, nt2); gemm_prefetch(G_ARGS, a, K, wt, K, mt2 * 128, nt2 * 128); }
    const int tid = tidx(), lane = tid & 63, wid = tid >> 6, wr = wid >> 1, wc = wid & 1, fr = lane & 15, fq = lane >> 4;
    stage_f32(acc, smem, wr, wc, fr, fq);
    __syncthreads();
    const int r0 = mt * 128;
    const float* md = mods_l + (size_t)modrow(r0) * (NMOD * D) + gate_idx * D + nt * 128;
    float* xb = xptr(p, r0) + nt * 128;
    const float* xr = from_input ? xin_ptr(p, r0) + nt * 128 : xb;
    const unsigned ch = tid & 31;
    const float4 g4 = *(const float4*)(md + ch * 4);
#pragma unroll 4
    for (int i = 0; i < 16; ++i) {
      const unsigned row = (tid >> 5) + 8 * i;
      const float4 v = *(const float4*)(smem + row * ST32 + ch * 16);
      float4* xp = (float4*)(xb + row * (unsigned)D + ch * 4);
      float4 x = *(const float4*)(xr + row * (unsigned)D + ch * 4);
      x.x += coef * g4.x * v.x; x.y += coef * g4.y * v.y; x.z += coef * g4.z * v.z; x.w += coef * g4.w * v.w;
      *xp = x;
    }
    __syncthreads();
  }
}

DI void phase_inproj(const Params& p, int l, const u16* an, const u16* wt, char* smem, int bid, int nb) {
  constexpr int NTN = ZW / 128;
  char* ws = p.ws;
  G_DECL;
  { int tile = vbid(bid, nb); if (tile < MT * NTN) { int mt, nt; tile_of(tile, NTN, mt, nt); gemm_prefetch(G_ARGS, an, D, wt, D, mt * 128, nt * 128); } }
  for (int tile = vbid(bid, nb); tile < MT * NTN; tile += nb) {
    int mt, nt; tile_of(tile, NTN, mt, nt);
    f32x4 acc[4][4]; ZERO_ACC(acc);
    gemm_mainloop(G_ARGS, an, D, wt, D, D / 64, mt * 128, nt * 128, acc, smem);
    if (tile + nb < MT * NTN) { int mt2, nt2; tile_of(tile + nb, NTN, mt2, nt2); gemm_prefetch(G_ARGS, an, D, wt, D, mt2 * 128, nt2 * 128); }
    const int tid = tidx(), lane = tid & 63, wid = tid >> 6, wr = wid >> 1, wc = wid & 1, fr = lane & 15, fq = lane >> 4;
    if (nt == 37) {
      if (wc == 0) {
        u16* zkr = (u16*)(ws + OFF_ZKR);
#pragma unroll
        for (int m = 0; m < 4; ++m)
#pragma unroll
          for (int n = 0; n < 4; ++n) {
            const unsigned row = mt * 128 + wr * 64 + 16 * m + fr;
            uint2 v; v.x = pk2(acc[m][n][0], acc[m][n][1]); v.y = pk2(acc[m][n][2], acc[m][n][3]);
            *(uint2*)(zkr + row * 64u + 16 * n + 4 * fq) = v;
          }
      } else {
        float* zg = (float*)(ws + OFF_ZG);
        const float4 b4 = *(const float4*)(p.b_gate + l * 16 + 4 * fq);
#pragma unroll
        for (int m = 0; m < 4; ++m) {
          const unsigned row = mt * 128 + wr * 64 + 16 * m + fr;
          float4 v; v.x = acc[m][0][0] + b4.x; v.y = acc[m][0][1] + b4.y; v.z = acc[m][0][2] + b4.z; v.w = acc[m][0][3] + b4.w;
          *(float4*)(zg + row * 16u + 4 * fq) = v;
        }
      }
      continue;
    }
    if (nt >= 32 && nt < 37) {
      const bool isq = nt < 35;
      const float* gv = isq ? p.g_qa + l * 384 + (nt - 32) * 128 : p.g_kva + l * 256 + (nt - 35) * 128;
      float* ss2 = (float*)(ws + OFF_SS2);
      const int slot = isq ? (nt - 32) * 2 + wc : 8 + (nt - 35) * 2 + wc;
#pragma unroll
      for (int m = 0; m < 4; ++m) {
        float ssum = 0.f;
#pragma unroll
        for (int n = 0; n < 4; ++n) ssum += (acc[m][n][0] * acc[m][n][0] + acc[m][n][1] * acc[m][n][1]) + (acc[m][n][2] * acc[m][n][2] + acc[m][n][3] * acc[m][n][3]);
        ssum += __shfl_xor(ssum, 16); ssum += __shfl_xor(ssum, 32);
        if (fq == 0) ss2[(unsigned)(mt * 128 + wr * 64 + 16 * m + fr) * 16u + slot] = ssum;
      }
#pragma unroll
      for (int n = 0; n < 4; ++n) {
        const float4 g4 = *(const float4*)(gv + wc * 64 + 16 * n + 4 * fq);
#pragma unroll
        for (int m = 0; m < 4; ++m) { acc[m][n][0] *= g4.x; acc[m][n][1] *= g4.y; acc[m][n][2] *= g4.z; acc[m][n][3] *= g4.w; }
      }
    }
    stage_bf16(acc, smem, wr, wc, fr, fq);
    __syncthreads();
    const int c = nt * 128;
    u16* dst; unsigned ld, c0; unsigned nkb = 0;
    if (c < 4096) { dst = (u16*)(ws + OFF_ZQ) + (size_t)(c >> 10) * R * D; ld = D; c0 = c & 1023; }
    else if (c < 4480) { dst = (u16*)(ws + OFF_CQN); ld = 384; c0 = c - 4096; nkb = 6; }
    else if (c < 4736) { dst = (u16*)(ws + OFF_CKVN); ld = 256; c0 = c - 4480; nkb = 4; }
    else { dst = (u16*)(ws + OFF_ZBR); ld = 2048; c0 = c - 4864; }
    const unsigned rbase = mt * 128;
#pragma unroll
    for (int i = 0; i < 8; ++i) {
      const unsigned id = tid + 256 * i, row = id >> 4, ch = id & 15;
      const uint4 v = *(const uint4*)(smem + row * ST16 + ch * 16);
      *(uint4*)(dst + (nkb ? bko(rbase + row, c0 + ch * 8, nkb) : (rbase + row) * ld + c0 + ch * 8)) = v;
    }
    __syncthreads();
  }
}

DI void phase_prep(const Params& p, int l, int bid, int nb) {
  const int tid_ = tidx(), lane = tid_ & 63, wid = tid_ >> 6;
  char* ws = p.ws;
  const u16* zq = (const u16*)(ws + OFF_ZQ); const u16* zk = (const u16*)(ws + OFF_ZK);
  u16* qc = (u16*)(ws + OFF_AN); u16* kc = (u16*)(ws + OFF_KC);
  const float* wcv = p.w_conv + (size_t)l * 3 * 2048;
  const float2* tab = (const float2*)(ws + OFF_ROPE);
  for (int r = bid * 4 + wid; r < R; r += nb * 4) {
    int t, T;
    if (r < RL) { t = r & 4095; T = SEQ; } else { t = (r - RL) & 255; T = CTX; }
    const bool hp = t > 0, hn = t < T - 1;
#pragma unroll
    for (int c4 = 0; c4 < 4; ++c4) {
      const int ch = c4 * 512 + lane * 8;
      const bool isq = ch < 1024;
      const u16* src = isq ? zq : zk;
      const int cc = isq ? ch : ch - 1024;
      const uint4 zero = make_uint4(0, 0, 0, 0);
      const uint4 vc = *(const uint4*)(src + (size_t)r * D + cc);
      const uint4 vp = hp ? *(const uint4*)(src + (size_t)(r - 1) * D + cc) : zero;
      const uint4 vn = hn ? *(const uint4*)(src + (size_t)(r + 1) * D + cc) : zero;
      const unsigned pc[4] = {vc.x, vc.y, vc.z, vc.w}, pp[4] = {vp.x, vp.y, vp.z, vp.w}, pn[4] = {vn.x, vn.y, vn.z, vn.w};
      float o[8];
#pragma unroll
      for (int e = 0; e < 8; ++e) {
        const int sh = (e & 1) * 16;
        const float xc = bf2f((u16)(pc[e >> 1] >> sh)), xp = bf2f((u16)(pp[e >> 1] >> sh)), xn = bf2f((u16)(pn[e >> 1] >> sh));
        const float w0 = wcv[ch + e], w1 = wcv[2048 + ch + e], w2 = wcv[4096 + ch + e];
        float y = siluf(xp * w0 + xc * w1 + xn * w2);
        o[e] = isq ? y * 0.0625f : y;
      }
      uint4 ov; ov.x = pk2(o[0], o[1]); ov.y = pk2(o[2], o[3]); ov.z = pk2(o[4], o[5]); ov.w = pk2(o[6], o[7]);
      *(uint4*)((isq ? qc : kc) + (size_t)r * D + cc) = ov;
    }
    {
      const float v = bf2f(((const u16*)(ws + OFF_ZKR))[(size_t)r * 64 + lane]);
      const float pv = __shfl_xor(v, 1);
      float o = v;
      if (r < RL) {
        const float2 cs = tab[t * 32 + (lane >> 1)];
        o = (lane & 1) ? (pv * cs.y + v * cs.x) : (v * cs.x - pv * cs.y);
      }
      ((u16*)(ws + OFF_KROPE))[(size_t)r * 64 + lane] = f2bf(o);
    }
  }
  {
    const float* zg = (const float*)(ws + OFF_ZG);
    for (int item = bid * 4 + wid; item < 32 * NCH; item += nb * 4) {
      const int stream = item / NCH, n = item - stream * NCH;
      const int b = stream >> 3, hd = (stream >> 1) & 3, dir = stream & 1;
      int base, T, cc;
      if (n < 4) { base = RL + b * CTX; T = CTX; cc = n; } else { base = b * SEQ; T = SEQ; cc = n - 4; }
      const int pos = cc * 64 + lane;
      const int row = base + (dir ? T - 1 - pos : pos);
      const float ig = zg[(size_t)row * 16 + dir * 8 + hd];
      const float fg = zg[(size_t)row * 16 + dir * 8 + 4 + hd];
      const float lf = fminf(fg, 0.f) - log1pf(__expf(-fabsf(fg)));
      float bc = lf;
#pragma unroll
      for (int d = 1; d < 64; d <<= 1) { const float tt = __shfl_up(bc, d); if (lane >= d) bc += tt; }
      const float bL = __shfl(bc, 63);
      const float wv = ig - bc;
      float pm = wv;
#pragma unroll
      for (int d = 1; d < 64; d <<= 1) { const float tt = __shfl_up(pm, d); if (lane >= d) pm = fmaxf(pm, tt); }
      const float endl = bL + wv;
      const float me = wave_max(endl);
      float* g = (float*)(ws + OFF_G) + ((size_t)stream * NCH + n) * 512;
      g[lane] = bc; g[64 + lane] = wv; g[128 + lane] = pm; g[192 + lane] = endl;
      if (lane == 0) { g[256] = bL; g[257] = me; }
    }
  }
}

DI void phase_upproj(const Params& p, const u16* wb, char* smem, int bid, int nb) {
  char* ws = p.ws;
  const float2* tab = (const float2*)(ws + OFF_ROPE);
  u16* qa = (u16*)(ws + OFF_H);
  u16* kv = (u16*)(ws + OFF_KV);
  constexpr int NQ = 12, NKV = 16;
  const int total = MT * (NQ + NKV);
  G_DECL;
#define UP_PREFETCH(T) { const int t_ = (T); if (t_ < MT * NQ) { int m_, n_; tile_of(t_, NQ, m_, n_); gemm_prefetch(G_ARGS, (const u16*)(ws + OFF_CQN), 384, wb + WB_UQ, 384, m_ * 128, n_ * 128); } \
    else if (t_ < total) { int m_, n_; tile_of(t_ - MT * NQ, NKV, m_, n_); gemm_prefetch(G_ARGS, (const u16*)(ws + OFF_CKVN), 256, wb + WB_UKV, 256, m_ * 128, n_ * 128); } }
  for (int tile = vbid(bid, nb); tile < total; tile += nb) {
    const bool isq = tile < MT * NQ;
    int mt, nt;
    f32x4 acc[4][4]; ZERO_ACC(acc);
    UP_PREFETCH(tile)
    if (isq) { tile_of(tile, NQ, mt, nt); gemm_mainloop(G_ARGS, (const u16*)(ws + OFF_CQN), 384, wb + WB_UQ, 384, 6, mt * 128, nt * 128, acc, smem); }
    else { tile_of(tile - MT * NQ, NKV, mt, nt); gemm_mainloop(G_ARGS, (const u16*)(ws + OFF_CKVN), 256, wb + WB_UKV, 256, 4, mt * 128, nt * 128, acc, smem); }
    const int tid = tidx(), lane = tid & 63, wid = tid >> 6, wr = wid >> 1, wc = wid & 1, fr = lane & 15, fq = lane >> 4;
    {
      const float* ss2 = (const float*)(ws + OFF_SS2);
#pragma unroll
      for (int m = 0; m < 4; ++m) {
        const float* sp = ss2 + (unsigned)(mt * 128 + wr * 64 + 16 * m + fr) * 16u;
        float rstd;
        if (isq) { const float4 a = *(const float4*)sp; const float2 b = *(const float2*)(sp + 4); rstd = rsqrtf((((a.x + a.y) + (a.z + a.w)) + (b.x + b.y)) * (1.f / 384.f) + EPS); }
        else { const float4 a = *(const float4*)(sp + 8); rstd = rsqrtf(((a.x + a.y) + (a.z + a.w)) * (1.f / 256.f) + EPS); }
#pragma unroll
        for (int n = 0; n < 4; ++n) { acc[m][n][0] *= rstd; acc[m][n][1] *= rstd; acc[m][n][2] *= rstd; acc[m][n][3] *= rstd; }
      }
    }
    stage_bf16(acc, smem, wr, wc, fr, fq);
    __syncthreads();
    const unsigned rbase = mt * 128;
    if (isq) {
#pragma unroll
      for (int i = 0; i < 8; ++i) {
        const unsigned id = tid + 256 * i, row = id >> 4, ch = id & 15;
        uint4 v = *(const uint4*)(smem + row * ST16 + ch * 16);
        const unsigned col = nt * 128 + ch * 8, d0 = col % 192u, grow = rbase + row;
        if (d0 >= 128u && grow < (unsigned)RL) {
          const float4* tp = (const float4*)(tab + (grow & 4095u) * 32u + ((d0 - 128u) >> 1));
          const float4 t0 = tp[0], t1 = tp[1];
          float x0, x1;
          x0 = bf2f((u16)(v.x & 0xffff)); x1 = bf2f((u16)(v.x >> 16)); v.x = pk2(x0 * t0.x - x1 * t0.y, x0 * t0.y + x1 * t0.x);
          x0 = bf2f((u16)(v.y & 0xffff)); x1 = bf2f((u16)(v.y >> 16)); v.y = pk2(x0 * t0.z - x1 * t0.w, x0 * t0.w + x1 * t0.z);
          x0 = bf2f((u16)(v.z & 0xffff)); x1 = bf2f((u16)(v.z >> 16)); v.z = pk2(x0 * t1.x - x1 * t1.y, x0 * t1.y + x1 * t1.x);
          x0 = bf2f((u16)(v.w & 0xffff)); x1 = bf2f((u16)(v.w >> 16)); v.w = pk2(x0 * t1.z - x1 * t1.w, x0 * t1.w + x1 * t1.z);
        }
        *(uint4*)(qa + grow * 1536u + col) = v;
      }
    } else {
#pragma unroll
      for (int i = 0; i < 8; ++i) {
        const unsigned id = tid + 256 * i, row = id >> 4, ch = id & 15;
        const uint4 v = *(const uint4*)(smem + row * ST16 + ch * 16);
        *(uint4*)(kv + (rbase + row) * 2048u + nt * 128 + ch * 8) = v;
      }
    }
    __syncthreads();
  }
#undef UP_PREFETCH
}

constexpr int AKS = 400;
constexpr int AVS = 320;
DI void attn_task(const Params& p, int b, int h, int qrow0, int nkt, bool with_latent, char* smem) {
  const int tid = tidx(), lane = tid & 63, wid = tid >> 6, l31 = lane & 31, h2 = lane >> 5;
  char* ws = p.ws;
  const u16* qa = (const u16*)(ws + OFF_H);
  const u16* kvb = (const u16*)(ws + OFF_KV);
  const u16* krp = (const u16*)(ws + OFF_KROPE);
  u16* ao = (u16*)(ws + OFF_H) + (size_t)R * 1536;
  char* Ks = smem; char* Vs = smem + 64 * AKS;
  bf16x8 qf[12];
  {
    const u16* qp = qa + (size_t)(qrow0 + wid * 32 + l31) * 1536 + h * 192 + h2 * 8;
#pragma unroll
    for (int st = 0; st < 12; ++st) qf[st] = *(const bf16x8*)(qp + st * 16);
  }
  uint4 kreg0, kreg1, kreg2, kreg3, kreg4, kreg5, vreg0, vreg1, vreg2, vreg3;
#define KEY_ROW(kt, i) ((kt) < 4 ? (RL + b * CTX + (kt) * 64 + (i)) : (b * SEQ + ((kt) - 4) * 64 + (i)))
#define ATT_KL(kt, i) { const int id = tid + 256 * i, row = id / 24, ch = id - row * 24; const int kr = KEY_ROW(kt, row); \
    const u16* src = ch < 16 ? (kvb + (size_t)kr * 2048 + h * 256 + ch * 8) : (krp + (size_t)kr * 64 + (ch - 16) * 8); kreg##i = *(const uint4*)src; }
#define ATT_VL(kt, i) { const int id = tid + 256 * i, row = id >> 4, ch = id & 15; const int kr = KEY_ROW(kt, row); \
    vreg##i = *(const uint4*)(kvb + (size_t)kr * 2048 + h * 256 + 128 + ch * 8); }
#define ATT_GLOADK(kt) ATT_KL(kt, 0) ATT_KL(kt, 1) ATT_KL(kt, 2) ATT_KL(kt, 3) ATT_KL(kt, 4) ATT_KL(kt, 5)
#define ATT_GLOADV(kt) ATT_VL(kt, 0) ATT_VL(kt, 1) ATT_VL(kt, 2) ATT_VL(kt, 3)
#define ATT_GLOAD(kt) ATT_GLOADK(kt) ATT_GLOADV(kt)
#define ATT_KS(i) { const int id = tid + 256 * i, row = id / 24, ch = id - row * 24; *(uint4*)(Ks + row * AKS + ch * 16) = kreg##i; }
#define ATT_VS(i) { const int id = tid + 256 * i, row = id >> 4, ch = id & 15; *(uint4*)(Vs + row * AVS + ch * 16) = vreg##i; }
#define ATT_SSTORE() ATT_KS(0) ATT_KS(1) ATT_KS(2) ATT_KS(3) ATT_KS(4) ATT_KS(5) ATT_VS(0) ATT_VS(1) ATT_VS(2) ATT_VS(3)
  f32x16 o[4];
#pragma unroll
  for (int n = 0; n < 4; ++n)
#pragma unroll
    for (int i = 0; i < 16; ++i) o[n][i] = 0.f;
  float mrun = -1e30f, lrun = 0.f;
  const float sc = 0.07216878364870322f * 1.4426950408889634f;
  const int i16 = lane & 15, tq = i16 >> 2, tp = i16 & 3, blk = (lane >> 4) & 1;
  ATT_GLOAD(0)
  __syncthreads();
  ATT_SSTORE()
  __syncthreads();
  for (int kt = 0; kt < nkt; ++kt) {
    if (kt + 1 < nkt) { ATT_GLOADK(kt + 1) }
    f32x16 s0, s1;
#pragma unroll
    for (int i = 0; i < 16; ++i) { s0[i] = 0.f; s1[i] = 0.f; }
#pragma unroll
    for (int st = 0; st < 12; ++st) {
      const bf16x8 a0 = *(const bf16x8*)(Ks + l31 * AKS + st * 32 + h2 * 16);
      const bf16x8 a1 = *(const bf16x8*)(Ks + (32 + l31) * AKS + st * 32 + h2 * 16);
      s0 = MFMA32(a0, qf[st], s0);
      s1 = MFMA32(a1, qf[st], s1);
    }
    __builtin_amdgcn_sched_group_barrier(0x100, 4, 0);
#pragma unroll
    for (int i = 0; i < 10; ++i) { __builtin_amdgcn_sched_group_barrier(0x008, 2, 0); __builtin_amdgcn_sched_group_barrier(0x100, 2, 0); }
    __builtin_amdgcn_sched_group_barrier(0x008, 4, 0);
    __builtin_amdgcn_sched_barrier(0);
    float mx = s0[0];
#pragma unroll
    for (int i = 0; i < 16; ++i) { mx = fmaxf(mx, s0[i]); mx = fmaxf(mx, s1[i]); }
    mx = fmaxf(mx, __shfl_xor(mx, 32));
    const float mnew = fmaxf(mrun, mx * sc);
    const float alpha = __builtin_amdgcn_exp2f(mrun - mnew);
    mrun = mnew;
    float ls = 0.f;
#pragma unroll
    for (int i = 0; i < 16; ++i) { s0[i] = __builtin_amdgcn_exp2f(s0[i] * sc - mnew); s1[i] = __builtin_amdgcn_exp2f(s1[i] * sc - mnew); ls += s0[i] + s1[i]; }
    lrun = lrun * alpha + ls;
    if (__any(alpha != 1.f)) {
#pragma unroll
      for (int n = 0; n < 4; ++n)
#pragma unroll
        for (int i = 0; i < 16; ++i) o[n][i] *= alpha;
    }
    bf16x8 pbv[4];
#define ATT_PACK(SV, HH) \
    _Pragma("unroll") for (int s = 0; s < 2; ++s) { \
      u32x4 pu; \
      pu[0] = pk2(SV[8 * s + 0], SV[8 * s + 1]); pu[1] = pk2(SV[8 * s + 2], SV[8 * s + 3]); \
      pu[2] = pk2(SV[8 * s + 4], SV[8 * s + 5]); pu[3] = pk2(SV[8 * s + 6], SV[8 * s + 7]); \
      pbv[2 * HH + s] = __builtin_bit_cast(bf16x8, pu); \
    }
    ATT_PACK(s0, 0)
    ATT_PACK(s1, 1)
#undef ATT_PACK
    if (kt + 1 < nkt) { ATT_GLOADV(kt + 1) }
#pragma unroll
    for (int hs = 0; hs < 4; ++hs) {
      const char* vlo = Vs + (16 * hs + 4 * h2 + tq) * AVS + (16 * blk) * 2 + 8 * tp;
#pragma unroll
      for (int n = 0; n < 4; ++n) {
        const bf16x8 va = tr8(vlo + n * 64, vlo + n * 64 + 8 * AVS);
        o[n] = MFMA32(va, pbv[hs], o[n]);
      }
    }
    __syncthreads();
    if (kt + 1 < nkt) { ATT_SSTORE() }
    __syncthreads();
  }
  const float ltot = lrun + __shfl_xor(lrun, 32);
  const float inv = 1.f / ltot;
  const unsigned orow = qrow0 + wid * 32 + l31;
#pragma unroll
  for (int n = 0; n < 4; ++n)
#pragma unroll
    for (int g = 0; g < 4; ++g) {
      uint2 w; w.x = pk2(o[n][4 * g] * inv, o[n][4 * g + 1] * inv); w.y = pk2(o[n][4 * g + 2] * inv, o[n][4 * g + 3] * inv);
      *(uint2*)(ao + bko(orow, h * 128 + 32 * n + 8 * g + 4 * h2, D / 64)) = w;
    }
}

constexpr int MKS = 528;
constexpr int MVS = 112;
constexpr int M_CT = 64 * MKS;
constexpr int M_VS = M_CT + 48 * MKS;
constexpr int M_VW = M_VS + 64 * MVS;
constexpr int M_GS = 73728;
constexpr int M_MS = M_GS + 1536;
DI void mlstm_task(const Params& p, int task, char* smem) {
  const int tid = tidx(), lane = tid & 63, w = tid >> 6, fr = lane & 15, fq = lane >> 4, tq = fr >> 2, tp = fr & 3;
  const int stream = task >> 3, c = task & 7, b = stream >> 3, hd = (stream >> 1) & 3, dir = stream & 1;
  char* ws = p.ws;
  const u16* qc = (const u16*)(ws + OFF_AN); const u16* kc = (const u16*)(ws + OFF_KC); const u16* zv = (const u16*)(ws + OFF_ZV);
  const float* G = (const float*)(ws + OFF_G) + (size_t)stream * NCH * 512;
  _Float16* hout = (_Float16*)(ws + (dir ? OFF_ZK : OFF_ZQ));
  char* Ks = smem; char* Ct = smem + M_CT; char* Vs = smem + M_VS; char* Vw = smem + M_VW;
#define ROW_OF(n, pos) ((n) < 4 ? (RL + b * CTX + (dir ? CTX - 1 - ((n) * 64 + (pos)) : ((n) * 64 + (pos)))) : (b * SEQ + (dir ? SEQ - 1 - (((n) - 4) * 64 + (pos)) : (((n) - 4) * 64 + (pos)))))
  __syncthreads();
  for (int i = tid; i < 48 * MKS / 16; i += 256) ((uint4*)Ct)[i] = make_uint4(0, 0, 0, 0);
  f32x4 cacc[4][3];
#pragma unroll
  for (int kt = 0; kt < 4; ++kt)
#pragma unroll
    for (int vt = 0; vt < 3; ++vt) cacc[kt][vt] = f32x4{0.f, 0.f, 0.f, 0.f};
  uint4 kreg0, kreg1, kreg2, kreg3, kreg4, kreg5, kreg6, kreg7; uint4 vreg; float wreg; float4 greg = make_float4(0.f, 0.f, 0.f, 0.f);
#define M_KL(n, i) { const int id = tid + 256 * i, row = id >> 5, ch = id & 31; kreg##i = *(const uint4*)(kc + (size_t)ROW_OF(n, row) * D + hd * 256 + ch * 8); }
#define M_GLOAD(n) { M_KL(n, 0) M_KL(n, 1) M_KL(n, 2) M_KL(n, 3) M_KL(n, 4) M_KL(n, 5) M_KL(n, 6) M_KL(n, 7) \
    const int row_ = tid >> 2, part_ = tid & 3; \
    vreg = *(const uint4*)(zv + (size_t)ROW_OF(n, row_) * D + hd * 256 + c * 32 + part_ * 8); \
    wreg = G[(size_t)(n) * 512 + 192 + row_]; \
    if (tid < 64) { greg.x = G[(size_t)(n) * 512 + tid]; greg.y = G[(size_t)(n) * 512 + 64 + tid]; greg.z = G[(size_t)(n) * 512 + 128 + tid]; greg.w = G[(size_t)(n) * 512 + 192 + tid]; } }
#define M_KS(i) { const int id = tid + 256 * i, row = id >> 5, ch = id & 31; *(uint4*)(Ks + row * MKS + ch * 16) = kreg##i; }
#define M_SSTORE(n) { M_KS(0) M_KS(1) M_KS(2) M_KS(3) M_KS(4) M_KS(5) M_KS(6) M_KS(7) \
    const int row = tid >> 2, part = tid & 3; \
    const float mp_ = ((const float*)(smem + M_MS))[136 + (n)], mn_ = ((const float*)(smem + M_MS))[204 + (n)]; \
    if (tid < 64) { float* gs_ = (float*)(smem + M_GS); const float mj_ = fmaxf(greg.x + mp_, greg.x + greg.z); \
      gs_[tid] = greg.x - mj_; gs_[64 + tid] = greg.y; gs_[128 + tid] = __expf(greg.x + mp_ - mj_); gs_[192 + tid] = __expf(-mj_); gs_[256 + tid] = __expf(greg.w - mn_); \
      if (tid == 0) gs_[320] = __expf(((const float*)(smem + M_MS))[(n)] + mp_ - mn_); } \
    wreg = __expf(wreg - mn_); \
    *(uint4*)(Vs + row * MVS + part * 16) = vreg; \
    uint4 wv; \
    wv.x = pk2(bf2f((u16)(vreg.x & 0xffff)) * wreg, bf2f((u16)(vreg.x >> 16)) * wreg); \
    wv.y = pk2(bf2f((u16)(vreg.y & 0xffff)) * wreg, bf2f((u16)(vreg.y >> 16)) * wreg); \
    wv.z = pk2(bf2f((u16)(vreg.z & 0xffff)) * wreg, bf2f((u16)(vreg.z >> 16)) * wreg); \
    wv.w = pk2(bf2f((u16)(vreg.w & 0xffff)) * wreg, bf2f((u16)(vreg.w >> 16)) * wreg); \
    *(uint4*)(Vw + row * MVS + part * 16) = wv; \
    if (part == 0) { \
      *(uint4*)(Vs + row * MVS + 64) = make_uint4(0x3f80u, 0, 0, 0); \
      *(uint4*)(Vs + row * MVS + 80) = make_uint4(0, 0, 0, 0); \
      *(uint4*)(Vw + row * MVS + 64) = make_uint4((unsigned)f2bf(wreg), 0, 0, 0); \
      *(uint4*)(Vw + row * MVS + 80) = make_uint4(0, 0, 0, 0); \
    } }
#define M_QLOAD(n) { \
    const u16* qp = qc + (size_t)ROW_OF(n, 16 * w + fr) * D + hd * 256 + fq * 8; \
    _Pragma("unroll") for (int ks = 0; ks < 8; ++ks) qf[ks] = *(const bf16x8*)(qp + ks * 32); }
  bf16x8 qf[8];
  M_GLOAD(0) M_QLOAD(0)
  {
    float* ms = (float*)(smem + M_MS);
    if (tid < NCH) { ms[tid] = G[(size_t)tid * 512 + 256]; ms[68 + tid] = G[(size_t)tid * 512 + 257]; }
    __syncthreads();
    if (tid == 0) { float m = 0.f; for (int i = 0; i < NCH; ++i) { const float mn = fmaxf(ms[i] + m, ms[68 + i]); ms[136 + i] = m; ms[204 + i] = mn; m = mn; } }
    __syncthreads();
  }
  M_SSTORE(0)
  __syncthreads();
  for (int n = 0; n < NCH; ++n) {
    const bool more = n + 1 < NCH;
    if (more) M_GLOAD(n + 1)
    const float* g = (const float*)(smem + M_GS);
    const int jpos = 16 * w + fr;
    const float u_j = g[jpos], e_j = g[128 + jpos], rd_j = g[192 + jpos];
    const float a_state = g[320];
    f32x4 xs[4];
#pragma unroll
    for (int st = 0; st < 4; ++st) {
      xs[st] = f32x4{0.f, 0.f, 0.f, 0.f};
      if (st <= w) {
#pragma unroll
        for (int ks = 0; ks < 8; ++ks) {
          const bf16x8 a = *(const bf16x8*)(Ks + (16 * st + fr) * MKS + ks * 64 + fq * 16);
          xs[st] = MFMA16(a, qf[ks], xs[st]);
        }
        const float4 wv4 = *(const float4*)(g + 64 + 16 * st + 4 * fq);
        const int sb = 16 * st + 4 * fq;
        xs[st][0] *= (sb + 0 <= jpos) ? __expf(u_j + wv4.x) : 0.f;
        xs[st][1] *= (sb + 1 <= jpos) ? __expf(u_j + wv4.y) : 0.f;
        xs[st][2] *= (sb + 2 <= jpos) ? __expf(u_j + wv4.z) : 0.f;
        xs[st][3] *= (sb + 3 <= jpos) ? __expf(u_j + wv4.w) : 0.f;
      }
    }
    bf16x8 pb[2];
#pragma unroll
    for (int u = 0; u < 2; ++u) {
      u32x4 pu;
      pu[0] = pk2(xs[2 * u][0], xs[2 * u][1]); pu[1] = pk2(xs[2 * u][2], xs[2 * u][3]);
      pu[2] = pk2(xs[2 * u + 1][0], xs[2 * u + 1][1]); pu[3] = pk2(xs[2 * u + 1][2], xs[2 * u + 1][3]);
      pb[u] = __builtin_bit_cast(bf16x8, pu);
    }
    f32x4 num[3];
#pragma unroll
    for (int vt = 0; vt < 3; ++vt) {
      f32x4 n1 = {0.f, 0.f, 0.f, 0.f}, n2 = {0.f, 0.f, 0.f, 0.f};
#pragma unroll
      for (int u = 0; u < 2; ++u) {
        const char* lo = Vs + (32 * u + 4 * fq + tq) * MVS + (16 * vt) * 2 + 8 * tp;
        const bf16x8 a = tr8(lo, lo + 16 * MVS);
        n1 = MFMA16(a, pb[u], n1);
      }
#pragma unroll
      for (int ks = 0; ks < 8; ++ks) {
        const bf16x8 a = *(const bf16x8*)(Ct + (16 * vt + fr) * MKS + ks * 64 + fq * 16);
        n2 = MFMA16(a, qf[ks], n2);
      }
#pragma unroll
      for (int r = 0; r < 4; ++r) num[vt][r] = n1[r] + e_j * n2[r];
    }
    const float den = __shfl(num[2][0], fr);
    const float inv = 1.f / fmaxf(fabsf(den), rd_j);
    {
      _Float16* hp = hout + (size_t)ROW_OF(n, jpos) * D + hd * 256 + c * 32 + 4 * fq;
#pragma unroll
      for (int vt = 0; vt < 2; ++vt) {
        h16x4 hv;
#pragma unroll
        for (int r = 0; r < 4; ++r) hv[r] = (_Float16)(num[vt][r] * inv);
        *(h16x4*)(hp + 16 * vt) = hv;
      }
    }
    if (more) M_QLOAD(n + 1)
    __syncthreads();
#pragma unroll
    for (int kt = 0; kt < 4; ++kt)
#pragma unroll
      for (int vt = 0; vt < 3; ++vt) cacc[kt][vt] *= a_state;
#pragma unroll
    for (int u = 0; u < 2; ++u) {
      bf16x8 bfr[3];
#pragma unroll
      for (int vt = 0; vt < 3; ++vt) {
        const char* lo = Vw + (32 * u + 8 * fq + tq) * MVS + (16 * vt) * 2 + 8 * tp;
        bfr[vt] = tr8(lo, lo + 4 * MVS);
      }
#pragma unroll
      for (int kt = 0; kt < 4; ++kt) {
        const char* lo = Ks + (32 * u + 8 * fq + tq) * MKS + (64 * w + 16 * kt) * 2 + 8 * tp;
        const bf16x8 af = tr8(lo, lo + 4 * MKS);
#pragma unroll
        for (int vt = 0; vt < 3; ++vt) cacc[kt][vt] = MFMA16(af, bfr[vt], cacc[kt][vt]);
      }
    }
#pragma unroll
    for (int kt = 0; kt < 4; ++kt)
#pragma unroll
      for (int vt = 0; vt < 3; ++vt) {
        uint2 o2; o2.x = pk2(cacc[kt][vt][0], cacc[kt][vt][1]); o2.y = pk2(cacc[kt][vt][2], cacc[kt][vt][3]);
        *(uint2*)(Ct + (16 * vt + fr) * MKS + (64 * w + 16 * kt + 4 * fq) * 2) = o2;
      }
    __syncthreads();
    if (more) M_SSTORE(n + 1)
    __syncthreads();
  }
}

DI int q_pull(int* head, volatile LAS unsigned* s_task_p) {
  __syncthreads();
  if (threadIdx.x == 0) *s_task_p = (unsigned)atomicAdd(head, 1);
  __syncthreads();
  return (int)*s_task_p;
}
DI void phase_mix(const Params& p, int l, char* smem, volatile LAS unsigned* s_task_p, int bid, int nb) {
  int* C = (int*)(p.ws + OFF_CTR) + l * 16;
  const bool last = (l & 3) == NL - 1;
  const int per_g = last ? 32 : 34;
  const int n_cv = last ? 0 : NCONV;
  const int xcd = (int)(xb_xcc_id() & 7u);
  for (;;) { const int t = q_pull(C, s_task_p); if (t >= 256) break; mlstm_task(p, t, smem); }
  for (int j = 0; j < 8; ++j) {
    const int x = (xcd + j) & 7;
    for (;;) {
      const int e = q_pull(C + 1 + x, s_task_p);
      if (e >= 4 * per_g) break;
      const int gi = e / per_g, r = e - gi * per_g, g = x + 8 * gi, b = g >> 3, h = g & 7;
      if (r < 32) attn_task(p, b, h, b * SEQ + r * 128, 68, true, smem);
      else attn_task(p, b, h, RL + b * CTX + (r - 32) * 128, 4, false, smem);
    }
  }
  for (;;) { const int t = q_pull(C + 9, s_task_p); if (t >= n_cv) break; const int c0 = t * CONV_PER_TASK; convert_range(p, (l & 3) + 1, smem, c0, c0 + CONV_PER_TASK, 1); }
}

DI void phase_mout(const Params& p, int l, int bid, int nb) {
  const int tid_ = tidx(), lane = tid_ & 63, wid = tid_ >> 6;
  char* ws = p.ws;
  const _Float16* hf = (const _Float16*)(ws + OFF_ZQ); const _Float16* hb = (const _Float16*)(ws + OFF_ZK);
  const u16* zo = (const u16*)(ws + OFF_ZO);
  u16* hm = (u16*)(ws + OFF_KC);
  for (int r = bid * 4 + wid; r < R; r += nb * 4) {
#pragma unroll
    for (int hd = 0; hd < 4; ++hd) {
      const size_t off = (size_t)r * D + hd * 256 + lane * 4;
      const h16x4 a = *(const h16x4*)(hf + off), bb = *(const h16x4*)(hb + off);
      float v[4]; float ss = 0.f;
#pragma unroll
      for (int e = 0; e < 4; ++e) { v[e] = (float)a[e] + (float)bb[e]; ss += v[e] * v[e]; }
      ss = wave_sum(ss);
      const float rstd = rsqrtf(ss * (1.f / 256.f) + EPS);
      const uint2 z = *(const uint2*)(zo + off);
      const float4 g4 = *(const float4*)(p.g_mh + (size_t)l * D + hd * 256 + lane * 4);
      const float o0 = sigmf(bf2f((u16)(z.x & 0xffff))) * v[0] * rstd * g4.x;
      const float o1 = sigmf(bf2f((u16)(z.x >> 16))) * v[1] * rstd * g4.y;
      const float o2 = sigmf(bf2f((u16)(z.y & 0xffff))) * v[2] * rstd * g4.z;
      const float o3 = sigmf(bf2f((u16)(z.y >> 16))) * v[3] * rstd * g4.w;
      uint2 o; o.x = pk2(o0, o1); o.y = pk2(o2, o3);
      *(uint2*)(hm + bko(r, hd * 256 + lane * 4, D / 64)) = o;
    }
  }
}

DI void phase_merge(const Params& p, const u16* wb, int mtn, char* smem, int bid, int nb) {
  constexpr int NTN = D / 128;
  char* ws = p.ws;
  const u16* hm = (const u16*)(ws + OFF_KC);
  const u16* ao = (const u16*)(ws + OFF_H) + (size_t)R * 1536;
  const u16* zbr = (const u16*)(ws + OFF_ZBR);
  u16* tt = (u16*)(ws + OFF_AN);
  G_DECL;
  for (int tile = vbid(bid, nb); tile < mtn * NTN; tile += nb) {
    int mt, nt; tile_of(tile, NTN, mt, nt);
    f32x4 acc[4][4]; ZERO_ACC(acc);
    gemm_prefetch(G_ARGS, hm, D, wb + WB_BM, D, mt * 128, nt * 128);
    gemm_mainloop(G_ARGS, hm, D, wb + WB_BM, D, D / 64, mt * 128, nt * 128, acc, smem);
    const unsigned rbase = mt * 128;
    {
      const int tid = tidx(), lane = tid & 63, wid = tid >> 6, wr = wid >> 1, wc = wid & 1, fr = lane & 15, fq = lane >> 4;
      stage_bf16(acc, smem, wr, wc, fr, fq);
      __syncthreads();
#pragma unroll
      for (int i = 0; i < 8; ++i) {
        const unsigned id = tid + 256 * i, row = id >> 4, ch = id & 15;
        const uint4 a = *(const uint4*)(smem + row * ST16 + ch * 16);
        const unsigned grow = rbase + row, col = nt * 128 + ch * 8;
        const uint4 gm = *(const uint4*)(zbr + grow * 2048u + col);
        uint4 o;
#define MRG1(F) o.F = pk2(sigmf(bf2f((u16)(gm.F & 0xffff))) * bf2f((u16)(a.F & 0xffff)), sigmf(bf2f((u16)(gm.F >> 16))) * bf2f((u16)(a.F >> 16)));
        MRG1(x) MRG1(y) MRG1(z) MRG1(w)
#undef MRG1
        *(uint4*)(tt + bko(grow, col, D / 64)) = o;
      }
      __syncthreads();
    }
    ZERO_ACC(acc);
    gemm_prefetch(G_ARGS, ao, D, wb + WB_BA, D, mt * 128, nt * 128);
    gemm_mainloop(G_ARGS, ao, D, wb + WB_BA, D, D / 64, mt * 128, nt * 128, acc, smem);
    const int tid = tidx(), lane = tid & 63, wid = tid >> 6, wr = wid >> 1, wc = wid & 1, fr = lane & 15, fq = lane >> 4;
    stage_bf16(acc, smem, wr, wc, fr, fq);
    __syncthreads();
#pragma unroll
    for (int i = 0; i < 8; ++i) {
      const unsigned id = tid + 256 * i, row = id >> 4, ch = id & 15;
      const uint4 b = *(const uint4*)(smem + row * ST16 + ch * 16);
      const unsigned grow = rbase + row, col = nt * 128 + ch * 8;
      const uint4 a = *(const uint4*)(tt + bko(grow, col, D / 64));
      const uint4 ga = *(const uint4*)(zbr + grow * 2048u + 1024u + col);
      uint4 o;
#define MRG(F) { \
      const float o0 = bf2f((u16)(a.F & 0xffff)) + sigmf(bf2f((u16)(ga.F & 0xffff))) * bf2f((u16)(b.F & 0xffff)); \
      const float o1 = bf2f((u16)(a.F >> 16)) + sigmf(bf2f((u16)(ga.F >> 16))) * bf2f((u16)(b.F >> 16)); \
      o.F = pk2(o0, o1); }
      MRG(x) MRG(y) MRG(z) MRG(w)
#undef MRG
      *(uint4*)(tt + bko(grow, col, D / 64)) = o;
    }
    __syncthreads();
  }
}

__global__ void __launch_bounds__(256, 2) fwd_kernel(Params p) {
  extern __shared__ __attribute__((aligned(16))) char smem[];
  __shared__ __attribute__((aligned(16))) unsigned xbw[4];
  const int bid = blockIdx.x, nb = gridDim.x;
  char* ws = p.ws;
  u16* an = (u16*)(ws + OFF_AN);
  u16* hbuf = (u16*)(ws + OFF_H);
  if (threadIdx.x < 4) xbw[threadIdx.x] = 0u;
  __syncthreads();
  XcdBarrier xb = xcd_barrier_post((unsigned*)(ws + OFF_BAR), (volatile LAS unsigned*)xbw);
  for (int ph = p.ph_lo; ph < p.ph_hi; ++ph) {
    if (ph == NPH - 1) {
      phase_final(p, bid, nb);
    } else {
      const int l = ph / NPH_LAYER, k = ph - l * NPH_LAYER;
      if (k == 0 && l > 0) continue;
      if (k == 7) continue;
      const u16* wb = (const u16*)(ws + OFF_WB) + (size_t)(l & 1) * WB_END;
      const float* mods_l = (const float*)(ws + OFF_MODS) + (size_t)l * 5 * NMOD * D;
      const int mtl = (l == NL - 1) ? RL / 128 : MT;
      const int nrep = ((DUP_MASK >> k) & 1) ? 2 : 1;
      for (int rep = 0; rep < nrep; ++rep) {
      if (rep) xcd_barrier(xb);
      switch (k) {
        case 0:
          if (l == 0) {
            phase_init(p, smem, bid, nb);
            constexpr int NMODWG = NL * (NMOD * D / 128), CV_A = 10240;
            convert_range(p, 0, smem, bid, CV_A, nb);
            if (bid >= NMODWG && nb > NMODWG) convert_range(p, 0, smem, CV_A + (bid - NMODWG), CONV_TILES, nb - NMODWG);
            else if (nb <= NMODWG) convert_range(p, 0, smem, CV_A + bid, CONV_TILES, nb);
          } else phase_convert(p, l, smem, bid, nb);
          break;
        case 1: phase_norm(p, R, p.g_n1 + l * D, mods_l, 0, 1, an, l == 0, bid, nb); break;
        case 2: phase_ffn_up(p, MT, an, wb + WB_UP1, hbuf, smem, bid, nb); break;
        case 3: phase_gemm_resid(p, MT, hbuf, DFF, wb + WB_DN1, mods_l, 2, 0.5f, l == 0, smem, bid, nb); break;
        case 4: phase_norm(p, R, p.g_n2 + l * D, mods_l, 3, 4, an, false, bid, nb); break;
        case 5: phase_inproj(p, l, an, wb + WB_IN, smem, bid, nb); break;
        case 6: phase_prep(p, l, bid, nb); phase_upproj(p, wb, smem, bid, nb); break;
        case 7: phase_upproj(p, wb, smem, bid, nb); break;
        case 8: phase_mix(p, l + 4 * rep, smem, (volatile LAS unsigned*)&xbw[2], bid, nb); break;
        case 9: phase_mout(p, l, bid, nb); break;
        case 10: phase_merge(p, wb, mtl, smem, bid, nb); break;
        case 11: phase_gemm_resid(p, mtl, an, D, wb + WB_OUT, mods_l, 5, 1.0f, false, smem, bid, nb); break;
        case 12: phase_norm(p, mtl * 128, p.g_n3 + l * D, mods_l, 6, 7, an, false, bid, nb); break;
        case 13: phase_ffn_up(p, mtl, an, wb + WB_UP2, hbuf, smem, bid, nb); break;
        case 14: phase_gemm_resid(p, mtl, hbuf, DFF, wb + WB_DN2, mods_l, 8, 0.5f, false, smem, bid, nb); break;
      }
      }
    }
    if (ph + 1 < p.ph_hi) { if (ph == 0) cg::this_grid().sync(); else xcd_barrier(xb); }
  }
}

extern "C" void kernel_launch(void* const* d_in, const int* in_sizes, int n_in, void* d_out, int out_size, void* d_ws, size_t ws_size, hipStream_t stream) {
  static int grid = 0;
  if (grid == 0) {
    if (n_in != 25 || ws_size < WS_END) { fprintf(stderr, "kernel_launch: unexpected n_in %d or ws_size %zu (< %zu)\n", n_in, ws_size, (size_t)WS_END); grid = -1; return; }
    int dev = 0, cus = 0, per_cu = 0;
    hipGetDevice(&dev);
    hipDeviceGetAttribute(&cus, hipDeviceAttributeMultiprocessorCount, dev);
    hipFuncSetAttribute((const void*)fwd_kernel, hipFuncAttributeMaxDynamicSharedMemorySize, SMEM_BYTES);
    hipOccupancyMaxActiveBlocksPerMultiprocessor(&per_cu, (const void*)fwd_kernel, 256, SMEM_BYTES);
    if (per_cu < 1) per_cu = 1;
    if (per_cu > 2) per_cu = 2;
    grid = cus * per_cu;
    fprintf(stderr, "kernel_launch: grid %d (%d CUs x %d), ws need %zu have %zu\n", grid, cus, per_cu, (size_t)WS_END, ws_size);
  }
  if (grid < 0) return;
  Params p{};
  const float** f = (const float**)&p;
  for (int i = 0; i < 25; ++i) f[i] = (const float*)d_in[i];
  p.out = (float*)d_out; p.ws = (char*)d_ws;
  hipMemsetAsync((char*)d_ws + OFF_CTR, 0, (OFF_WB - OFF_CTR), stream);
#if ONE_LAUNCH
  p.ph_lo = 0; p.ph_hi = NPH;
  void* args[] = {&p};
  hipError_t e = hipLaunchCooperativeKernel((const void*)fwd_kernel, dim3(grid), dim3(256), args, SMEM_BYTES, stream);
  if (e != hipSuccess) fprintf(stderr, "cooperative launch failed: %s (grid %d)\n", hipGetErrorString(e), grid);
#else
  for (int ph = 0; ph < NPH; ++ph) {
    p.ph_lo = ph; p.ph_hi = ph + 1;
    hipLaunchKernelGGL(fwd_kernel, dim3(grid), dim3(256), SMEM_BYTES, stream, p);
  }
#endif
}
```

```cpp
#include <hip/hip_runtime.h>
#include <hip/hip_cooperative_groups.h>
#include <cstdio>
namespace cg = cooperative_groups;

#ifndef DUP_MASK
#define DUP_MASK 0
#endif
#ifndef ONE_LAUNCH
#define ONE_LAUNCH 1
#endif

typedef unsigned short u16;
typedef __attribute__((ext_vector_type(8))) short bf16x8;
typedef __attribute__((ext_vector_type(4))) short s16x4;
typedef __attribute__((ext_vector_type(4))) float f32x4;
typedef __attribute__((ext_vector_type(16))) float f32x16;
typedef __attribute__((ext_vector_type(4))) _Float16 h16x4;
typedef __attribute__((ext_vector_type(4))) unsigned u32x4;
#define DI __device__ __forceinline__
#define MFMA16(a, b, c) __builtin_amdgcn_mfma_f32_16x16x32_bf16((a), (b), (c), 0, 0, 0)
#define MFMA32(a, b, c) __builtin_amdgcn_mfma_f32_32x32x16_bf16((a), (b), (c), 0, 0, 0)

constexpr int D = 1024, NB = 4, SEQ = 4096, NL = 4, CTX = 256;
constexpr int RL = NB * SEQ;
constexpr int RC = NB * CTX;
constexpr int R = RL + RC;
constexpr int DFF = 2816, INW = 6864, ZW = 6912, NMOD = 9;
constexpr float EPS = 1e-6f;
constexpr int NCH = 68;
constexpr int MT = R / 128;

constexpr size_t al(size_t x) { return (x + 255) & ~(size_t)255; }
constexpr size_t OFF_XC = 0;
constexpr size_t OFF_MODS = al(OFF_XC + (size_t)RC * D * 4);
constexpr size_t OFF_ROPE = al(OFF_MODS + (size_t)NL * 5 * NMOD * D * 4);
constexpr size_t OFF_G = al(OFF_ROPE + (size_t)SEQ * 32 * 8);
constexpr size_t OFF_CTR = al(OFF_G + (size_t)32 * NCH * 512 * 4);
constexpr size_t OFF_BAR = al(OFF_CTR + 8 * 16 * 4);
constexpr size_t OFF_WB = al(OFF_BAR + 3456 * 4);
constexpr size_t WB_UP1 = 0;
constexpr size_t WB_DN1 = WB_UP1 + (size_t)2 * DFF * D;
constexpr size_t WB_UP2 = WB_DN1 + (size_t)D * DFF;
constexpr size_t WB_DN2 = WB_UP2 + (size_t)2 * DFF * D;
constexpr size_t WB_IN = WB_DN2 + (size_t)D * DFF;
constexpr size_t WB_UQ = WB_IN + (size_t)ZW * D;
constexpr size_t WB_UKV = WB_UQ + (size_t)1536 * 384;
constexpr size_t WB_BM = WB_UKV + (size_t)2048 * 256;
constexpr size_t WB_BA = WB_BM + (size_t)D * D;
constexpr size_t WB_OUT = WB_BA + (size_t)D * D;
constexpr size_t WB_END = WB_OUT + (size_t)D * D;
constexpr size_t OFF_AN = al(OFF_WB + 2 * WB_END * 2);
constexpr size_t OFF_H = al(OFF_AN + (size_t)R * D * 2);
constexpr size_t OFF_ZQ = al(OFF_H + (size_t)R * DFF * 2);
constexpr size_t OFF_ZK = al(OFF_ZQ + (size_t)R * D * 2);
constexpr size_t OFF_ZV = al(OFF_ZK + (size_t)R * D * 2);
constexpr size_t OFF_ZO = al(OFF_ZV + (size_t)R * D * 2);
constexpr size_t OFF_ZCQ = al(OFF_ZO + (size_t)R * D * 2);
constexpr size_t OFF_ZCKV = al(OFF_ZCQ + (size_t)R * 384 * 2);
constexpr size_t OFF_ZKR = al(OFF_ZCKV + (size_t)R * 256 * 2);
constexpr size_t OFF_ZG = al(OFF_ZKR + (size_t)R * 64 * 2);
constexpr size_t OFF_ZBR = al(OFF_ZG + (size_t)R * 16 * 4);
constexpr size_t OFF_KC = al(OFF_ZBR + (size_t)R * 2048 * 2);
constexpr size_t OFF_KV = al(OFF_KC + (size_t)R * D * 2);
constexpr size_t OFF_CQN = al(OFF_KV + (size_t)R * 2048 * 2);
constexpr size_t OFF_CKVN = al(OFF_CQN + (size_t)R * 384 * 2);
constexpr size_t OFF_KROPE = al(OFF_CKVN + (size_t)R * 256 * 2);
constexpr size_t OFF_SS2 = al(OFF_KROPE + (size_t)R * 64 * 2);
constexpr size_t WS_END = al(OFF_SS2 + (size_t)R * 16 * 4);

constexpr int SMEM_BYTES = 76800;
constexpr int NPH_LAYER = 15;
constexpr int NPH = NL * NPH_LAYER + 1;

struct Params {
  const float *x, *c, *ctx, *c_ctx, *w_ada, *b_ada, *g_n1, *g_n2, *g_n3, *w_ff1_up, *w_ff1_dn, *w_ff2_up, *w_ff2_dn,
      *w_in, *b_gate, *w_conv, *g_mh, *g_qa, *g_kva, *w_uq, *w_ukv, *w_bm, *w_ba, *w_out, *g_final;
  float* out;
  char* ws;
  int ph_lo, ph_hi;
};

DI float bf2f(u16 u) { return __uint_as_float(((unsigned)u) << 16); }
DI u16 f2bf(float x) { return __builtin_bit_cast(u16, (__bf16)x); }
DI unsigned pk2(float a, float b) { return (unsigned)f2bf(a) | ((unsigned)f2bf(b) << 16); }
DI float siluf(float x) { return x / (1.f + __expf(-x)); }
DI float sigmf(float x) { return 1.f / (1.f + __expf(-x)); }
DI float wave_sum(float v) {
#pragma unroll
  for (int o = 32; o > 0; o >>= 1) v += __shfl_xor(v, o);
  return v;
}
DI float wave_max(float v) {
#pragma unroll
  for (int o = 32; o > 0; o >>= 1) v = fmaxf(v, __shfl_xor(v, o));
  return v;
}
DI int tidx() { int t = threadIdx.x; asm volatile("" : "+v"(t)); return t; }
DI unsigned bko(unsigned r, unsigned k, unsigned nkt) { return ((r >> 7) * nkt + (k >> 6)) * 8192u + ((r & 127u) << 6) + (k & 63u); }
DI float* xptr(const Params& p, int r) { return r < RL ? p.out + (size_t)r * D : (float*)(p.ws + OFF_XC) + (size_t)(r - RL) * D; }
DI const float* xin_ptr(const Params& p, int r) { return r < RL ? p.x + (size_t)r * D : p.ctx + (size_t)(r - RL) * D; }
DI int modrow(int r) { return r < RL ? (r >> 12) : 4; }
DI bf16x8 tr8(const char* lo, const char* hi) {
  s16x4 a = __builtin_amdgcn_ds_read_tr16_b64_v4i16((s16x4 __attribute__((address_space(3)))*)(lo));
  s16x4 b = __builtin_amdgcn_ds_read_tr16_b64_v4i16((s16x4 __attribute__((address_space(3)))*)(hi));
  return __builtin_shufflevector(a, b, 0, 1, 2, 3, 4, 5, 6, 7);
}


#define XB_TMO      128
#define XB_XCNT(j)  (256  + 64 * (j))
#define XB_XSUB(j)  (1280 + 64 * (j))
#define XB_XGEN(j)  (2304 + 64 * (j))
#define XB_TOP      3328
#define XB_TOPGEN   3392
#define XCD_BAR_WORDS 3456
#define XB_SPIN_CAP (1u << 22)
#define LAS __attribute__((address_space(3)))
DI unsigned xb_ld(unsigned* p) { return __hip_atomic_load(p, __ATOMIC_RELAXED, __HIP_MEMORY_SCOPE_AGENT); }
DI unsigned xb_add(unsigned* p, unsigned v) { return __hip_atomic_fetch_add(p, v, __ATOMIC_RELAXED, __HIP_MEMORY_SCOPE_AGENT); }
DI unsigned xb_xcc_id() { return (unsigned)__builtin_amdgcn_s_getreg((3 << 11) | 20) & 0xFu; }
#define XB_SPIN(cond, bar) do { unsigned _sp = 0; while (cond) { __builtin_amdgcn_s_sleep(1); \
    if ((++_sp & 255u) == 0u) { if (xb_ld(&(bar)[XB_TMO])) break; if (_sp > XB_SPIN_CAP) { atomicAdd(&(bar)[XB_TMO], 1u); break; } } } } while (0)
struct XcdBarrier { unsigned* bar; unsigned x; volatile LAS unsigned* st; };
DI XcdBarrier xcd_barrier_post(unsigned* bar, volatile LAS unsigned* st) {
  XcdBarrier b; b.bar = bar; b.x = xb_xcc_id(); b.st = st;
  if (threadIdx.x == 0) (void)xb_add(&bar[XB_XCNT(b.x)], 1u);
  return b;
}
DI void xcd_barrier_complete(unsigned* bar, unsigned x, unsigned& nloc, unsigned& nx) {
  const unsigned G = gridDim.x * gridDim.y * gridDim.z;
  unsigned sum, cnt, mine, sp = 0u;
  for (;;) {
    sum = 0u; cnt = 0u; mine = 0u;
#pragma unroll
    for (unsigned j = 0; j < 16; ++j) { const unsigned c = xb_ld(&bar[XB_XCNT(j)]); sum += c; cnt += (c > 0u) ? 1u : 0u; mine = (j == x) ? c : mine; }
    if (sum == G) break;
    __builtin_amdgcn_s_sleep(1);
    if ((++sp & 255u) == 0u) { if (xb_ld(&bar[XB_TMO])) break; if (sp > XB_SPIN_CAP) { atomicAdd(&bar[XB_TMO], 1u); break; } }
  }
  nloc = mine > 0u ? mine : 1u; nx = cnt > 0u ? cnt : 1u;
}
DI void xcd_barrier(const XcdBarrier& b) {
  asm volatile("s_waitcnt vmcnt(0)" ::: "memory");
  __syncthreads();
  if (threadIdx.x == 0) {
    unsigned* bar = b.bar;
    __builtin_amdgcn_s_waitcnt(0);
    unsigned nloc = b.st[0], nx = b.st[1];
    if (nloc == 0u) { xcd_barrier_complete(bar, b.x, nloc, nx); b.st[0] = nloc; b.st[1] = nx; }
    const unsigned old = xb_add(&bar[XB_XSUB(b.x)], 1u);
    const unsigned gen = old / nloc;
    if (old + 1u == (gen + 1u) * nloc) {
      __builtin_amdgcn_fence(__ATOMIC_RELEASE, "agent");
      asm volatile("s_waitcnt vmcnt(0)" ::: "memory");
      const unsigned og = xb_add(&bar[XB_TOP], 1u);
      const unsigned tg = og / nx;
      if (og + 1u == (tg + 1u) * nx) xb_add(&bar[XB_TOPGEN], 1u);
      else XB_SPIN(xb_ld(&bar[XB_TOPGEN]) == tg, bar);
      __builtin_amdgcn_fence(__ATOMIC_ACQUIRE, "agent");
      xb_add(&bar[XB_XGEN(b.x)], 1u);
      asm volatile("s_waitcnt vmcnt(0)" ::: "memory");
    } else {
      XB_SPIN(xb_ld(&bar[XB_XGEN(b.x)]) == gen, bar);
      __builtin_amdgcn_fence(__ATOMIC_ACQUIRE, "agent");
      asm volatile("s_waitcnt vmcnt(0)" ::: "memory");
    }
  }
  __syncthreads();
}

DI int src_col(int perm, int r) {
  if (perm == 0) return r;
  if (perm == 1) { int grp = r >> 6, j = r & 63; return j < 32 ? grp * 32 + j : DFF + grp * 32 + (j - 32); }
  if (r < 4096) return r;
  if (r < 4800) return r + 16;
  if (r < 4816) return r - 704;
  if (r < 4864) return -1;
  return r - 48;
}

DI void convert_tile(const float* __restrict__ W, int Nsrc, int K, int perm, u16* __restrict__ Wt, int tile, char* smem) {
  const int nkt = K >> 6;
  const int rt = tile / nkt, kt = tile - rt * nkt;
  const int r0 = rt * 32, k0 = kt * 64;
  u16* t = (u16*)smem;
  const int tid = tidx();
  {
    const int j = tid & 31, i = tid >> 5;
    const int sc = src_col(perm, r0 + j);
#pragma unroll
    for (int s = 0; s < 8; ++s) {
      const int k = i + 8 * s;
      float v = sc >= 0 ? W[(size_t)(k0 + k) * Nsrc + sc] : 0.f;
      t[j * 72 + k] = f2bf(v);
    }
  }
  __syncthreads();
  {
    const int row = tid >> 3, c8 = tid & 7;
    uint4 v = *(const uint4*)(t + row * 72 + c8 * 8);
    *(uint4*)(Wt + bko(r0 + row, k0 + c8 * 8, K >> 6)) = v;
  }
  __syncthreads();
}

DI void convert_range(const Params& p, int l, char* smem, int t0, int t1, int tstep) {
  u16* wb = (u16*)(p.ws + OFF_WB) + (size_t)(l & 1) * WB_END;
  constexpr int T_UP = (2 * DFF / 32) * (D / 64);
  constexpr int T_DN = (D / 32) * (DFF / 64);
  constexpr int T_IN = (ZW / 32) * (D / 64);
  constexpr int T_UQ = (1536 / 32) * (384 / 64);
  constexpr int T_UKV = (2048 / 32) * (256 / 64);
  constexpr int T_SQ = (D / 32) * (D / 64);
  constexpr int C1 = T_UP, C2 = C1 + T_DN, C3 = C2 + T_UP, C4 = C3 + T_DN, C5 = C4 + T_IN, C6 = C5 + T_UQ, C7 = C6 + T_UKV,
                C8 = C7 + T_SQ, C9 = C8 + T_SQ, C10 = C9 + T_SQ;
  if (t1 > C10) t1 = C10;
  for (int t = t0; t < t1; t += tstep) {
    if (t < C1) convert_tile(p.w_ff1_up + (size_t)l * D * 2 * DFF, 2 * DFF, D, 1, wb + WB_UP1, t, smem);
    else if (t < C2) convert_tile(p.w_ff1_dn + (size_t)l * DFF * D, D, DFF, 0, wb + WB_DN1, t - C1, smem);
    else if (t < C3) convert_tile(p.w_ff2_up + (size_t)l * D * 2 * DFF, 2 * DFF, D, 1, wb + WB_UP2, t - C2, smem);
    else if (t < C4) convert_tile(p.w_ff2_dn + (size_t)l * DFF * D, D, DFF, 0, wb + WB_DN2, t - C3, smem);
    else if (t < C5) convert_tile(p.w_in + (size_t)l * D * INW, INW, D, 2, wb + WB_IN, t - C4, smem);
    else if (t < C6) convert_tile(p.w_uq + (size_t)l * 384 * 1536, 1536, 384, 0, wb + WB_UQ, t - C5, smem);
    else if (t < C7) convert_tile(p.w_ukv + (size_t)l * 256 * 2048, 2048, 256, 0, wb + WB_UKV, t - C6, smem);
    else if (t < C8) convert_tile(p.w_bm + (size_t)l * D * D, D, D, 0, wb + WB_BM, t - C7, smem);
    else if (t < C9) convert_tile(p.w_ba + (size_t)l * D * D, D, D, 0, wb + WB_BA, t - C8, smem);
    else convert_tile(p.w_out + (size_t)l * D * D, D, D, 0, wb + WB_OUT, t - C9, smem);
  }
}
constexpr int CONV_TILES = 13984;
constexpr int CONV_PER_TASK = 16;
constexpr int NCONV = (CONV_TILES + CONV_PER_TASK - 1) / CONV_PER_TASK;
DI void phase_convert(const Params& p, int l, char* smem, int bid, int nb) { convert_range(p, l, smem, bid, CONV_TILES, nb); }

DI void phase_init(const Params& p, char* smem, int bid, int nb) {
  const int tid = tidx(), lane = tid & 63, wid = tid >> 6;
  {
    float2* tab = (float2*)(p.ws + OFF_ROPE);
    for (int idx = bid * 256 + tid; idx < SEQ * 32; idx += nb * 256) {
      const int t = idx >> 5, i = idx & 31, f = i & 15;
      const float pos = (float)(i < 16 ? (t >> 6) : (t & 63));
      const float inv = powf(10000.f, -(float)(2 * f) / 32.f);
      const float ang = pos * inv;
      tab[idx] = make_float2(cosf(ang), sinf(ang));
    }
  }
  float* sc = (float*)smem;
  float* red = sc + 5 * D;
  for (int i = tid; i < 5 * D; i += 256) {
    const int row = i >> 10, k = i & 1023;
    const float v = row < 4 ? p.c[row * D + k] : p.c_ctx[k];
    sc[i] = siluf(v);
  }
  __syncthreads();
  float* mods = (float*)(p.ws + OFF_MODS);
  constexpr int NG = NMOD * D / 128;
  for (int t = bid; t < NL * NG; t += nb) {
    const int l = t / NG, n = (t - l * NG) * 128 + lane * 2;
    const float* w = p.w_ada + (size_t)l * D * NMOD * D + n;
    float a0 = 0, a1 = 0, a2 = 0, a3 = 0, a4 = 0, b0 = 0, b1 = 0, b2 = 0, b3 = 0, b4 = 0;
    const int kb = wid * 256;
#pragma unroll 8
    for (int k = 0; k < 256; ++k) {
      const float2 wv = *(const float2*)(w + (size_t)(kb + k) * (NMOD * D));
      const float s0 = sc[kb + k], s1 = sc[D + kb + k], s2 = sc[2 * D + kb + k], s3 = sc[3 * D + kb + k], s4 = sc[4 * D + kb + k];
      a0 += s0 * wv.x; a1 += s1 * wv.x; a2 += s2 * wv.x; a3 += s3 * wv.x; a4 += s4 * wv.x;
      b0 += s0 * wv.y; b1 += s1 * wv.y; b2 += s2 * wv.y; b3 += s3 * wv.y; b4 += s4 * wv.y;
    }
    float* rp = red + (wid * 5) * 128 + lane * 2;
    rp[0] = a0; rp[1] = b0; rp[128] = a1; rp[129] = b1; rp[256] = a2; rp[257] = b2; rp[384] = a3; rp[385] = b3; rp[512] = a4; rp[513] = b4;
    __syncthreads();
    for (int i = tid; i < 640; i += 256) {
      const int row = i >> 7, ln = i & 127;
      const int nn = (t - l * NG) * 128 + ln;
      const float s = (red[(0 * 5 + row) * 128 + ln] + red[(1 * 5 + row) * 128 + ln]) + (red[(2 * 5 + row) * 128 + ln] + red[(3 * 5 + row) * 128 + ln]);
      mods[((size_t)l * 5 + row) * (NMOD * D) + nn] = s + p.b_ada[(size_t)l * NMOD * D + nn];
    }
    __syncthreads();
  }
}

DI void phase_norm(const Params& p, int nrows, const float* __restrict__ g, const float* __restrict__ mods_l, int shift_idx, int scale_idx, u16* __restrict__ an, bool from_input, int bid, int nb) {
  const int tid_ = tidx(), lane = tid_ & 63, wid = tid_ >> 6;
  for (int r = bid * 4 + wid; r < nrows; r += nb * 4) {
    const float* x = from_input ? xin_ptr(p, r) : xptr(p, r);
    float4 v[4]; float ss = 0.f;
#pragma unroll
    for (int i = 0; i < 4; ++i) { v[i] = *(const float4*)(x + i * 256 + lane * 4); ss += v[i].x * v[i].x + v[i].y * v[i].y + v[i].z * v[i].z + v[i].w * v[i].w; }
    ss = wave_sum(ss);
    const float rstd = rsqrtf(ss * (1.f / D) + EPS);
    const float* md = mods_l + (size_t)modrow(r) * (NMOD * D);
#pragma unroll
    for (int i = 0; i < 4; ++i) {
      const int col = i * 256 + lane * 4;
      const float4 g4 = *(const float4*)(g + col);
      const float4 sh = *(const float4*)(md + shift_idx * D + col);
      const float4 sc = *(const float4*)(md + scale_idx * D + col);
      const float y0 = v[i].x * rstd * g4.x * (1.f + sc.x) + sh.x;
      const float y1 = v[i].y * rstd * g4.y * (1.f + sc.y) + sh.y;
      const float y2 = v[i].z * rstd * g4.z * (1.f + sc.z) + sh.z;
      const float y3 = v[i].w * rstd * g4.w * (1.f + sc.w) + sh.w;
      uint2 o; o.x = pk2(y0, y1); o.y = pk2(y2, y3);
      *(uint2*)(an + bko(r, col, D / 64)) = o;
    }
  }
}

DI void phase_final(const Params& p, int bid, int nb) {
  const int tid_ = tidx(), lane = tid_ & 63, wid = tid_ >> 6;
  for (int r = bid * 4 + wid; r < RL; r += nb * 4) {
    float* x = p.out + (size_t)r * D;
    float4 v[4]; float ss = 0.f;
#pragma unroll
    for (int i = 0; i < 4; ++i) { v[i] = *(const float4*)(x + i * 256 + lane * 4); ss += v[i].x * v[i].x + v[i].y * v[i].y + v[i].z * v[i].z + v[i].w * v[i].w; }
    ss = wave_sum(ss);
    const float rstd = rsqrtf(ss * (1.f / D) + EPS);
#pragma unroll
    for (int i = 0; i < 4; ++i) {
      const int col = i * 256 + lane * 4;
      const float4 g4 = *(const float4*)(p.g_final + col);
      float4 o; o.x = v[i].x * rstd * g4.x; o.y = v[i].y * rstd * g4.y; o.z = v[i].z * rstd * g4.z; o.w = v[i].w * rstd * g4.w;
      *(float4*)(x + col) = o;
    }
  }
}

constexpr int GSTR = 128;
constexpr int GBUF = 128 * GSTR;

#define G_PARAMS uint4 &ra00, uint4 &ra01, uint4 &ra02, uint4 &ra03, uint4 &rb00, uint4 &rb01, uint4 &rb02, uint4 &rb03, \
                 uint4 &ra10, uint4 &ra11, uint4 &ra12, uint4 &ra13, uint4 &rb10, uint4 &rb11, uint4 &rb12, uint4 &rb13
#define G_DECL uint4 g_a00, g_a01, g_a02, g_a03, g_b00, g_b01, g_b02, g_b03, g_a10, g_a11, g_a12, g_a13, g_b10, g_b11, g_b12, g_b13
#define G_ARGS g_a00, g_a01, g_a02, g_a03, g_b00, g_b01, g_b02, g_b03, g_a10, g_a11, g_a12, g_a13, g_b10, g_b11, g_b12, g_b13
#define G_L1(S, i, kt) ra##S##i = *(const uint4*)(ap + (size_t)(kt) * 8192 + i * 2048); rb##S##i = *(const uint4*)(bp + (size_t)(kt) * 8192 + i * 2048);
#define G_LOAD(S, kt) { G_L1(S, 0, kt) G_L1(S, 1, kt) G_L1(S, 2, kt) G_L1(S, 3, kt) }
#define G_S1(S, i, buf) *(uint4*)(sA + (buf) * GBUF + soff + i * 32 * GSTR) = ra##S##i; *(uint4*)(sB + (buf) * GBUF + soff + i * 32 * GSTR) = rb##S##i;
#define G_STORE(S, buf) { G_S1(S, 0, buf) G_S1(S, 1, buf) G_S1(S, 2, buf) G_S1(S, 3, buf) }
DI void gemm_prefetch(G_PARAMS, const u16* __restrict__ A, int lda, const u16* __restrict__ Bt, int ldb, int m0, int n0) {
  const int tid = tidx();
  const int lr = tid >> 3, lc = tid & 7;
  const u16* ap = A + (size_t)((m0 >> 7) * (lda >> 6)) * 8192 + lr * 64 + lc * 8;
  const u16* bp = Bt + (size_t)((n0 >> 7) * (ldb >> 6)) * 8192 + lr * 64 + lc * 8;
  G_LOAD(0, 0)
  G_LOAD(1, 1)
}
DI void gemm_mainloop(G_PARAMS, const u16* __restrict__ A, int lda, const u16* __restrict__ Bt, int ldb, int nk, int m0, int n0, f32x4 (&acc)[4][4], char* smem) {
  const int tid = tidx(), lane = tid & 63, wid = tid >> 6, wr = wid >> 1, wc = wid & 1;
  const int lr = tid >> 3, lc = tid & 7;
  const u16* ap = A + (size_t)((m0 >> 7) * (lda >> 6)) * 8192 + lr * 64 + lc * 8;
  const u16* bp = Bt + (size_t)((n0 >> 7) * (ldb >> 6)) * 8192 + lr * 64 + lc * 8;
#define G_COMPUTE(buf) { const char* cA = sA + (buf) * GBUF; const char* cB = sB + (buf) * GBUF; \
    _Pragma("unroll") for (int ks = 0; ks < 2; ++ks) { \
      bf16x8 a[4], b[4]; \
      _Pragma("unroll") for (int m = 0; m < 4; ++m) a[m] = *(const bf16x8*)(cA + (aoff ^ (ks * 64)) + m * 16 * GSTR); \
      _Pragma("unroll") for (int n = 0; n < 4; ++n) b[n] = *(const bf16x8*)(cB + (boff ^ (ks * 64)) + n * 16 * GSTR); \
      _Pragma("unroll") for (int m = 0; m < 4; ++m) _Pragma("unroll") for (int n = 0; n < 4; ++n) acc[m][n] = MFMA16(b[n], a[m], acc[m][n]); \
    } }
  char* sA = smem; char* sB = smem + 2 * GBUF;
  const int soff = lr * GSTR + ((lc ^ ((lr >> 1) & 7)) << 4);
  const int fr = lane & 15, fq = lane >> 4;
  const int swz = (fq ^ ((fr >> 1) & 7)) << 4;
  const int aoff = (wr * 64 + fr) * GSTR + swz;
  const int boff = (wc * 64 + fr) * GSTR + swz;
  uint4 ra20, ra21, ra22, ra23, rb20, rb21, rb22, rb23;
  if (2 < nk) G_LOAD(2, 2)
  G_STORE(0, 0)
  __syncthreads();
  if (3 < nk) G_LOAD(0, 3)
#define G_STEP(i, SN, BN) if (kt + (i) < nk) { \
    G_COMPUTE((i) & 1) \
    if (kt + (i) + 1 < nk) G_STORE(SN, BN) \
    __syncthreads(); \
    if (kt + (i) + 4 < nk) G_LOAD(SN, kt + (i) + 4) }
  for (int kt = 0; kt < nk; kt += 6) {
    G_STEP(0, 1, 1)
    G_STEP(1, 2, 0)
    G_STEP(2, 0, 1)
    G_STEP(3, 1, 0)
    G_STEP(4, 2, 1)
    G_STEP(5, 0, 0)
  }
#undef G_STEP
#undef G_COMPUTE
}
#undef G_L1
#undef G_S1
#undef G_LOAD
#undef G_STORE

DI int vbid(int bid, int nb) { return bid; }
DI void tile_of(int tile, int ntn, int& mt, int& nt) {
  const int gm = tile / (4 * ntn), rem = tile - gm * 4 * ntn;
  nt = rem >> 2; mt = gm * 4 + (rem & 3);
}
#define ZERO_ACC(acc) _Pragma("unroll") for (int m_ = 0; m_ < 4; ++m_) _Pragma("unroll") for (int n_ = 0; n_ < 4; ++n_) acc[m_][n_] = f32x4{0.f, 0.f, 0.f, 0.f}

constexpr int ST16 = 272;
constexpr int ST32 = 528;
DI void stage_bf16(const f32x4 (&acc)[4][4], char* st, int wr, int wc, int fr, int fq) {
#pragma unroll
  for (int m = 0; m < 4; ++m)
#pragma unroll
    for (int n = 0; n < 4; ++n) {
      uint2 v; v.x = pk2(acc[m][n][0], acc[m][n][1]); v.y = pk2(acc[m][n][2], acc[m][n][3]);
      *(uint2*)(st + (wr * 64 + 16 * m + fr) * ST16 + (wc * 64 + 16 * n + 4 * fq) * 2) = v;
    }
}
DI void stage_f32(const f32x4 (&acc)[4][4], char* st, int wr, int wc, int fr, int fq) {
#pragma unroll
  for (int m = 0; m < 4; ++m)
#pragma unroll
    for (int n = 0; n < 4; ++n) *(f32x4*)(st + (wr * 64 + 16 * m + fr) * ST32 + (wc * 64 + 16 * n + 4 * fq) * 4) = acc[m][n];
}

DI void phase_ffn_up(const Params& p, int mtn, const u16* an, const u16* wt, u16* h, char* smem, int bid, int nb) {
  constexpr int NTN = 2 * DFF / 128;
  G_DECL;
  { int tile = vbid(bid, nb); if (tile < mtn * NTN) { int mt, nt; tile_of(tile, NTN, mt, nt); gemm_prefetch(G_ARGS, an, D, wt, D, mt * 128, nt * 128); } }
  for (int tile = vbid(bid, nb); tile < mtn * NTN; tile += nb) {
    int mt, nt; tile_of(tile, NTN, mt, nt);
    f32x4 acc[4][4]; ZERO_ACC(acc);
    gemm_mainloop(G_ARGS, an, D, wt, D, D / 64, mt * 128, nt * 128, acc, smem);
    if (tile + nb < mtn * NTN) { int mt2, nt2; tile_of(tile + nb, NTN, mt2, nt2); gemm_prefetch(G_ARGS, an, D, wt, D, mt2 * 128, nt2 * 128); }
    const int tid = tidx(), lane = tid & 63, wid = tid >> 6, wr = wid >> 1, wc = wid & 1, fr = lane & 15, fq = lane >> 4;
#pragma unroll
    for (int m = 0; m < 4; ++m)
#pragma unroll
      for (int n = 0; n < 2; ++n) {
        float o[4];
#pragma unroll
        for (int r = 0; r < 4; ++r) o[r] = siluf(acc[m][n][r]) * acc[m][n + 2][r];
        uint2 v; v.x = pk2(o[0], o[1]); v.y = pk2(o[2], o[3]);
        *(uint2*)(smem + (wr * 64 + 16 * m + fr) * ST16 + (wc * 32 + 16 * n + 4 * fq) * 2) = v;
      }
    __syncthreads();
    const unsigned rbase = mt * 128, cbase = nt * 64;
#pragma unroll
    for (int i = 0; i < 4; ++i) {
      const unsigned id = tid + 256 * i, row = id >> 3, ch = id & 7;
      const uint4 v = *(const uint4*)(smem + row * ST16 + ch * 16);
      *(uint4*)(h + bko(rbase + row, cbase + ch * 8, DFF / 64)) = v;
    }
    __syncthreads();
  }
}

DI void phase_gemm_resid(const Params& p, int mtn, const u16* a, int K, const u16* wt, const float* mods_l, int gate_idx, float coef, bool from_input, char* smem, int bid, int nb) {
  constexpr int NTN = D / 128;
  G_DECL;
  { int tile = vbid(bid, nb); if (tile < mtn * NTN) { int mt, nt; tile_of(tile, NTN, mt, nt); gemm_prefetch(G_ARGS, a, K, wt, K, mt * 128, nt * 128); } }
  for (int tile = vbid(bid, nb); tile < mtn * NTN; tile += nb) {
    int mt, nt; tile_of(tile, NTN, mt, nt);
    f32x4 acc[4][4]; ZERO_ACC(acc);
    gemm_mainloop(G_ARGS, a, K, wt, K, K / 64, mt * 128, nt * 128, acc, smem);
    if (tile + nb < mtn * NTN) { int mt2, nt2; tile_of(tile + nb, NTN, mt2, nt2); gemm_prefetch(G_ARGS, a, K, wt, K, mt2 * 128, nt2 * 128); }
    const int tid = tidx(), lane = tid & 63, wid = tid >> 6, wr = wid >> 1, wc = wid & 1, fr = lane & 15, fq = lane >> 4;
    stage_f32(acc, smem, wr, wc, fr, fq);
    __syncthreads();
    const int r0 = mt * 128;
    const float* md = mods_l + (size_t)modrow(r0) * (NMOD * D) + gate_idx * D + nt * 128;
    float* xb = xptr(p, r0) + nt * 128;
    const float* xr = from_input ? xin_ptr(p, r0) + nt * 128 : xb;
    const unsigned ch = tid & 31;
    const float4 g4 = *(const float4*)(md + ch * 4);
#pragma unroll 4
    for (int i = 0; i < 16; ++i) {
      const unsigned row = (tid >> 5) + 8 * i;
      const float4 v = *(const float4*)(smem + row * ST32 + ch * 16);
      float4* xp = (float4*)(xb + row * (unsigned)D + ch * 4);
      float4 x = *(const float4*)(xr + row * (unsigned)D + ch * 4);
      x.x += coef * g4.x * v.x; x.y += coef * g4.y * v.y; x.z += coef * g4.z * v.z; x.w += coef * g4.w * v.w;
      *xp = x;
    }
    __syncthreads();
  }
}

DI void inproj_tile(int tile, bool last, int& mt, int& nt) {
  constexpr int NTN = ZW / 128;
  if (!last || tile < (RL / 128) * NTN) { tile_of(tile, NTN, mt, nt); return; }
  const int u = tile - (RL / 128) * NTN, idx = u >> 3;
  mt = RL / 128 + (u & 7);
  nt = idx < 8 ? 8 + idx : idx < 16 ? 16 + (idx - 8) : 35 + (idx - 16);
}
DI void phase_inproj(const Params& p, int l, const u16* an, const u16* wt, char* smem, int bid, int nb) {
  constexpr int NTN = ZW / 128;
  char* ws = p.ws;
  G_DECL;
  const bool last = (l == NL - 1);
  const int ntiles = last ? (RL / 128) * NTN + 8 * 19 : MT * NTN;
  { int tile = vbid(bid, nb); if (tile < ntiles) { int mt, nt; inproj_tile(tile, last, mt, nt); gemm_prefetch(G_ARGS, an, D, wt, D, mt * 128, nt * 128); } }
  for (int tile = vbid(bid, nb); tile < ntiles; tile += nb) {
    int mt, nt; inproj_tile(tile, last, mt, nt);
    f32x4 acc[4][4]; ZERO_ACC(acc);
    gemm_mainloop(G_ARGS, an, D, wt, D, D / 64, mt * 128, nt * 128, acc, smem);
    if (tile + nb < ntiles) { int mt2, nt2; inproj_tile(tile + nb, last, mt2, nt2); gemm_prefetch(G_ARGS, an, D, wt, D, mt2 * 128, nt2 * 128); }
    const int tid = tidx(), lane = tid & 63, wid = tid >> 6, wr = wid >> 1, wc = wid & 1, fr = lane & 15, fq = lane >> 4;
    if (nt == 37) {
      if (wc == 0) {
        u16* zkr = (u16*)(ws + OFF_ZKR);
#pragma unroll
        for (int m = 0; m < 4; ++m)
#pragma unroll
          for (int n = 0; n < 4; ++n) {
            const unsigned row = mt * 128 + wr * 64 + 16 * m + fr;
            uint2 v; v.x = pk2(acc[m][n][0], acc[m][n][1]); v.y = pk2(acc[m][n][2], acc[m][n][3]);
            *(uint2*)(zkr + row * 64u + 16 * n + 4 * fq) = v;
          }
      } else {
        float* zg = (float*)(ws + OFF_ZG);
        const float4 b4 = *(const float4*)(p.b_gate + l * 16 + 4 * fq);
#pragma unroll
        for (int m = 0; m < 4; ++m) {
          const unsigned row = mt * 128 + wr * 64 + 16 * m + fr;
          float4 v; v.x = acc[m][0][0] + b4.x; v.y = acc[m][0][1] + b4.y; v.z = acc[m][0][2] + b4.z; v.w = acc[m][0][3] + b4.w;
          *(float4*)(zg + row * 16u + 4 * fq) = v;
        }
      }
      continue;
    }
    if (nt >= 32 && nt < 37) {
      const bool isq = nt < 35;
      const float* gv = isq ? p.g_qa + l * 384 + (nt - 32) * 128 : p.g_kva + l * 256 + (nt - 35) * 128;
      float* ss2 = (float*)(ws + OFF_SS2);
      const int slot = isq ? (nt - 32) * 2 + wc : 8 + (nt - 35) * 2 + wc;
#pragma unroll
      for (int m = 0; m < 4; ++m) {
        float ssum = 0.f;
#pragma unroll
        for (int n = 0; n < 4; ++n) ssum += (acc[m][n][0] * acc[m][n][0] + acc[m][n][1] * acc[m][n][1]) + (acc[m][n][2] * acc[m][n][2] + acc[m][n][3] * acc[m][n][3]);
        ssum += __shfl_xor(ssum, 16); ssum += __shfl_xor(ssum, 32);
        if (fq == 0) ss2[(unsigned)(mt * 128 + wr * 64 + 16 * m + fr) * 16u + slot] = ssum;
      }
#pragma unroll
      for (int n = 0; n < 4; ++n) {
        const float4 g4 = *(const float4*)(gv + wc * 64 + 16 * n + 4 * fq);
#pragma unroll
        for (int m = 0; m < 4; ++m) { acc[m][n][0] *= g4.x; acc[m][n][1] *= g4.y; acc[m][n][2] *= g4.z; acc[m][n][3] *= g4.w; }
      }
    }
    stage_bf16(acc, smem, wr, wc, fr, fq);
    __syncthreads();
    const int c = nt * 128;
    u16* dst; unsigned ld, c0; unsigned nkb = 0;
    if (c < 4096) { dst = (u16*)(ws + OFF_ZQ) + (size_t)(c >> 10) * R * D; ld = D; c0 = c & 1023; }
    else if (c < 4480) { dst = (u16*)(ws + OFF_CQN); ld = 384; c0 = c - 4096; nkb = 6; }
    else if (c < 4736) { dst = (u16*)(ws + OFF_CKVN); ld = 256; c0 = c - 4480; nkb = 4; }
    else { dst = (u16*)(ws + OFF_ZBR); ld = 2048; c0 = c - 4864; }
    const unsigned rbase = mt * 128;
#pragma unroll
    for (int i = 0; i < 8; ++i) {
      const unsigned id = tid + 256 * i, row = id >> 4, ch = id & 15;
      const uint4 v = *(const uint4*)(smem + row * ST16 + ch * 16);
      *(uint4*)(dst + (nkb ? bko(rbase + row, c0 + ch * 8, nkb) : (rbase + row) * ld + c0 + ch * 8)) = v;
    }
    __syncthreads();
  }
}

DI void phase_prep(const Params& p, int l, int bid, int nb) {
  const int tid_ = tidx(), lane = tid_ & 63, wid = tid_ >> 6;
  char* ws = p.ws;
  const u16* zq = (const u16*)(ws + OFF_ZQ); const u16* zk = (const u16*)(ws + OFF_ZK);
  u16* qc = (u16*)(ws + OFF_AN); u16* kc = (u16*)(ws + OFF_KC);
  const float* wcv = p.w_conv + (size_t)l * 3 * 2048;
  const float2* tab = (const float2*)(ws + OFF_ROPE);
  for (int r = bid * 4 + wid; r < R; r += nb * 4) {
    int t, T;
    if (r < RL) { t = r & 4095; T = SEQ; } else { t = (r - RL) & 255; T = CTX; }
    const bool hp = t > 0, hn = t < T - 1;
#pragma unroll
    for (int c4 = 0; c4 < 4; ++c4) {
      const int ch = c4 * 512 + lane * 8;
      const bool isq = ch < 1024;
      const u16* src = isq ? zq : zk;
      const int cc = isq ? ch : ch - 1024;
      const uint4 zero = make_uint4(0, 0, 0, 0);
      const uint4 vc = *(const uint4*)(src + (size_t)r * D + cc);
      const uint4 vp = hp ? *(const uint4*)(src + (size_t)(r - 1) * D + cc) : zero;
      const uint4 vn = hn ? *(const uint4*)(src + (size_t)(r + 1) * D + cc) : zero;
      const unsigned pc[4] = {vc.x, vc.y, vc.z, vc.w}, pp[4] = {vp.x, vp.y, vp.z, vp.w}, pn[4] = {vn.x, vn.y, vn.z, vn.w};
      float o[8];
#pragma unroll
      for (int e = 0; e < 8; ++e) {
        const int sh = (e & 1) * 16;
        const float xc = bf2f((u16)(pc[e >> 1] >> sh)), xp = bf2f((u16)(pp[e >> 1] >> sh)), xn = bf2f((u16)(pn[e >> 1] >> sh));
        const float w0 = wcv[ch + e], w1 = wcv[2048 + ch + e], w2 = wcv[4096 + ch + e];
        float y = siluf(xp * w0 + xc * w1 + xn * w2);
        o[e] = isq ? y * 0.0625f : y;
      }
      uint4 ov; ov.x = pk2(o[0], o[1]); ov.y = pk2(o[2], o[3]); ov.z = pk2(o[4], o[5]); ov.w = pk2(o[6], o[7]);
      *(uint4*)((isq ? qc : kc) + (size_t)r * D + cc) = ov;
    }
    {
      const float v = bf2f(((const u16*)(ws + OFF_ZKR))[(size_t)r * 64 + lane]);
      const float pv = __shfl_xor(v, 1);
      float o = v;
      if (r < RL) {
        const float2 cs = tab[t * 32 + (lane >> 1)];
        o = (lane & 1) ? (pv * cs.y + v * cs.x) : (v * cs.x - pv * cs.y);
      }
      ((u16*)(ws + OFF_KROPE))[(size_t)r * 64 + lane] = f2bf(o);
    }
  }
  {
    const float* zg = (const float*)(ws + OFF_ZG);
    for (int item = bid * 4 + wid; item < 32 * NCH; item += nb * 4) {
      const int stream = item / NCH, n = item - stream * NCH;
      const int b = stream >> 3, hd = (stream >> 1) & 3, dir = stream & 1;
      int base, T, cc;
      if (n < 4) { base = RL + b * CTX; T = CTX; cc = n; } else { base = b * SEQ; T = SEQ; cc = n - 4; }
      const int pos = cc * 64 + lane;
      const int row = base + (dir ? T - 1 - pos : pos);
      const float ig = zg[(size_t)row * 16 + dir * 8 + hd];
      const float fg = zg[(size_t)row * 16 + dir * 8 + 4 + hd];
      const float lf = fminf(fg, 0.f) - log1pf(__expf(-fabsf(fg)));
      float bc = lf;
#pragma unroll
      for (int d = 1; d < 64; d <<= 1) { const float tt = __shfl_up(bc, d); if (lane >= d) bc += tt; }
      const float bL = __shfl(bc, 63);
      const float wv = ig - bc;
      float pm = wv;
#pragma unroll
      for (int d = 1; d < 64; d <<= 1) { const float tt = __shfl_up(pm, d); if (lane >= d) pm = fmaxf(pm, tt); }
      const float endl = bL + wv;
      const float me = wave_max(endl);
      float* g = (float*)(ws + OFF_G) + ((size_t)stream * NCH + n) * 512;
      g[lane] = bc; g[64 + lane] = wv; g[128 + lane] = pm; g[192 + lane] = endl;
      if (lane == 0) { g[256] = bL; g[257] = me; }
    }
  }
}

DI void phase_upproj(const Params& p, const u16* wb, char* smem, int bid, int nb) {
  char* ws = p.ws;
  const float2* tab = (const float2*)(ws + OFF_ROPE);
  u16* qa = (u16*)(ws + OFF_H);
  u16* kv = (u16*)(ws + OFF_KV);
  constexpr int NQ = 12, NKV = 16;
  const int total = MT * (NQ + NKV);
  G_DECL;
#define UP_PREFETCH(T) { const int t_ = (T); if (t_ < MT * NQ) { int m_, n_; tile_of(t_, NQ, m_, n_); gemm_prefetch(G_ARGS, (const u16*)(ws + OFF_CQN), 384, wb + WB_UQ, 384, m_ * 128, n_ * 128); } \
    else if (t_ < total) { int m_, n_; tile_of(t_ - MT * NQ, NKV, m_, n_); gemm_prefetch(G_ARGS, (const u16*)(ws + OFF_CKVN), 256, wb + WB_UKV, 256, m_ * 128, n_ * 128); } }
  for (int tile = vbid(bid, nb); tile < total; tile += nb) {
    const bool isq = tile < MT * NQ;
    int mt, nt;
    f32x4 acc[4][4]; ZERO_ACC(acc);
    UP_PREFETCH(tile)
    if (isq) { tile_of(tile, NQ, mt, nt); gemm_mainloop(G_ARGS, (const u16*)(ws + OFF_CQN), 384, wb + WB_UQ, 384, 6, mt * 128, nt * 128, acc, smem); }
    else { tile_of(tile - MT * NQ, NKV, mt, nt); gemm_mainloop(G_ARGS, (const u16*)(ws + OFF_CKVN), 256, wb + WB_UKV, 256, 4, mt * 128, nt * 128, acc, smem); }
    const int tid = tidx(), lane = tid & 63, wid = tid >> 6, wr = wid >> 1, wc = wid & 1, fr = lane & 15, fq = lane >> 4;
    {
      const float* ss2 = (const float*)(ws + OFF_SS2);
#pragma unroll
      for (int m = 0; m < 4; ++m) {
        const float* sp = ss2 + (unsigned)(mt * 128 + wr * 64 + 16 * m + fr) * 16u;
        float rstd;
        if (isq) { const float4 a = *(const float4*)sp; const float2 b = *(const float2*)(sp + 4); rstd = rsqrtf((((a.x + a.y) + (a.z + a.w)) + (b.x + b.y)) * (1.f / 384.f) + EPS); }
        else { const float4 a = *(const float4*)(sp + 8); rstd = rsqrtf(((a.x + a.y) + (a.z + a.w)) * (1.f / 256.f) + EPS); }
#pragma unroll
        for (int n = 0; n < 4; ++n) { acc[m][n][0] *= rstd; acc[m][n][1] *= rstd; acc[m][n][2] *= rstd; acc[m][n][3] *= rstd; }
      }
    }
    stage_bf16(acc, smem, wr, wc, fr, fq);
    __syncthreads();
    const unsigned rbase = mt * 128;
    if (isq) {
#pragma unroll
      for (int i = 0; i < 8; ++i) {
        const unsigned id = tid + 256 * i, row = id >> 4, ch = id & 15;
        uint4 v = *(const uint4*)(smem + row * ST16 + ch * 16);
        const unsigned col = nt * 128 + ch * 8, d0 = col % 192u, grow = rbase + row;
        if (d0 >= 128u && grow < (unsigned)RL) {
          const float4* tp = (const float4*)(tab + (grow & 4095u) * 32u + ((d0 - 128u) >> 1));
          const float4 t0 = tp[0], t1 = tp[1];
          float x0, x1;
          x0 = bf2f((u16)(v.x & 0xffff)); x1 = bf2f((u16)(v.x >> 16)); v.x = pk2(x0 * t0.x - x1 * t0.y, x0 * t0.y + x1 * t0.x);
          x0 = bf2f((u16)(v.y & 0xffff)); x1 = bf2f((u16)(v.y >> 16)); v.y = pk2(x0 * t0.z - x1 * t0.w, x0 * t0.w + x1 * t0.z);
          x0 = bf2f((u16)(v.z & 0xffff)); x1 = bf2f((u16)(v.z >> 16)); v.z = pk2(x0 * t1.x - x1 * t1.y, x0 * t1.y + x1 * t1.x);
          x0 = bf2f((u16)(v.w & 0xffff)); x1 = bf2f((u16)(v.w >> 16)); v.w = pk2(x0 * t1.z - x1 * t1.w, x0 * t1.w + x1 * t1.z);
        }
        *(uint4*)(qa + grow * 1536u + col) = v;
      }
    } else {
#pragma unroll
      for (int i = 0; i < 8; ++i) {
        const unsigned id = tid + 256 * i, row = id >> 4, ch = id & 15;
        const uint4 v = *(const uint4*)(smem + row * ST16 + ch * 16);
        *(uint4*)(kv + (rbase + row) * 2048u + nt * 128 + ch * 8) = v;
      }
    }
    __syncthreads();
  }
#undef UP_PREFETCH
}

constexpr int AKS = 400;
constexpr int AVS = 320;
DI void attn_task(const Params& p, int b, int h, int qrow0, int nkt, bool with_latent, char* smem) {
  const int tid = tidx(), lane = tid & 63, wid = tid >> 6, l31 = lane & 31, h2 = lane >> 5;
  char* ws = p.ws;
  const u16* qa = (const u16*)(ws + OFF_H);
  const u16* kvb = (const u16*)(ws + OFF_KV);
  const u16* krp = (const u16*)(ws + OFF_KROPE);
  u16* ao = (u16*)(ws + OFF_H) + (size_t)R * 1536;
  char* Ks = smem; char* Vs = smem + 64 * AKS;
  bf16x8 qf[12];
  {
    const u16* qp = qa + (size_t)(qrow0 + wid * 32 + l31) * 1536 + h * 192 + h2 * 8;
#pragma unroll
    for (int st = 0; st < 12; ++st) qf[st] = *(const bf16x8*)(qp + st * 16);
  }
  uint4 kreg0, kreg1, kreg2, kreg3, kreg4, kreg5, vreg0, vreg1, vreg2, vreg3;
#define KEY_ROW(kt, i) ((kt) < 4 ? (RL + b * CTX + (kt) * 64 + (i)) : (b * SEQ + ((kt) - 4) * 64 + (i)))
#define ATT_KL(kt, i) { const int id = tid + 256 * i, row = id / 24, ch = id - row * 24; const int kr = KEY_ROW(kt, row); \
    const u16* src = ch < 16 ? (kvb + (size_t)kr * 2048 + h * 256 + ch * 8) : (krp + (size_t)kr * 64 + (ch - 16) * 8); kreg##i = *(const uint4*)src; }
#define ATT_VL(kt, i) { const int id = tid + 256 * i, row = id >> 4, ch = id & 15; const int kr = KEY_ROW(kt, row); \
    vreg##i = *(const uint4*)(kvb + (size_t)kr * 2048 + h * 256 + 128 + ch * 8); }
#define ATT_GLOADK(kt) ATT_KL(kt, 0) ATT_KL(kt, 1) ATT_KL(kt, 2) ATT_KL(kt, 3) ATT_KL(kt, 4) ATT_KL(kt, 5)
#define ATT_GLOADV(kt) ATT_VL(kt, 0) ATT_VL(kt, 1) ATT_VL(kt, 2) ATT_VL(kt, 3)
#define ATT_GLOAD(kt) ATT_GLOADK(kt) ATT_GLOADV(kt)
#define ATT_KS(i) { const int id = tid + 256 * i, row = id / 24, ch = id - row * 24; *(uint4*)(Ks + row * AKS + ch * 16) = kreg##i; }
#define ATT_VS(i) { const int id = tid + 256 * i, row = id >> 4, ch = id & 15; *(uint4*)(Vs + row * AVS + ch * 16) = vreg##i; }
#define ATT_SSTORE() ATT_KS(0) ATT_KS(1) ATT_KS(2) ATT_KS(3) ATT_KS(4) ATT_KS(5) ATT_VS(0) ATT_VS(1) ATT_VS(2) ATT_VS(3)
  f32x16 o[4];
#pragma unroll
  for (int n = 0; n < 4; ++n)
#pragma unroll
    for (int i = 0; i < 16; ++i) o[n][i] = 0.f;
  float mrun = -1e30f, lrun = 0.f;
  const float sc = 0.07216878364870322f * 1.4426950408889634f;
  const int i16 = lane & 15, tq = i16 >> 2, tp = i16 & 3, blk = (lane >> 4) & 1;
  ATT_GLOAD(0)
  __syncthreads();
  ATT_SSTORE()
  __syncthreads();
  for (int kt = 0; kt < nkt; ++kt) {
    if (kt + 1 < nkt) { ATT_GLOADK(kt + 1) }
    f32x16 s0, s1;
#pragma unroll
    for (int i = 0; i < 16; ++i) { s0[i] = 0.f; s1[i] = 0.f; }
#pragma unroll
    for (int st = 0; st < 12; ++st) {
      const bf16x8 a0 = *(const bf16x8*)(Ks + l31 * AKS + st * 32 + h2 * 16);
      const bf16x8 a1 = *(const bf16x8*)(Ks + (32 + l31) * AKS + st * 32 + h2 * 16);
      s0 = MFMA32(a0, qf[st], s0);
      s1 = MFMA32(a1, qf[st], s1);
    }
    __builtin_amdgcn_sched_group_barrier(0x100, 4, 0);
#pragma unroll
    for (int i = 0; i < 10; ++i) { __builtin_amdgcn_sched_group_barrier(0x008, 2, 0); __builtin_amdgcn_sched_group_barrier(0x100, 2, 0); }
    __builtin_amdgcn_sched_group_barrier(0x008, 4, 0);
    __builtin_amdgcn_sched_barrier(0);
    float mx = s0[0];
#pragma unroll
    for (int i = 0; i < 16; ++i) { mx = fmaxf(mx, s0[i]); mx = fmaxf(mx, s1[i]); }
    mx = fmaxf(mx, __shfl_xor(mx, 32));
    const float mnew = fmaxf(mrun, mx * sc);
    const float alpha = __builtin_amdgcn_exp2f(mrun - mnew);
    mrun = mnew;
    float ls = 0.f;
#pragma unroll
    for (int i = 0; i < 16; ++i) { s0[i] = __builtin_amdgcn_exp2f(s0[i] * sc - mnew); s1[i] = __builtin_amdgcn_exp2f(s1[i] * sc - mnew); ls += s0[i] + s1[i]; }
    lrun = lrun * alpha + ls;
    if (__any(alpha != 1.f)) {
#pragma unroll
      for (int n = 0; n < 4; ++n)
#pragma unroll
        for (int i = 0; i < 16; ++i) o[n][i] *= alpha;
    }
    bf16x8 pbv[4];
#define ATT_PACK(SV, HH) \
    _Pragma("unroll") for (int s = 0; s < 2; ++s) { \
      u32x4 pu; \
      pu[0] = pk2(SV[8 * s + 0], SV[8 * s + 1]); pu[1] = pk2(SV[8 * s + 2], SV[8 * s + 3]); \
      pu[2] = pk2(SV[8 * s + 4], SV[8 * s + 5]); pu[3] = pk2(SV[8 * s + 6], SV[8 * s + 7]); \
      pbv[2 * HH + s] = __builtin_bit_cast(bf16x8, pu); \
    }
    ATT_PACK(s0, 0)
    ATT_PACK(s1, 1)
#undef ATT_PACK
    if (kt + 1 < nkt) { ATT_GLOADV(kt + 1) }
#pragma unroll
    for (int hs = 0; hs < 4; ++hs) {
      const char* vlo = Vs + (16 * hs + 4 * h2 + tq) * AVS + (16 * blk) * 2 + 8 * tp;
#pragma unroll
      for (int n = 0; n < 4; ++n) {
        const bf16x8 va = tr8(vlo + n * 64, vlo + n * 64 + 8 * AVS);
        o[n] = MFMA32(va, pbv[hs], o[n]);
      }
    }
    __syncthreads();
    if (kt + 1 < nkt) { ATT_SSTORE() }
    __syncthreads();
  }
  const float ltot = lrun + __shfl_xor(lrun, 32);
  const float inv = 1.f / ltot;
  const unsigned orow = qrow0 + wid * 32 + l31;
#pragma unroll
  for (int n = 0; n < 4; ++n)
#pragma unroll
    for (int g = 0; g < 4; ++g) {
      uint2 w; w.x = pk2(o[n][4 * g] * inv, o[n][4 * g + 1] * inv); w.y = pk2(o[n][4 * g + 2] * inv, o[n][4 * g + 3] * inv);
      *(uint2*)(ao + bko(orow, h * 128 + 32 * n + 8 * g + 4 * h2, D / 64)) = w;
    }
}

constexpr int MKS = 528;
constexpr int MVS = 112;
constexpr int M_CT = 64 * MKS;
constexpr int M_VS = M_CT + 48 * MKS;
constexpr int M_VW = M_VS + 64 * MVS;
constexpr int M_GS = 73728;
constexpr int M_MS = M_GS + 1536;
DI void mlstm_task(const Params& p, int task, char* smem) {
  const int tid = tidx(), lane = tid & 63, w = tid >> 6, fr = lane & 15, fq = lane >> 4, tq = fr >> 2, tp = fr & 3;
  const int stream = task >> 3, c = task & 7, b = stream >> 3, hd = (stream >> 1) & 3, dir = stream & 1;
  char* ws = p.ws;
  const u16* qc = (const u16*)(ws + OFF_AN); const u16* kc = (const u16*)(ws + OFF_KC); const u16* zv = (const u16*)(ws + OFF_ZV);
  const float* G = (const float*)(ws + OFF_G) + (size_t)stream * NCH * 512;
  _Float16* hout = (_Float16*)(ws + (dir ? OFF_ZK : OFF_ZQ));
  char* Ks = smem; char* Ct = smem + M_CT; char* Vs = smem + M_VS; char* Vw = smem + M_VW;
#define ROW_OF(n, pos) ((n) < 4 ? (RL + b * CTX + (dir ? CTX - 1 - ((n) * 64 + (pos)) : ((n) * 64 + (pos)))) : (b * SEQ + (dir ? SEQ - 1 - (((n) - 4) * 64 + (pos)) : (((n) - 4) * 64 + (pos)))))
  __syncthreads();
  for (int i = tid; i < 48 * MKS / 16; i += 256) ((uint4*)Ct)[i] = make_uint4(0, 0, 0, 0);
  f32x4 cacc[4][3];
#pragma unroll
  for (int kt = 0; kt < 4; ++kt)
#pragma unroll
    for (int vt = 0; vt < 3; ++vt) cacc[kt][vt] = f32x4{0.f, 0.f, 0.f, 0.f};
  uint4 kreg0, kreg1, kreg2, kreg3, kreg4, kreg5, kreg6, kreg7; uint4 vreg; float wreg; float4 greg = make_float4(0.f, 0.f, 0.f, 0.f);
#define M_KL(n, i) { const int id = tid + 256 * i, row = id >> 5, ch = id & 31; kreg##i = *(const uint4*)(kc + (size_t)ROW_OF(n, row) * D + hd * 256 + ch * 8); }
#define M_GLOAD(n) { M_KL(n, 0) M_KL(n, 1) M_KL(n, 2) M_KL(n, 3) M_KL(n, 4) M_KL(n, 5) M_KL(n, 6) M_KL(n, 7) \
    const int row_ = tid >> 2, part_ = tid & 3; \
    vreg = *(const uint4*)(zv + (size_t)ROW_OF(n, row_) * D + hd * 256 + c * 32 + part_ * 8); \
    wreg = G[(size_t)(n) * 512 + 192 + row_]; \
    if (tid < 64) { greg.x = G[(size_t)(n) * 512 + tid]; greg.y = G[(size_t)(n) * 512 + 64 + tid]; greg.z = G[(size_t)(n) * 512 + 128 + tid]; greg.w = G[(size_t)(n) * 512 + 192 + tid]; } }
#define M_KS(i) { const int id = tid + 256 * i, row = id >> 5, ch = id & 31; *(uint4*)(Ks + row * MKS + ch * 16) = kreg##i; }
#define M_SSTORE(n) { M_KS(0) M_KS(1) M_KS(2) M_KS(3) M_KS(4) M_KS(5) M_KS(6) M_KS(7) \
    const int row = tid >> 2, part = tid & 3; \
    const float mp_ = ((const float*)(smem + M_MS))[136 + (n)], mn_ = ((const float*)(smem + M_MS))[204 + (n)]; \
    if (tid < 64) { float* gs_ = (float*)(smem + M_GS); const float mj_ = fmaxf(greg.x + mp_, greg.x + greg.z); \
      gs_[tid] = greg.x - mj_; gs_[64 + tid] = greg.y; gs_[128 + tid] = __expf(greg.x + mp_ - mj_); gs_[192 + tid] = __expf(-mj_); gs_[256 + tid] = __expf(greg.w - mn_); \
      if (tid == 0) gs_[320] = __expf(((const float*)(smem + M_MS))[(n)] + mp_ - mn_); } \
    wreg = __expf(wreg - mn_); \
    *(uint4*)(Vs + row * MVS + part * 16) = vreg; \
    uint4 wv; \
    wv.x = pk2(bf2f((u16)(vreg.x & 0xffff)) * wreg, bf2f((u16)(vreg.x >> 16)) * wreg); \
    wv.y = pk2(bf2f((u16)(vreg.y & 0xffff)) * wreg, bf2f((u16)(vreg.y >> 16)) * wreg); \
    wv.z = pk2(bf2f((u16)(vreg.z & 0xffff)) * wreg, bf2f((u16)(vreg.z >> 16)) * wreg); \
    wv.w = pk2(bf2f((u16)(vreg.w & 0xffff)) * wreg, bf2f((u16)(vreg.w >> 16)) * wreg); \
    *(uint4*)(Vw + row * MVS + part * 16) = wv; \
    if (part == 0) { \
      *(uint4*)(Vs + row * MVS + 64) = make_uint4(0x3f80u, 0, 0, 0); \
      *(uint4*)(Vs + row * MVS + 80) = make_uint4(0, 0, 0, 0); \
      *(uint4*)(Vw + row * MVS + 64) = make_uint4((unsigned)f2bf(wreg), 0, 0, 0); \
      *(uint4*)(Vw + row * MVS + 80) = make_uint4(0, 0, 0, 0); \
    } }
#define M_QLOAD(n) { \
    const u16* qp = qc + (size_t)ROW_OF(n, 16 * w + fr) * D + hd * 256 + fq * 8; \
    _Pragma("unroll") for (int ks = 0; ks < 8; ++ks) qf[ks] = *(const bf16x8*)(qp + ks * 32); }
  bf16x8 qf[8];
  M_GLOAD(0) M_QLOAD(0)
  {
    float* ms = (float*)(smem + M_MS);
    if (tid < NCH) { ms[tid] = G[(size_t)tid * 512 + 256]; ms[68 + tid] = G[(size_t)tid * 512 + 257]; }
    __syncthreads();
    if (tid == 0) { float m = 0.f; for (int i = 0; i < NCH; ++i) { const float mn = fmaxf(ms[i] + m, ms[68 + i]); ms[136 + i] = m; ms[204 + i] = mn; m = mn; } }
    __syncthreads();
  }
  M_SSTORE(0)
  __syncthreads();
  for (int n = 0; n < NCH; ++n) {
    const bool more = n + 1 < NCH;
    if (more) M_GLOAD(n + 1)
    const float* g = (const float*)(smem + M_GS);
    const int jpos = 16 * w + fr;
    const float u_j = g[jpos], e_j = g[128 + jpos], rd_j = g[192 + jpos];
    const float a_state = g[320];
    f32x4 xs[4];
#pragma unroll
    for (int st = 0; st < 4; ++st) {
      xs[st] = f32x4{0.f, 0.f, 0.f, 0.f};
      if (st <= w) {
#pragma unroll
        for (int ks = 0; ks < 8; ++ks) {
          const bf16x8 a = *(const bf16x8*)(Ks + (16 * st + fr) * MKS + ks * 64 + fq * 16);
          xs[st] = MFMA16(a, qf[ks], xs[st]);
        }
        const float4 wv4 = *(const float4*)(g + 64 + 16 * st + 4 * fq);
        const int sb = 16 * st + 4 * fq;
        xs[st][0] *= (sb + 0 <= jpos) ? __expf(u_j + wv4.x) : 0.f;
        xs[st][1] *= (sb + 1 <= jpos) ? __expf(u_j + wv4.y) : 0.f;
        xs[st][2] *= (sb + 2 <= jpos) ? __expf(u_j + wv4.z) : 0.f;
        xs[st][3] *= (sb + 3 <= jpos) ? __expf(u_j + wv4.w) : 0.f;
      }
    }
    bf16x8 pb[2];
#pragma unroll
    for (int u = 0; u < 2; ++u) {
      u32x4 pu;
      pu[0] = pk2(xs[2 * u][0], xs[2 * u][1]); pu[1] = pk2(xs[2 * u][2], xs[2 * u][3]);
      pu[2] = pk2(xs[2 * u + 1][0], xs[2 * u + 1][1]); pu[3] = pk2(xs[2 * u + 1][2], xs[2 * u + 1][3]);
      pb[u] = __builtin_bit_cast(bf16x8, pu);
    }
    f32x4 num[3];
#pragma unroll
    for (int vt = 0; vt < 3; ++vt) {
      f32x4 n1 = {0.f, 0.f, 0.f, 0.f}, n2 = {0.f, 0.f, 0.f, 0.f};
#pragma unroll
      for (int u = 0; u < 2; ++u) {
        const char* lo = Vs + (32 * u + 4 * fq + tq) * MVS + (16 * vt) * 2 + 8 * tp;
        const bf16x8 a = tr8(lo, lo + 16 * MVS);
        n1 = MFMA16(a, pb[u], n1);
      }
#pragma unroll
      for (int ks = 0; ks < 8; ++ks) {
        const bf16x8 a = *(const bf16x8*)(Ct + (16 * vt + fr) * MKS + ks * 64 + fq * 16);
        n2 = MFMA16(a, qf[ks], n2);
      }
#pragma unroll
      for (int r = 0; r < 4; ++r) num[vt][r] = n1[r] + e_j * n2[r];
    }
    const float den = __shfl(num[2][0], fr);
    const float inv = 1.f / fmaxf(fabsf(den), rd_j);
    {
      _Float16* hp = hout + (size_t)ROW_OF(n, jpos) * D + hd * 256 + c * 32 + 4 * fq;
#pragma unroll
      for (int vt = 0; vt < 2; ++vt) {
        h16x4 hv;
#pragma unroll
        for (int r = 0; r < 4; ++r) hv[r] = (_Float16)(num[vt][r] * inv);
        *(h16x4*)(hp + 16 * vt) = hv;
      }
    }
    if (more) M_QLOAD(n + 1)
    __syncthreads();
#pragma unroll
    for (int kt = 0; kt < 4; ++kt)
#pragma unroll
      for (int vt = 0; vt < 3; ++vt) cacc[kt][vt] *= a_state;
#pragma unroll
    for (int u = 0; u < 2; ++u) {
      bf16x8 bfr[3];
#pragma unroll
      for (int vt = 0; vt < 3; ++vt) {
        const char* lo = Vw + (32 * u + 8 * fq + tq) * MVS + (16 * vt) * 2 + 8 * tp;
        bfr[vt] = tr8(lo, lo + 4 * MVS);
      }
#pragma unroll
      for (int kt = 0; kt < 4; ++kt) {
        const char* lo = Ks + (32 * u + 8 * fq + tq) * MKS + (64 * w + 16 * kt) * 2 + 8 * tp;
        const bf16x8 af = tr8(lo, lo + 4 * MKS);
#pragma unroll
        for (int vt = 0; vt < 3; ++vt) cacc[kt][vt] = MFMA16(af, bfr[vt], cacc[kt][vt]);
      }
    }
#pragma unroll
    for (int kt = 0; kt < 4; ++kt)
#pragma unroll
      for (int vt = 0; vt < 3; ++vt) {
        uint2 o2; o2.x = pk2(cacc[kt][vt][0], cacc[kt][vt][1]); o2.y = pk2(cacc[kt][vt][2], cacc[kt][vt][3]);
        *(uint2*)(Ct + (16 * vt + fr) * MKS + (64 * w + 16 * kt + 4 * fq) * 2) = o2;
      }
    __syncthreads();
    if (more) M_SSTORE(n + 1)
    __syncthreads();
  }
}

DI int q_pull(int* head, volatile LAS unsigned* s_task_p) {
  __syncthreads();
  if (threadIdx.x == 0) *s_task_p = (unsigned)atomicAdd(head, 1);
  __syncthreads();
  return (int)*s_task_p;
}
DI void phase_mix(const Params& p, int l, char* smem, volatile LAS unsigned* s_task_p, int bid, int nb) {
  int* C = (int*)(p.ws + OFF_CTR) + l * 16;
  const bool last = (l & 3) == NL - 1;
  const int per_g = last ? 32 : 34;
  const int n_cv = last ? 0 : NCONV;
  const int xcd = (int)(xb_xcc_id() & 7u);
  for (;;) { const int t = q_pull(C, s_task_p); if (t >= 256) break; mlstm_task(p, t, smem); }
  for (int j = 0; j < 8; ++j) {
    const int x = (xcd + j) & 7;
    for (;;) {
      const int e = q_pull(C + 1 + x, s_task_p);
      if (e >= 4 * per_g) break;
      const int gi = e / per_g, r = e - gi * per_g, g = x + 8 * gi, b = g >> 3, h = g & 7;
      if (r < 32) attn_task(p, b, h, b * SEQ + r * 128, 68, true, smem);
      else attn_task(p, b, h, RL + b * CTX + (r - 32) * 128, 4, false, smem);
    }
  }
  for (;;) { const int t = q_pull(C + 9, s_task_p); if (t >= n_cv) break; const int c0 = t * CONV_PER_TASK; convert_range(p, (l & 3) + 1, smem, c0, c0 + CONV_PER_TASK, 1); }
}

DI void phase_mout(const Params& p, int l, int bid, int nb) {
  const int tid_ = tidx(), lane = tid_ & 63, wid = tid_ >> 6;
  char* ws = p.ws;
  const _Float16* hf = (const _Float16*)(ws + OFF_ZQ); const _Float16* hb = (const _Float16*)(ws + OFF_ZK);
  const u16* zo = (const u16*)(ws + OFF_ZO);
  u16* hm = (u16*)(ws + OFF_KC);
  for (int r = bid * 4 + wid; r < R; r += nb * 4) {
#pragma unroll
    for (int hd = 0; hd < 4; ++hd) {
      const size_t off = (size_t)r * D + hd * 256 + lane * 4;
      const h16x4 a = *(const h16x4*)(hf + off), bb = *(const h16x4*)(hb + off);
      float v[4]; float ss = 0.f;
#pragma unroll
      for (int e = 0; e < 4; ++e) { v[e] = (float)a[e] + (float)bb[e]; ss += v[e] * v[e]; }
      ss = wave_sum(ss);
      const float rstd = rsqrtf(ss * (1.f / 256.f) + EPS);
      const uint2 z = *(const uint2*)(zo + off);
      const float4 g4 = *(const float4*)(p.g_mh + (size_t)l * D + hd * 256 + lane * 4);
      const float o0 = sigmf(bf2f((u16)(z.x & 0xffff))) * v[0] * rstd * g4.x;
      const float o1 = sigmf(bf2f((u16)(z.x >> 16))) * v[1] * rstd * g4.y;
      const float o2 = sigmf(bf2f((u16)(z.y & 0xffff))) * v[2] * rstd * g4.z;
      const float o3 = sigmf(bf2f((u16)(z.y >> 16))) * v[3] * rstd * g4.w;
      uint2 o; o.x = pk2(o0, o1); o.y = pk2(o2, o3);
      *(uint2*)(hm + bko(r, hd * 256 + lane * 4, D / 64)) = o;
    }
  }
}

DI void phase_merge(const Params& p, const u16* wb, int mtn, char* smem, int bid, int nb) {
  constexpr int NTN = D / 128;
  char* ws = p.ws;
  const u16* hm = (const u16*)(ws + OFF_KC);
  const u16* ao = (const u16*)(ws + OFF_H) + (size_t)R * 1536;
  const u16* zbr = (const u16*)(ws + OFF_ZBR);
  u16* tt = (u16*)(ws + OFF_AN);
  G_DECL;
  for (int tile = vbid(bid, nb); tile < mtn * NTN; tile += nb) {
    int mt, nt; tile_of(tile, NTN, mt, nt);
    f32x4 acc[4][4]; ZERO_ACC(acc);
    gemm_prefetch(G_ARGS, hm, D, wb + WB_BM, D, mt * 128, nt * 128);
    gemm_mainloop(G_ARGS, hm, D, wb + WB_BM, D, D / 64, mt * 128, nt * 128, acc, smem);
    const unsigned rbase = mt * 128;
    {
      const int tid = tidx(), lane = tid & 63, wid = tid >> 6, wr = wid >> 1, wc = wid & 1, fr = lane & 15, fq = lane >> 4;
      stage_bf16(acc, smem, wr, wc, fr, fq);
      __syncthreads();
#pragma unroll
      for (int i = 0; i < 8; ++i) {
        const unsigned id = tid + 256 * i, row = id >> 4, ch = id & 15;
        const uint4 a = *(const uint4*)(smem + row * ST16 + ch * 16);
        const unsigned grow = rbase + row, col = nt * 128 + ch * 8;
        const uint4 gm = *(const uint4*)(zbr + grow * 2048u + col);
        uint4 o;
#define MRG1(F) o.F = pk2(sigmf(bf2f((u16)(gm.F & 0xffff))) * bf2f((u16)(a.F & 0xffff)), sigmf(bf2f((u16)(gm.F >> 16))) * bf2f((u16)(a.F >> 16)));
        MRG1(x) MRG1(y) MRG1(z) MRG1(w)
#undef MRG1
        *(uint4*)(tt + bko(grow, col, D / 64)) = o;
      }
      __syncthreads();
    }
    ZERO_ACC(acc);
    gemm_prefetch(G_ARGS, ao, D, wb + WB_BA, D, mt * 128, nt * 128);
    gemm_mainloop(G_ARGS, ao, D, wb + WB_BA, D, D / 64, mt * 128, nt * 128, acc, smem);
    const int tid = tidx(), lane = tid & 63, wid = tid >> 6, wr = wid >> 1, wc = wid & 1, fr = lane & 15, fq = lane >> 4;
    stage_bf16(acc, smem, wr, wc, fr, fq);
    __syncthreads();
#pragma unroll
    for (int i = 0; i < 8; ++i) {
      const unsigned id = tid + 256 * i, row = id >> 4, ch = id & 15;
      const uint4 b = *(const uint4*)(smem + row * ST16 + ch * 16);
      const unsigned grow = rbase + row, col = nt * 128 + ch * 8;
      const uint4 a = *(const uint4*)(tt + bko(grow, col, D / 64));
      const uint4 ga = *(const uint4*)(zbr + grow * 2048u + 1024u + col);
      uint4 o;
#define MRG(F) { \
      const float o0 = bf2f((u16)(a.F & 0xffff)) + sigmf(bf2f((u16)(ga.F & 0xffff))) * bf2f((u16)(b.F & 0xffff)); \
      const float o1 = bf2f((u16)(a.F >> 16)) + sigmf(bf2f((u16)(ga.F >> 16))) * bf2f((u16)(b.F >> 16)); \
      o.F = pk2(o0, o1); }
      MRG(x) MRG(y) MRG(z) MRG(w)
#undef MRG
      *(uint4*)(tt + bko(grow, col, D / 64)) = o;
    }
    __syncthreads();
  }
}

__global__ void __launch_bounds__(256, 2) fwd_kernel(Params p) {
  extern __shared__ __attribute__((aligned(16))) char smem[];
  __shared__ __attribute__((aligned(16))) unsigned xbw[4];
  const int bid = blockIdx.x, nb = gridDim.x;
  char* ws = p.ws;
  u16* an = (u16*)(ws + OFF_AN);
  u16* hbuf = (u16*)(ws + OFF_H);
  if (threadIdx.x < 4) xbw[threadIdx.x] = 0u;
  __syncthreads();
  XcdBarrier xb = xcd_barrier_post((unsigned*)(ws + OFF_BAR), (volatile LAS unsigned*)xbw);
  for (int ph = p.ph_lo; ph < p.ph_hi; ++ph) {
    if (ph == NPH - 1) {
      phase_final(p, bid, nb);
    } else {
      const int l = ph / NPH_LAYER, k = ph - l * NPH_LAYER;
      if (k == 0 && l > 0) continue;
      if (k == 7) continue;
      const u16* wb = (const u16*)(ws + OFF_WB) + (size_t)(l & 1) * WB_END;
      const float* mods_l = (const float*)(ws + OFF_MODS) + (size_t)l * 5 * NMOD * D;
      const int mtl = (l == NL - 1) ? RL / 128 : MT;
      const int nrep = ((DUP_MASK >> k) & 1) ? 2 : 1;
      for (int rep = 0; rep < nrep; ++rep) {
      if (rep) xcd_barrier(xb);
      switch (k) {
        case 0:
          if (l == 0) {
            phase_init(p, smem, bid, nb);
            constexpr int NMODWG = NL * (NMOD * D / 128), CV_A = 10240;
            convert_range(p, 0, smem, bid, CV_A, nb);
            if (bid >= NMODWG && nb > NMODWG) convert_range(p, 0, smem, CV_A + (bid - NMODWG), CONV_TILES, nb - NMODWG);
            else if (nb <= NMODWG) convert_range(p, 0, smem, CV_A + bid, CONV_TILES, nb);
          } else phase_convert(p, l, smem, bid, nb);
          break;
        case 1: phase_norm(p, R, p.g_n1 + l * D, mods_l, 0, 1, an, l == 0, bid, nb); break;
        case 2: phase_ffn_up(p, MT, an, wb + WB_UP1, hbuf, smem, bid, nb); break;
        case 3: phase_gemm_resid(p, MT, hbuf, DFF, wb + WB_DN1, mods_l, 2, 0.5f, l == 0, smem, bid, nb); break;
        case 4: phase_norm(p, R, p.g_n2 + l * D, mods_l, 3, 4, an, false, bid, nb); break;
        case 5: phase_inproj(p, l, an, wb + WB_IN, smem, bid, nb); break;
        case 6: phase_prep(p, l, bid, nb); phase_upproj(p, wb, smem, bid, nb); break;
        case 7: phase_upproj(p, wb, smem, bid, nb); break;
        case 8: phase_mix(p, l + 4 * rep, smem, (volatile LAS unsigned*)&xbw[2], bid, nb); break;
        case 9: phase_mout(p, l, bid, nb); break;
        case 10: phase_merge(p, wb, mtl, smem, bid, nb); break;
        case 11: phase_gemm_resid(p, mtl, an, D, wb + WB_OUT, mods_l, 5, 1.0f, false, smem, bid, nb); break;
        case 12: phase_norm(p, mtl * 128, p.g_n3 + l * D, mods_l, 6, 7, an, false, bid, nb); break;
        case 13: phase_ffn_up(p, mtl, an, wb + WB_UP2, hbuf, smem, bid, nb); break;
        case 14: phase_gemm_resid(p, mtl, hbuf, DFF, wb + WB_DN2, mods_l, 8, 0.5f, false, smem, bid, nb); break;
      }
      }
    }
    if (ph + 1 < p.ph_hi) {
      if (p.ph_hi > NPH) cg::this_grid().sync(); else xcd_barrier(xb);
    }
  }
}

extern "C" void kernel_launch(void* const* d_in, const int* in_sizes, int n_in, void* d_out, int out_size, void* d_ws, size_t ws_size, hipStream_t stream) {
  static int grid = 0;
  if (grid == 0) {
    if (n_in != 25 || ws_size < WS_END) { fprintf(stderr, "kernel_launch: unexpected n_in %d or ws_size %zu (< %zu)\n", n_in, ws_size, (size_t)WS_END); grid = -1; return; }
    int dev = 0, cus = 0, per_cu = 0;
    hipGetDevice(&dev);
    hipDeviceGetAttribute(&cus, hipDeviceAttributeMultiprocessorCount, dev);
    hipFuncSetAttribute((const void*)fwd_kernel, hipFuncAttributeMaxDynamicSharedMemorySize, SMEM_BYTES);
    hipOccupancyMaxActiveBlocksPerMultiprocessor(&per_cu, (const void*)fwd_kernel, 256, SMEM_BYTES);
    if (per_cu < 1) per_cu = 1;
    if (per_cu > 2) per_cu = 2;
    grid = cus * per_cu;
    fprintf(stderr, "kernel_launch: grid %d (%d CUs x %d), ws need %zu have %zu\n", grid, cus, per_cu, (size_t)WS_END, ws_size);
  }
  if (grid < 0) return;
  Params p{};
  const float** f = (const float**)&p;
  for (int i = 0; i < 25; ++i) f[i] = (const float*)d_in[i];
  p.out = (float*)d_out; p.ws = (char*)d_ws;
  hipMemsetAsync((char*)d_ws + OFF_CTR, 0, (OFF_WB - OFF_CTR), stream);
#if ONE_LAUNCH
  p.ph_lo = 0; p.ph_hi = NPH;
  void* args[] = {&p};
  hipError_t e = hipLaunchCooperativeKernel((const void*)fwd_kernel, dim3(grid), dim3(256), args, SMEM_BYTES, stream);
  if (e != hipSuccess) fprintf(stderr, "cooperative launch failed: %s (grid %d)\n", hipGetErrorString(e), grid);
#else
  for (int ph = 0; ph < NPH; ++ph) {
    p.ph_lo = ph; p.ph_hi = ph + 1;
    hipLaunchKernelGGL(fwd_kernel, dim3(grid), dim3(256), SMEM_BYTES, stream, p);
  }
#endif
}
```
